# Optimizing an MI355X kernel written in HIP

```python
import jax, jax.numpy as jnp
from jax import lax
import numpy as np

D_MODEL = 2048
BATCH = 2
SEQ = 4096
DEPTH = 1

MLA_HEADS = 8
MLA_Q_RANK = 512
MLA_KV_RANK = 256
MLA_NOPE = 128
MLA_ROPE = 64
MLA_V = 128
ROPE_THETA = 10000.0
Q_BLOCK = 128
GLA_HEADS = 4
GLA_DK = 128
GLA_DV = 256
GLA_GATE_RANK = 16
GLA_GATE_NORM = 16.0
GLA_CHUNK = 64
N_EXPERTS = 32
TOP_K = 4
D_EXPERT = D_MODEL
SWIGLU_LIMIT = 7.0
SWIGLU_ALPHA = 1.702
EXPERT_BLOCK = 256
EPS = 1e-6
N_MOD = 6

IN_SPLITS = (
    MLA_Q_RANK,
    MLA_KV_RANK + MLA_ROPE,
    GLA_HEADS * GLA_DK,
    GLA_HEADS * GLA_DK,
    GLA_HEADS * GLA_DV,
    GLA_GATE_RANK,
    GLA_HEADS * GLA_DV,
    D_MODEL,
    D_MODEL,
)
D_IN = sum(IN_SPLITS)
IN_OFFSETS = tuple(sum(IN_SPLITS[: i + 1]) for i in range(len(IN_SPLITS) - 1))

kernel_name = "hybrid_mla_gla_moe_adaln"


def rms_norm(x, w):
    xf = x.astype(jnp.float32)
    y = xf * lax.rsqrt(jnp.mean(xf * xf, axis=-1, keepdims=True) + EPS)
    return (y * w.astype(jnp.float32)).astype(x.dtype)


def modulate(h, shift, scale):
    return h * (1 + scale[:, None, :]) + shift[:, None, :]


def apply_rope(x, cos, sin):
    xf = x.astype(jnp.float32).reshape(*x.shape[:-1], MLA_ROPE // 2, 2)
    x_re, x_im = xf[..., 0], xf[..., 1]
    out = jnp.stack([x_re * cos - x_im * sin, x_re * sin + x_im * cos], axis=-1)
    return out.reshape(x.shape).astype(x.dtype)


def mla_attention(q_lat, kv_lat, positions, q_norm_w, w_q_b, kv_norm_w, w_kv_b):
    B, S, _ = q_lat.shape
    H = MLA_HEADS
    q = (rms_norm(q_lat, q_norm_w) @ w_q_b).reshape(B, S, H, MLA_NOPE + MLA_ROPE)
    q_nope, q_pe = q[..., :MLA_NOPE], q[..., MLA_NOPE:]
    c_kv, k_pe = kv_lat[..., :MLA_KV_RANK], kv_lat[..., MLA_KV_RANK:]
    kv = (rms_norm(c_kv, kv_norm_w) @ w_kv_b).reshape(B, S, H, MLA_NOPE + MLA_V)
    k_nope, v = kv[..., :MLA_NOPE], kv[..., MLA_NOPE:]
    inv_freq = ROPE_THETA ** (-(jnp.arange(0, MLA_ROPE, 2, dtype=jnp.float32) / MLA_ROPE))
    ang = positions.astype(jnp.float32)[..., None] * inv_freq
    cos, sin = jnp.cos(ang), jnp.sin(ang)
    q_pe = apply_rope(q_pe, cos[:, :, None, :], sin[:, :, None, :])
    k_pe = apply_rope(k_pe, cos, sin)
    scale = (MLA_NOPE + MLA_ROPE) ** -0.5
    nb = S // Q_BLOCK
    qn_blocks = q_nope.reshape(B, nb, Q_BLOCK, H, MLA_NOPE).transpose(1, 0, 2, 3, 4)
    qp_blocks = q_pe.reshape(B, nb, Q_BLOCK, H, MLA_ROPE).transpose(1, 0, 2, 3, 4)
    key_idx = jnp.arange(S)

    def query_block(args):
        qn, qp, blk = args
        s = jnp.einsum('bqhd,bkhd->bhqk', qn, k_nope, preferred_element_type=jnp.float32)
        s = s + jnp.einsum('bqhr,bkr->bhqk', qp, k_pe, preferred_element_type=jnp.float32)
        q_idx = blk * Q_BLOCK + jnp.arange(Q_BLOCK)
        mask = key_idx[None, :] <= q_idx[:, None]
        s = jnp.where(mask, s * scale, -jnp.inf)
        p = jax.nn.softmax(s, axis=-1).astype(v.dtype)
        return jnp.einsum('bhqk,bkhd->bqhd', p, v)

    o = lax.map(query_block, (qn_blocks, qp_blocks, jnp.arange(nb)))
    return o.transpose(1, 0, 2, 3, 4).reshape(B, S, H * MLA_V)


def gla_attention(q, k, v, gate_lr, g_out, w_gk_up, b_gk_up, norm_w):
    B, S, _ = q.shape
    H, DK, DV, C = GLA_HEADS, GLA_DK, GLA_DV, GLA_CHUNK
    n_chunks = S // C
    gk = jax.nn.log_sigmoid((gate_lr @ w_gk_up + b_gk_up).astype(jnp.float32)) / GLA_GATE_NORM

    def to_chunks(t, d):
        return t.astype(jnp.float32).reshape(B, n_chunks, C, H, d).transpose(1, 0, 3, 2, 4)

    qc = to_chunks(q, DK) * (DK ** -0.5)
    kc, vc, gc = to_chunks(k, DK), to_chunks(v, DV), to_chunks(gk, DK)
    causal = jnp.tril(jnp.ones((C, C), dtype=bool))

    def chunk_step(state, inp):
        qi, ki, vi, gi = inp
        b = jnp.cumsum(gi, axis=2)
        o_inter = jnp.einsum('bhcd,bhdv->bhcv', qi * jnp.exp(b), state)
        diff = b[:, :, :, None, :] - b[:, :, None, :, :]
        decay = jnp.exp(jnp.where(causal[:, :, None], diff, -jnp.inf))
        a = jnp.einsum('bhid,bhjd,bhijd->bhij', qi, ki, decay)
        o_intra = jnp.einsum('bhij,bhjv->bhiv', a, vi)
        b_last = b[:, :, -1:, :]
        state = state * jnp.exp(b_last[:, :, 0, :])[..., None] + jnp.einsum(
            'bhjd,bhjv->bhdv', ki * jnp.exp(b_last - b), vi)
        return state, o_inter + o_intra

    s0 = jnp.zeros((B, H, DK, DV), jnp.float32)
    _, o = lax.scan(chunk_step, s0, (qc, kc, vc, gc))
    o = o.transpose(1, 0, 3, 2, 4).reshape(B, S, H, DV)
    o = rms_norm(o, norm_w) * jax.nn.silu(g_out.astype(jnp.float32).reshape(B, S, H, DV))
    return o.reshape(B, S, H * DV).astype(q.dtype)


def moe_ffn(h, w_router, b_router, w1, b1, w2, b2):
    B, S, D = h.shape
    N = B * S
    E, BLK = N_EXPERTS, EXPERT_BLOCK
    xt = h.reshape(N, D)
    logits = (xt @ w_router + b_router).astype(jnp.float32)
    top_val, top_idx = lax.top_k(logits, TOP_K)
    top_w = jax.nn.softmax(top_val, axis=-1)
    A = N * TOP_K
    e_flat = top_idx.reshape(A)
    tok_flat = jnp.repeat(jnp.arange(N, dtype=jnp.int32), TOP_K)
    w_flat = top_w.reshape(A)
    onehot = jax.nn.one_hot(e_flat, E, dtype=jnp.int32)
    counts = onehot.sum(axis=0)
    rank = (jnp.cumsum(onehot, axis=0) * onehot).sum(axis=-1) - 1
    padded = (counts + BLK - 1) // BLK * BLK
    pad_end = jnp.cumsum(padded)
    pad_start = pad_end - padded
    dest = pad_start[e_flat] + rank
    n_blocks = -(-A // BLK) + E
    P = n_blocks * BLK
    slot_tok = jnp.full((P,), N, dtype=jnp.int32).at[dest].set(tok_flat)
    slot_w = jnp.zeros((P,), jnp.float32).at[dest].set(w_flat)
    block_expert = jnp.minimum(
        jnp.searchsorted(pad_end, jnp.arange(n_blocks) * BLK, side='right'), E - 1)
    x_pad = jnp.concatenate([xt, jnp.zeros((1, D), xt.dtype)], axis=0)
    xs = x_pad[slot_tok].reshape(n_blocks, BLK, D)

    def expert_block(args):
        xb, e = args
        hm = xb @ w1[e] + b1[e]
        x_glu, x_lin = hm[:, ::2], hm[:, 1::2]
        x_glu = jnp.minimum(x_glu, SWIGLU_LIMIT)
        x_lin = jnp.clip(x_lin, -SWIGLU_LIMIT, SWIGLU_LIMIT)
        act = x_glu * jax.nn.sigmoid(SWIGLU_ALPHA * x_glu) * (x_lin + 1)
        return act @ w2[e] + b2[e]

    ys = lax.map(expert_block, (xs, block_expert)).reshape(P, D)
    out = jnp.zeros((N + 1, D), jnp.float32).at[slot_tok].add(
        ys.astype(jnp.float32) * slot_w[:, None])
    return out[:N].reshape(B, S, D).astype(h.dtype)


def setup_inputs(seed: int = 0) -> dict:
    key = jax.random.key(seed)
    ks = jax.random.split(key, 32)
    f32 = jnp.float32
    L, D = DEPTH, D_MODEL

    def nrm(k, shape, fan_in):
        return jax.random.normal(k, shape, f32) * (fan_in ** -0.5)

    def gain(k, shape):
        return 1.0 + 0.02 * jax.random.normal(k, shape, f32)

    def bias(k, shape):
        return 0.01 * jax.random.normal(k, shape, f32)

    x = jax.random.normal(ks[0], (BATCH, SEQ, D), f32)
    c = jax.random.normal(ks[1], (BATCH, D), f32)
    offsets = jax.random.randint(ks[2], (BATCH, 1), 0, 1024, dtype=jnp.int32)
    positions = offsets + jnp.arange(SEQ, dtype=jnp.int32)[None, :]
    return {
        "x": x,
        "c": c,
        "positions": positions,
        "w_ada": 0.5 * nrm(ks[3], (L, D, N_MOD * D), D),
        "b_ada": bias(ks[4], (L, N_MOD * D)),
        "norm_mix_w": gain(ks[5], (L, D)),
        "w_in": nrm(ks[6], (L, D, D_IN), D),
        "mla_q_norm_w": gain(ks[7], (L, MLA_Q_RANK)),
        "mla_w_q_b": nrm(ks[8], (L, MLA_Q_RANK, MLA_HEADS * (MLA_NOPE + MLA_ROPE)), MLA_Q_RANK),
        "mla_kv_norm_w": gain(ks[9], (L, MLA_KV_RANK)),
        "mla_w_kv_b": nrm(ks[10], (L, MLA_KV_RANK, MLA_HEADS * (MLA_NOPE + MLA_V)), MLA_KV_RANK),
        "gla_w_gk_up": nrm(ks[11], (L, GLA_GATE_RANK, GLA_HEADS * GLA_DK), GLA_GATE_RANK),
        "gla_b_gk_up": bias(ks[12], (L, GLA_HEADS * GLA_DK)),
        "gla_norm_w": gain(ks[13], (L, GLA_DV)),
        "w_o_mla": nrm(ks[14], (L, MLA_HEADS * MLA_V, D), MLA_HEADS * MLA_V),
        "w_o_gla": nrm(ks[15], (L, GLA_HEADS * GLA_DV, D), GLA_HEADS * GLA_DV),
        "w_out": nrm(ks[16], (L, D, D), D),
        "norm_ffn_w": gain(ks[17], (L, D)),
        "w_router": nrm(ks[18], (L, D, N_EXPERTS), D),
        "b_router": bias(ks[19], (L, N_EXPERTS)),
        "w1": nrm(ks[20], (L, N_EXPERTS, D, 2 * D_EXPERT), D),
        "b1": bias(ks[21], (L, N_EXPERTS, 2 * D_EXPERT)),
        "w2": nrm(ks[22], (L, N_EXPERTS, D_EXPERT, D), D_EXPERT),
        "b2": bias(ks[23], (L, N_EXPERTS, D)),
        "w_ada_final": 0.5 * nrm(ks[24], (D, 2 * D), D),
        "b_ada_final": bias(ks[25], (2 * D,)),
        "norm_final_w": gain(ks[26], (D,)),
    }


def reference(x, c, positions, w_ada, b_ada, norm_mix_w, w_in, mla_q_norm_w, mla_w_q_b,
              mla_kv_norm_w, mla_w_kv_b, gla_w_gk_up, gla_b_gk_up, gla_norm_w, w_o_mla,
              w_o_gla, w_out, norm_ffn_w, w_router, b_router, w1, b1, w2, b2,
              w_ada_final, b_ada_final, norm_final_w):
    cond = jax.nn.silu(c)
    for l in range(DEPTH):
        mod = cond @ w_ada[l] + b_ada[l]
        sh_m, sc_m, g_m, sh_f, sc_f, g_f = jnp.split(mod, N_MOD, axis=-1)
        h = modulate(rms_norm(x, norm_mix_w[l]), sh_m, sc_m)
        proj = h @ w_in[l]
        q_lat, kv_lat, gq, gk, gv, g_lr, g_out, gate_a, gate_b = jnp.split(proj, IN_OFFSETS, axis=-1)
        y_a = mla_attention(q_lat, kv_lat, positions, mla_q_norm_w[l], mla_w_q_b[l],
                            mla_kv_norm_w[l], mla_w_kv_b[l]) @ w_o_mla[l]
        y_b = gla_attention(gq, gk, gv, g_lr, g_out, gla_w_gk_up[l], gla_b_gk_up[l],
                            gla_norm_w[l]) @ w_o_gla[l]
        merged = jax.nn.sigmoid(gate_a) * y_a + jax.nn.sigmoid(gate_b) * y_b
        x = x + g_m[:, None, :] * (merged @ w_out[l])
        h = modulate(rms_norm(x, norm_ffn_w[l]), sh_f, sc_f)
        x = x + g_f[:, None, :] * moe_ffn(h, w_router[l], b_router[l], w1[l], b1[l], w2[l], b2[l])
    fmod = cond @ w_ada_final + b_ada_final
    sh_o, sc_o = jnp.split(fmod, 2, axis=-1)
    return modulate(rms_norm(x, norm_final_w), sh_o, sc_o)
```

```cpp
#include <hip/hip_runtime.h>
#include <cstdio>
#include <cstdint>

#ifndef MK_ONE_LAUNCH
#define MK_ONE_LAUNCH 1
#endif

#define GAS __attribute__((address_space(1)))
#define LAS __attribute__((address_space(3)))
typedef unsigned short bf16_t;
typedef short bf16x8 __attribute__((ext_vector_type(8)));
typedef short s16x4 __attribute__((ext_vector_type(4)));
typedef float f32x2 __attribute__((ext_vector_type(2)));
typedef float f32x4 __attribute__((ext_vector_type(4)));
typedef float f32x16 __attribute__((ext_vector_type(16)));
typedef unsigned u32x2 __attribute__((ext_vector_type(2)));
typedef unsigned u32x4 __attribute__((ext_vector_type(4)));
typedef GAS unsigned gu32;

constexpr int DM = 2048, NB = 2, SEQ = 4096, NTOK = NB * SEQ;
constexpr int MLA_H = 8, MLA_QR = 512, MLA_KVR = 256, MLA_NOPE = 128, MLA_ROPE = 64, MLA_V = 128, MLA_QK = MLA_NOPE + MLA_ROPE;
constexpr int GLA_H = 4, GLA_DK = 128, GLA_DV = 256, GLA_R = 16, GLA_C = 64, GLA_NCH = SEQ / GLA_C;
constexpr int NEXP = 32, TOPK = 4, DEXP = 2048;
constexpr float EPS = 1e-6f;
constexpr int DIN = 8016, DINP = 8192;
constexpr int C_QLAT = 0, C_CKV = 512, C_KPE = 768, C_GQ = 832, C_GK = 1344, C_GV = 1856, C_GLR = 2880, C_GOUT = 2896, C_GA = 3920, C_GB = 5968;
constexpr int NQ = MLA_H * MLA_QK;
constexpr int NKV = MLA_H * (MLA_NOPE + MLA_V);
constexpr int ECAP = NTOK;

typedef __bf16 bf16x2_hw __attribute__((ext_vector_type(2)));
__device__ __forceinline__ unsigned cvt_pk_bf16(float lo, float hi) { const f32x2 v = {lo, hi}; return __builtin_bit_cast(unsigned, __builtin_convertvector(v, bf16x2_hw)); }
__device__ __forceinline__ float bf_lo(unsigned w) { return __uint_as_float(w << 16); }
__device__ __forceinline__ float bf_hi(unsigned w) { return __uint_as_float(w & 0xffff0000u); }
__device__ __forceinline__ float bf2f(bf16_t b) { return __uint_as_float(((unsigned)b) << 16); }
__device__ __forceinline__ float fast_exp(float x) { return __builtin_amdgcn_exp2f(x * 1.4426950408889634f); }
__device__ __forceinline__ float fast_sigmoid(float x) { return __builtin_amdgcn_rcpf(1.0f + __builtin_amdgcn_exp2f(-x * 1.4426950408889634f)); }
__device__ __forceinline__ float wave_sum(float v) {
#pragma unroll
    for (int o = 1; o < 64; o <<= 1) v += __shfl_xor(v, o);
    return v;
}
__device__ __forceinline__ unsigned pk4_fp8(float a, float b, float c, float d) { int w = 0; w = __builtin_amdgcn_cvt_pk_fp8_f32(a, b, w, false); w = __builtin_amdgcn_cvt_pk_fp8_f32(c, d, w, true); return (unsigned)w; }
constexpr float W8_SCALE = 256.0f, A8_SCALE = 4.0f, Y8_SCALE = 16.0f;
#define LDS_WAIT() asm volatile("s_waitcnt lgkmcnt(0)" ::: "memory")
#define VM_WAIT() asm volatile("s_waitcnt vmcnt(0)" ::: "memory")
#define RLX_AGENT __ATOMIC_RELAXED, __HIP_MEMORY_SCOPE_AGENT

namespace pg8 {
constexpr int BM = 256, BK = 64, HALF = 128, HTB = HALF * BK * 2, STAGE_BYTES = 8 * HTB, NXCD = 8, WGM = 8;
__host__ __device__ __forceinline__ int lds_byte(int r, int c) { const int st = (r >> 4) * 2 + (c >> 5), rr = r & 15, cc = c & 31, ob = rr * 64 + cc * 2; return st * 1024 + (ob ^ (((ob >> 9) & 1) << 5)); }
__host__ __device__ __forceinline__ void stage_rc(int b, int& R, int& C) { const int st = b / 1024, sb = b % 1024, swz = sb ^ (((sb >> 9) & 1) << 5); R = (st >> 1) * 16 + swz / 64; C = (st & 1) * 32 + (swz % 64) / 2; }
__host__ __device__ __forceinline__ int perm32(int rho) { const int n = rho >> 4, i = rho & 15; return 8 * (i >> 2) + 4 * n + (i & 3); }

struct Unit { int pm, pn, aux, cnt; };
typedef int v4i_t __attribute__((ext_vector_type(4)));
typedef int v8i_t __attribute__((ext_vector_type(8)));
__device__ __forceinline__ v8i_t ld_frag8(const LAS unsigned char* p) {
    const v4i_t lo = *(const LAS v4i_t*)p, hi = *(const LAS v4i_t*)(p + 1024);
    return __builtin_shufflevector(lo, hi, 0, 1, 2, 3, 4, 5, 6, 7);
}
template <bool FP8> struct FragT { typedef bf16x8 T[2]; };
template <> struct FragT<true> { typedef v8i_t T; };

struct DenseOrder {
    static constexpr bool GATHER = false, FP8 = false, DEPWAIT = false;
    const bf16_t* A; const bf16_t* Bt; int ldab, KB;
    int nM, nN, nwg, G, c;
    __device__ __forceinline__ void init(const bf16_t* A_, int lda_, const bf16_t* Bt_, int M, int N, int K_, int G_, int c_) { A = A_; ldab = lda_ * 2; Bt = Bt_; KB = K_ * 2; nM = M / BM; nN = N / BM; nwg = nM * nN; G = G_; c = c_; }
    __device__ __forceinline__ bool next(int i, Unit& u) const {
        const long L = (long)i * G + c; if (L >= nwg) return false;
        int wgid = (int)L; { const int q = nwg / NXCD, r = nwg % NXCD, xcd = wgid % NXCD, off = wgid / NXCD; wgid = (xcd < r ? xcd * (q + 1) : r * (q + 1) + (xcd - r) * q) + off; }
        const int nig = WGM * nN, gid = wgid / nig, fm = gid * WGM, gsz = (nM - fm) < WGM ? (nM - fm) : WGM;
        u.pm = fm + ((wgid % nig) % gsz); u.pn = (wgid % nig) / gsz; u.aux = 0; u.cnt = 0; return true;
    }
    __device__ __forceinline__ const char* a_ptr(const Unit& u) const { return (const char*)A + (size_t)u.pm * BM * ldab; }
    __device__ __forceinline__ unsigned a_off(const Unit&, int row, int colb) const { return (unsigned)(row * ldab + colb); }
    __device__ __forceinline__ int a_row(const Unit&, int row) const { return row; }
    __device__ __forceinline__ const char* b_ptr(const Unit& u) const { return (const char*)Bt + (size_t)u.pn * BM * KB; }
};

template <class Epi, class Sched>
__device__ __forceinline__ void gemm_phase(LAS unsigned char* lds, const Sched& S, const Epi& E) {
    const int tid = threadIdx.x, wid = __builtin_amdgcn_readfirstlane(tid >> 6), lane = tid & 63, wr = wid >> 2, wc = wid & 3, fr = lane & 15, fq = lane >> 4;
    int KB = S.KB; asm volatile("" : "+s"(KB));
    const int nt = KB / (BK * 2);
    int sR[2], sC[2]; unsigned voffB[2];
#pragma unroll
    for (int i = 0; i < 2; ++i) { int R, C; stage_rc(tid * 16 + i * 8192, R, C); sR[i] = R; sC[i] = 2 * C; const int Rb = (R & ~31) + perm32(R & 31); voffB[i] = (unsigned)(Rb * KB + 2 * C); }
    const size_t kstep = (size_t)(BK * 2);
    const size_t hstep = (size_t)HALF * KB;
    const unsigned ldsw = (unsigned)wid * 1024u;
    const int aoff = lds_byte(wr * 64 + fr, fq * 8), boff = lds_byte(wc * 32 + fr, fq * 8);
#define PG8_SA(b, h) (((b) * 2 + (h)) * HTB)
#define PG8_SB(b, h) ((4 + (b) * 2 + (h)) * HTB)
#define PG8_STAGE(bufoff, gbase, v0, v1) do { \
        __builtin_amdgcn_global_load_lds((const unsigned*)((const char*)(gbase) + (v0)), (LAS unsigned*)(lds + (bufoff) + ldsw), 16, 0, 0); \
        __builtin_amdgcn_global_load_lds((const unsigned*)((const char*)(gbase) + (v1)), (LAS unsigned*)(lds + (bufoff) + ldsw + 8192), 16, 0, 0); } while (0)
#define PG8_STAGEB(bufoff, gbase) PG8_STAGE(bufoff, gbase, voffB[0], voffB[1])
#define PG8_LDA(dst, b, h) do { _Pragma("unroll") for (int m = 0; m < 4; ++m) { if constexpr (Sched::FP8) dst[m] = ld_frag8(lds + PG8_SA(b, h) + aoff + m * 2048); \
        else { _Pragma("unroll") for (int k = 0; k < 2; ++k) dst[m][k] = *(const LAS bf16x8*)(lds + PG8_SA(b, h) + aoff + m * 2048 + k * 1024); } } } while (0)
#define PG8_LDB(dst, b, h) do { _Pragma("unroll") for (int n = 0; n < 2; ++n) { if constexpr (Sched::FP8) dst[n] = ld_frag8(lds + PG8_SB(b, h) + boff + n * 2048); \
        else { _Pragma("unroll") for (int k = 0; k < 2; ++k) dst[n][k] = *(const LAS bf16x8*)(lds + PG8_SB(b, h) + boff + n * 2048 + k * 1024); } } } while (0)
#define PG8_MMA(ai, bj, At, Bt) do { __builtin_amdgcn_s_setprio(1); _Pragma("unroll") for (int m = 0; m < 4; ++m) _Pragma("unroll") for (int n = 0; n < 2; ++n) { \
        if constexpr (Sched::FP8) acc[ai][bj][m][n] = __builtin_amdgcn_mfma_scale_f32_16x16x128_f8f6f4(Bt[n], At[m], acc[ai][bj][m][n], 0, 0, 0, 0x7F7F7F7F, 0, 0x7F7F7F7F); \
        else { _Pragma("unroll") for (int k = 0; k < 2; ++k) acc[ai][bj][m][n] = __builtin_amdgcn_mfma_f32_16x16x32_bf16(Bt[n][k], At[m][k], acc[ai][bj][m][n], 0, 0, 0); } } \
        __builtin_amdgcn_s_setprio(0); } while (0)
#define PG8_WAIT_V(n) asm volatile("s_waitcnt vmcnt(" #n ")" ::: "memory")
#define PG8_WAIT_L(n) asm volatile("s_waitcnt lgkmcnt(" #n ")" ::: "memory")
#define PG8_BAR __builtin_amdgcn_s_barrier()
#define PG8_SCHED __builtin_amdgcn_sched_barrier(0)
#define PG8_KITER(t) do { \
            const bool last = (t == nt - 2); \
            const char* a1 = cA + (size_t)(t + 1) * kstep; \
            const char* a2 = last ? nA : cA + (size_t)(t + 2) * kstep; const char* b2 = last ? nB : cB + (size_t)(t + 2) * kstep; \
            const char* a3 = a2 + kstep; const char* b3 = b2 + kstep; \
            PG8_LDB(B0, 0, 0); PG8_LDB(B1, 0, 1); PG8_SCHED; PG8_LDA(At, 0, 0); PG8_STAGE(PG8_SA(1, 1), a1, vc[1][0], vc[1][1]); \
            if constexpr (Sched::GATHER) { if (last) { \
                _Pragma("unroll") \
                for (int h = 0; h < 2; ++h) \
                _Pragma("unroll") \
                    for (int i = 0; i < 2; ++i) vc[h][i] = vn[h][i]; } } \
            PG8_WAIT_V(8); PG8_WAIT_L(0); PG8_BAR; PG8_MMA(0, 0, At, B0); PG8_MMA(0, 1, At, B1); PG8_BAR; PG8_SCHED; \
            PG8_LDA(At, 0, 1); PG8_STAGEB(PG8_SB(0, 0), b2); PG8_STAGEB(PG8_SB(0, 1), b2 + hstep); PG8_STAGE(PG8_SA(0, 0), a2, vc[0][0], vc[0][1]); \
            PG8_WAIT_V(8); PG8_WAIT_L(0); PG8_BAR; PG8_MMA(1, 0, At, B0); PG8_MMA(1, 1, At, B1); PG8_BAR; PG8_SCHED; \
            PG8_LDB(B0, 1, 0); PG8_LDB(B1, 1, 1); PG8_SCHED; PG8_LDA(At, 1, 0); PG8_STAGE(PG8_SA(0, 1), a2, vc[1][0], vc[1][1]); \
            PG8_WAIT_V(8); PG8_WAIT_L(0); PG8_BAR; PG8_MMA(0, 0, At, B0); PG8_MMA(0, 1, At, B1); PG8_BAR; PG8_SCHED; \
            PG8_LDA(At, 1, 1); PG8_STAGEB(PG8_SB(1, 0), b3); PG8_STAGEB(PG8_SB(1, 1), b3 + hstep); PG8_STAGE(PG8_SA(1, 0), a3, vc[0][0], vc[0][1]); \
            PG8_WAIT_V(8); PG8_WAIT_L(0); PG8_BAR; PG8_MMA(1, 0, At, B0); PG8_MMA(1, 1, At, B1); PG8_BAR; PG8_SCHED; \
        } while (0)
    Unit cur, nxt; int ui = 0;
    if (!S.next(0, cur)) return;
    f32x4 acc[2][2][4][2];
#pragma unroll
    for (int a = 0; a < 2; ++a)
#pragma unroll
        for (int b = 0; b < 2; ++b)
#pragma unroll
            for (int m = 0; m < 4; ++m)
#pragma unroll
                for (int n = 0; n < 2; ++n) acc[a][b][m][n] = (f32x4){0.f, 0.f, 0.f, 0.f};
    typename FragT<Sched::FP8>::T At[4], B0[2], B1[2];
    unsigned vc[2][2], vn[2][2];
#pragma unroll
    for (int h = 0; h < 2; ++h)
#pragma unroll
        for (int i = 0; i < 2; ++i) { vc[h][i] = S.a_off(cur, 128 * h + sR[i], sC[i]); asm volatile("" : "+v"(vc[h][i])); vn[h][i] = vc[h][i]; }
    const char* cA = S.a_ptr(cur); const char* cB = S.b_ptr(cur);
    if constexpr (Sched::DEPWAIT) S.wait_ready(cur);
    if constexpr (Epi::PREBIAS) { if (wid == 0) E.pre(cur, (LAS float*)(lds + STAGE_BYTES), lane); }
    PG8_STAGEB(PG8_SB(0, 0), cB); PG8_STAGEB(PG8_SB(0, 1), cB + hstep); PG8_STAGE(PG8_SA(0, 0), cA, vc[0][0], vc[0][1]); PG8_STAGE(PG8_SA(0, 1), cA, vc[1][0], vc[1][1]);
    if (wr == 1) PG8_BAR;
    PG8_WAIT_V(2); PG8_BAR;
    PG8_STAGEB(PG8_SB(1, 0), cB + kstep); PG8_STAGE(PG8_SA(1, 0), cA + kstep, vc[0][0], vc[0][1]); PG8_STAGEB(PG8_SB(1, 1), cB + hstep + kstep);
    PG8_WAIT_V(6); PG8_BAR;
    for (;;) {
        const bool has_next = S.next(ui + 1, nxt);
        const char* nA = has_next ? S.a_ptr(nxt) : cA; const char* nB = has_next ? S.b_ptr(nxt) : cB;
        if constexpr (Sched::GATHER) {
            if (has_next) {
                int tz = threadIdx.x; asm volatile("" : "+v"(tz));
#pragma unroll
                for (int h = 0; h < 2; ++h)
#pragma unroll
                    for (int i = 0; i < 2; ++i) { int R, C; stage_rc(tz * 16 + i * 8192, R, C); vn[h][i] = S.a_off(nxt, 128 * h + R, 2 * C); }
            }
        }
        if constexpr (Epi::MIDHOOK) {
            for (int t = 0; t < nt / 2; t += 2) PG8_KITER(t);
            { int tz = threadIdx.x; asm volatile("" : "+v"(tz)); const int we = tz >> 6, le = tz & 63; E.mid(acc, cur, we >> 2, we & 3, le & 15, le >> 4); }
            for (int t = nt / 2; t < nt; t += 2) PG8_KITER(t);
        } else if constexpr (Sched::DEPWAIT) {
            for (int t = 0; t < nt; t += 2) { if (t == nt - 2 && has_next) S.wait_ready(nxt); PG8_KITER(t); }
        } else { for (int t = 0; t < nt; t += 2) PG8_KITER(t); }
        if (wr == 0) PG8_BAR;
        { int tz = threadIdx.x; asm volatile("" : "+v"(tz)); const int we = tz >> 6, le = tz & 63;
          if constexpr (Epi::PREBIAS) E(acc, cur, we >> 2, we & 3, le & 15, le >> 4, (const LAS float*)(lds + STAGE_BYTES + (ui & 1) * 1024)); else E(acc, cur, we >> 2, we & 3, le & 15, le >> 4); }
        if (!has_next) break;
#pragma unroll
        for (int a = 0; a < 2; ++a)
#pragma unroll
            for (int b = 0; b < 2; ++b)
#pragma unroll
                for (int m = 0; m < 4; ++m)
#pragma unroll
                    for (int n = 0; n < 2; ++n) acc[a][b][m][n] = (f32x4){0.f, 0.f, 0.f, 0.f};
        cur = nxt; cA = nA; cB = nB; ++ui;
        if constexpr (Epi::PREBIAS) { if (wid == 0) E.pre(cur, (LAS float*)(lds + STAGE_BYTES + (ui & 1) * 1024), lane); }
        if (wr == 1) PG8_BAR;
    }
    PG8_WAIT_V(0);
    PG8_BAR;
#undef PG8_SA
#undef PG8_SB
#undef PG8_STAGE
#undef PG8_STAGEB
#undef PG8_LDA
#undef PG8_LDB
#undef PG8_MMA
#undef PG8_WAIT_V
#undef PG8_WAIT_L
#undef PG8_BAR
#undef PG8_SCHED
#undef PG8_KITER
}

template <class Epi, class Sched>
__device__ __forceinline__ void gemm_phase_b3(LAS unsigned char* lds, const Sched& S, const Epi& E) {
    const int tid = threadIdx.x, wid = __builtin_amdgcn_readfirstlane(tid >> 6), lane = tid & 63, wr = wid >> 2, wc = wid & 3, fr = lane & 15, fq = lane >> 4;
    const bool roleB = wc < 2; const int jr = wr * 2 + (wc & 1);
    int KB = S.KB; asm volatile("" : "+s"(KB));
    const int nt = KB / (BK * 2);
    constexpr int B_BASE = 5 * HTB, B_STAGE = 2 * HTB, BIAS_OFF = B_BASE + 2 * B_STAGE;
    const size_t kstep = (size_t)(BK * 2), hstep = (size_t)HALF * KB;
    const int aoff = lds_byte(wr * 64 + fr, fq * 8), boff = lds_byte(wc * 32 + fr, fq * 8);
    const unsigned pw = (unsigned)jr * 1024u;
    unsigned vs[8];
    LAS u32x4* park = (LAS u32x4*)(lds + BIAS_OFF + 2048) + tid;
#pragma unroll
    for (int i = 0; i < 4; ++i) { int R, C; stage_rc((jr + 4 * i) * 1024 + lane * 16, R, C); const int Rb = (R & ~31) + perm32(R & 31); vs[i] = (unsigned)(Rb * KB + 2 * C); vs[4 + i] = 0u; }
#define B3_STAGE4(ldsoff, gbase, v) do { _Pragma("unroll") for (int i_ = 0; i_ < 4; ++i_) \
        __builtin_amdgcn_global_load_lds((const unsigned*)((const char*)(gbase) + (v)[i_]), (LAS unsigned*)(lds + (ldsoff) + pw + 4096 * i_), 16, 0, 0); } while (0)
#define B3_LDA(dst, base) do { _Pragma("unroll") for (int m = 0; m < 4; ++m) { if constexpr (Sched::FP8) dst[m] = ld_frag8(lds + (base) + aoff + m * 2048); \
        else { _Pragma("unroll") for (int k = 0; k < 2; ++k) dst[m][k] = *(const LAS bf16x8*)(lds + (base) + aoff + m * 2048 + k * 1024); } } } while (0)
#define B3_LDB(dst, base) do { _Pragma("unroll") for (int n = 0; n < 2; ++n) { if constexpr (Sched::FP8) dst[n] = ld_frag8(lds + (base) + boff + n * 2048); \
        else { _Pragma("unroll") for (int k = 0; k < 2; ++k) dst[n][k] = *(const LAS bf16x8*)(lds + (base) + boff + n * 2048 + k * 1024); } } } while (0)
#define B3_MMA(ai, bj, At, Bt) do { __builtin_amdgcn_s_setprio(1); _Pragma("unroll") for (int m = 0; m < 4; ++m) _Pragma("unroll") for (int n = 0; n < 2; ++n) { \
        if constexpr (Sched::FP8) acc[ai][bj][m][n] = __builtin_amdgcn_mfma_scale_f32_16x16x128_f8f6f4(Bt[n], At[m], acc[ai][bj][m][n], 0, 0, 0, 0x7F7F7F7F, 0, 0x7F7F7F7F); \
        else { _Pragma("unroll") for (int k = 0; k < 2; ++k) acc[ai][bj][m][n] = __builtin_amdgcn_mfma_f32_16x16x32_bf16(Bt[n][k], At[m][k], acc[ai][bj][m][n], 0, 0, 0); } } \
        __builtin_amdgcn_s_setprio(0); } while (0)
#define B3_PIN(ai) do { _Pragma("unroll") for (int b_ = 0; b_ < 2; ++b_) _Pragma("unroll") for (int m_ = 0; m_ < 4; ++m_) \
        asm volatile("" : "+v"(acc[ai][b_][m_][0]), "+v"(acc[ai][b_][m_][1])); } while (0)
#define B3_WAIT_L0 asm volatile("s_waitcnt lgkmcnt(0)" ::: "memory")
#define B3_BAR __builtin_amdgcn_s_barrier()
#define B3_SCHED __builtin_amdgcn_sched_barrier(0)
    Unit cur, nxt; int ui = 0;
    if (!S.next(0, cur)) return;
    f32x4 acc[2][2][4][2];
#pragma unroll
    for (int a = 0; a < 2; ++a)
#pragma unroll
        for (int b = 0; b < 2; ++b)
#pragma unroll
            for (int m = 0; m < 4; ++m)
#pragma unroll
                for (int n = 0; n < 2; ++n) acc[a][b][m][n] = (f32x4){0.f, 0.f, 0.f, 0.f};
    typename FragT<Sched::FP8>::T At[4], B0[2], B1[2];
#define B3_ROWS(dst, U_) do { int tz_ = threadIdx.x; asm volatile("" : "+v"(tz_)); const int jr_ = ((tz_ >> 8) & 1) * 2 + ((tz_ >> 6) & 1), ln_ = tz_ & 63; \
        _Pragma("unroll") for (int h_ = 0; h_ < 2; ++h_) _Pragma("unroll") for (int i_ = 0; i_ < 4; i_ += 2) { int R0_, C0_, R1_, C1_; stage_rc((jr_ + 4 * i_) * 1024 + ln_ * 16, R0_, C0_); stage_rc((jr_ + 4 * i_ + 4) * 1024 + ln_ * 16, R1_, C1_); \
            dst[h_ * 2 + (i_ >> 1)] = (unsigned)S.a_row(U_, 128 * h_ + R0_) | ((unsigned)S.a_row(U_, 128 * h_ + R1_) << 16); } } while (0)
#define B3_UNPACK(srcp) do { int tz_ = threadIdx.x; asm volatile("" : "+v"(tz_)); const int jr_ = ((tz_ >> 8) & 1) * 2 + ((tz_ >> 6) & 1), ln_ = tz_ & 63; \
        _Pragma("unroll") for (int h_ = 0; h_ < 2; ++h_) _Pragma("unroll") for (int i_ = 0; i_ < 4; ++i_) { int R_, C_; stage_rc((jr_ + 4 * i_) * 1024 + ln_ * 16, R_, C_); \
            const unsigned rw_ = (srcp[h_ * 2 + (i_ >> 1)] >> ((i_ & 1) * 16)) & 0xffffu; vs[h_ * 4 + i_] = rw_ * (unsigned)S.ldab + 2u * (unsigned)C_; } } while (0)
    if (!roleB) { if constexpr (Sched::DEPWAIT) S.wait_ready(cur); unsigned vnp[4]; B3_ROWS(vnp, cur); B3_UNPACK(vnp); *park = (u32x4){vnp[0], vnp[1], vnp[2], vnp[3]}; }
    const char* cA = S.a_ptr(cur); const char* cB = S.b_ptr(cur);
    if constexpr (Epi::PREBIAS) { if (wid == 0) E.pre(cur, (LAS float*)(lds + BIAS_OFF), lane); }
    if (roleB) {
#pragma unroll
        for (int s = 0; s < 2; ++s) { B3_STAGE4(B_BASE + s * B_STAGE, cB + s * kstep, vs); B3_STAGE4(B_BASE + s * B_STAGE + HTB, cB + s * kstep + hstep, vs); }
    } else { B3_STAGE4(0, cA, vs); B3_STAGE4(HTB, cA, (vs + 4)); B3_STAGE4(2 * HTB, cA + kstep, vs); B3_STAGE4(3 * HTB, cA + kstep, (vs + 4)); }
    if (wr == 1) B3_BAR;
    asm volatile("s_waitcnt vmcnt(0)" ::: "memory"); B3_BAR; B3_BAR;
    int aL = 0, sB = 0;
    for (;;) {
        const bool has_next = S.next(ui + 1, nxt);
        const char* nA = has_next ? S.a_ptr(nxt) : cA; const char* nB = has_next ? S.b_ptr(nxt) : cB;
        if (has_next && !roleB) { unsigned vnp[4]; B3_ROWS(vnp, nxt); *park = (u32x4){vnp[0], vnp[1], vnp[2], vnp[3]}; }
        for (int t = 0; t < nt; ++t) {
            const bool lastt = (t == nt - 2);
            if constexpr (Epi::MIDHOOK) { if (t == nt / 2) { int tz = threadIdx.x; asm volatile("" : "+v"(tz)); const int we = tz >> 6, le = tz & 63; E.mid(acc, cur, we >> 2, we & 3, le & 15, le >> 4); } }
            if (lastt && !roleB) { if constexpr (Sched::DEPWAIT) { if (has_next) S.wait_ready(nxt); } const u32x4 pk = *park; const unsigned vnp[4] = {pk.x, pk.y, pk.z, pk.w}; B3_UNPACK(vnp); }
            const char* aSrc = (t + 2 < nt) ? cA + (size_t)(t + 2) * kstep : nA + (size_t)(t + 2 - nt) * kstep;
            const char* bSrc = (t + 2 < nt) ? cB + (size_t)(t + 2) * kstep : nB + (size_t)(t + 2 - nt) * kstep;
            const int aU = aL == 4 ? 0 : aL + 1, aN = aL == 0 ? 4 : aL - 1;
            const int bb = B_BASE + sB * B_STAGE;
            B3_LDB(B0, bb); B3_LDB(B1, bb + HTB); B3_SCHED; B3_LDA(At, aL * HTB);
            if (!roleB) { B3_STAGE4(aN * HTB, aSrc, vs); asm volatile("s_waitcnt vmcnt(12)" ::: "memory"); }
            B3_WAIT_L0; B3_BAR; B3_MMA(0, 0, At, B0); B3_MMA(0, 1, At, B1); B3_PIN(0); B3_BAR; B3_SCHED;
            B3_LDA(At, aU * HTB);
            if (!roleB) { B3_STAGE4(aL * HTB, aSrc, (vs + 4)); asm volatile("s_waitcnt vmcnt(12)" ::: "memory"); }
            else { B3_STAGE4(bb, bSrc, vs); B3_STAGE4(bb + HTB, bSrc + hstep, vs); asm volatile("s_waitcnt vmcnt(8)" ::: "memory"); }
            B3_WAIT_L0; B3_BAR; B3_MMA(1, 0, At, B0); B3_MMA(1, 1, At, B1); B3_PIN(1); B3_BAR; B3_SCHED;
            aL = aL >= 3 ? aL - 3 : aL + 2; sB ^= 1;
        }
        if (wr == 0) B3_BAR;
        { int tz = threadIdx.x; asm volatile("" : "+v"(tz)); const int we = tz >> 6, le = tz & 63;
          if constexpr (Epi::PREBIAS) E(acc, cur, we >> 2, we & 3, le & 15, le >> 4, (const LAS float*)(lds + BIAS_OFF + (ui & 1) * 1024)); else E(acc, cur, we >> 2, we & 3, le & 15, le >> 4); }
        if (!has_next) break;
#pragma unroll
        for (int a = 0; a < 2; ++a)
#pragma unroll
            for (int b = 0; b < 2; ++b)
#pragma unroll
                for (int m = 0; m < 4; ++m)
#pragma unroll
                    for (int n = 0; n < 2; ++n) acc[a][b][m][n] = (f32x4){0.f, 0.f, 0.f, 0.f};
        cur = nxt; cA = nA; cB = nB; ++ui;
        if constexpr (Epi::PREBIAS) { if (wid == 0) E.pre(cur, (LAS float*)(lds + BIAS_OFF + (ui & 1) * 1024), lane); }
        if (wr == 1) B3_BAR;
    }
    asm volatile("s_waitcnt vmcnt(0)" ::: "memory");
    B3_BAR;
#undef B3_STAGE4
#undef B3_LDA
#undef B3_LDB
#undef B3_MMA
#undef B3_WAIT_L0
#undef B3_PIN
#undef B3_BAR
#undef B3_SCHED
#undef B3_ROWS
#undef B3_UNPACK
}
}

namespace epi {
using pg8::Unit; using pg8::BM; using pg8::HALF;
typedef f32x4 Acc[2][2][4][2];
#define EPI_ROWS_COLS const int row0 = u.pm * BM + wr * 64 + fr, col0 = u.pn * BM + wc * 32 + 8 * fq
__device__ __forceinline__ u32x4 pack8(f32x4 v0, f32x4 v1) { u32x4 w; w.x = cvt_pk_bf16(v0[0], v0[1]); w.y = cvt_pk_bf16(v0[2], v0[3]); w.z = cvt_pk_bf16(v1[0], v1[1]); w.w = cvt_pk_bf16(v1[2], v1[3]); return w; }

struct Bf16Plain {
    static constexpr bool PREBIAS = false;
    static constexpr bool MIDHOOK = false;
    bf16_t* O; int ldc;
    __device__ __forceinline__ void operator()(const Acc& acc, const Unit& u, int wr, int wc, int fr, int fq) const {
        EPI_ROWS_COLS;
#pragma unroll
        for (int ai = 0; ai < 2; ++ai)
#pragma unroll
            for (int m = 0; m < 4; ++m) { bf16_t* rowp = O + (size_t)(row0 + ai * HALF + m * 16) * ldc + col0;
#pragma unroll
                for (int bj = 0; bj < 2; ++bj) *(u32x4*)(rowp + bj * HALF) = pack8(acc[ai][bj][m][0], acc[ai][bj][m][1]); }
    }
};
struct Bf16RowScale {
    static constexpr bool PREBIAS = false;
    static constexpr bool MIDHOOK = false;
    bf16_t* O; int ldc; const float* rs;
    __device__ __forceinline__ void operator()(const Acc& acc, const Unit& u, int wr, int wc, int fr, int fq) const {
        const int row0 = u.pm * BM + wr * 64 + fr, cin = wc * 32 + 8 * fq;
#pragma unroll
        for (int ai = 0; ai < 2; ++ai)
#pragma unroll
            for (int m = 0; m < 4; ++m) { const int row = row0 + ai * HALF + m * 16; const float sc = rs[row]; const int bb = row / SEQ, ss = row % SEQ;
                bf16_t* rowp = O + ((size_t)(bb * MLA_H + u.pn) * SEQ + ss) * 256 + cin;
#pragma unroll
                for (int bj = 0; bj < 2; ++bj) *(u32x4*)(rowp + bj * HALF) = pack8(acc[ai][bj][m][0] * sc, acc[ai][bj][m][1] * sc); }
    }
};
struct QRope {
    static constexpr bool PREBIAS = false;
    static constexpr bool MIDHOOK = false;
    bf16_t* O; const float* rs; const float* cs;
    __device__ __forceinline__ void operator()(const Acc& acc, const Unit& u, int wr, int wc, int fr, int fq) const {
        EPI_ROWS_COLS;
#pragma unroll
        for (int ai = 0; ai < 2; ++ai)
#pragma unroll
            for (int m = 0; m < 4; ++m) { const int row = row0 + ai * HALF + m * 16; const float s = rs[row]; bf16_t* rowp = O + (size_t)row * NQ + col0;
#pragma unroll
                for (int bj = 0; bj < 2; ++bj) {
                    f32x4 v0 = acc[ai][bj][m][0] * s, v1 = acc[ai][bj][m][1] * s;
                    const int c = col0 + bj * HALF, o = c % MLA_QK;
                    if (o >= MLA_NOPE) { const int i0 = (o - MLA_NOPE) >> 1; const f32x4* t = (const f32x4*)(cs + ((size_t)row * 32 + i0) * 2);
                        const f32x4 t0 = t[0], t1 = t[1];
                        f32x4 r0, r1;
                        r0[0] = v0[0] * t0[0] - v0[1] * t0[1]; r0[1] = v0[0] * t0[1] + v0[1] * t0[0];
                        r0[2] = v0[2] * t0[2] - v0[3] * t0[3]; r0[3] = v0[2] * t0[3] + v0[3] * t0[2];
                        r1[0] = v1[0] * t1[0] - v1[1] * t1[1]; r1[1] = v1[0] * t1[1] + v1[1] * t1[0];
                        r1[2] = v1[2] * t1[2] - v1[3] * t1[3]; r1[3] = v1[2] * t1[3] + v1[3] * t1[2];
                        v0 = r0; v1 = r1; }
                    *(u32x4*)(rowp + bj * HALF) = pack8(v0, v1); } }
    }
};
struct GateStoreF32 {
    static constexpr bool PREBIAS = false;
    static constexpr bool MIDHOOK = false;
    float* M1; const bf16_t* proj; int gcol;
    __device__ __forceinline__ void operator()(const Acc& acc, const Unit& u, int wr, int wc, int fr, int fq) const {
        EPI_ROWS_COLS;
#pragma unroll
        for (int ai = 0; ai < 2; ++ai)
#pragma unroll
            for (int m = 0; m < 4; ++m) { const int row = row0 + ai * HALF + m * 16;
#pragma unroll
                for (int bj = 0; bj < 2; ++bj) { const int c = col0 + bj * HALF;
                    const u32x4 g = *(const u32x4*)(proj + (size_t)row * DINP + gcol + c);
                    f32x4 s0 = {fast_sigmoid(bf_lo(g.x)), fast_sigmoid(bf_hi(g.x)), fast_sigmoid(bf_lo(g.y)), fast_sigmoid(bf_hi(g.y))};
                    f32x4 s1 = {fast_sigmoid(bf_lo(g.z)), fast_sigmoid(bf_hi(g.z)), fast_sigmoid(bf_lo(g.w)), fast_sigmoid(bf_hi(g.w))};
                    float* p = M1 + (size_t)row * DM + c;
                    *(f32x4*)p = acc[ai][bj][m][0] * s0; *(f32x4*)(p + 4) = acc[ai][bj][m][1] * s1; } }
    }
};
struct GateMergeBf16 {
    static constexpr bool PREBIAS = false;
    static constexpr bool MIDHOOK = false;
    bf16_t* O; const float* M1; const bf16_t* proj; int gcol;
    __device__ __forceinline__ void operator()(const Acc& acc, const Unit& u, int wr, int wc, int fr, int fq) const {
        EPI_ROWS_COLS;
#pragma unroll
        for (int ai = 0; ai < 2; ++ai)
#pragma unroll
            for (int m = 0; m < 4; ++m) { const int row = row0 + ai * HALF + m * 16;
#pragma unroll
                for (int bj = 0; bj < 2; ++bj) { const int c = col0 + bj * HALF;
                    const u32x4 g = *(const u32x4*)(proj + (size_t)row * DINP + gcol + c);
                    f32x4 s0 = {fast_sigmoid(bf_lo(g.x)), fast_sigmoid(bf_hi(g.x)), fast_sigmoid(bf_lo(g.y)), fast_sigmoid(bf_hi(g.y))};
                    f32x4 s1 = {fast_sigmoid(bf_lo(g.z)), fast_sigmoid(bf_hi(g.z)), fast_sigmoid(bf_lo(g.w)), fast_sigmoid(bf_hi(g.w))};
                    const float* p = M1 + (size_t)row * DM + c;
                    const f32x4 a0 = *(const f32x4*)p, a1 = *(const f32x4*)(p + 4);
                    *(u32x4*)(O + (size_t)row * DM + c) = pack8(a0 + acc[ai][bj][m][0] * s0, a1 + acc[ai][bj][m][1] * s1); } }
    }
};
struct GateMerge2 {
    static constexpr bool PREBIAS = false;
    static constexpr bool MIDHOOK = true;
    bf16_t* O; const bf16_t* proj;
    __device__ __forceinline__ void mid(Acc& acc, const Unit& u, int wr, int wc, int fr, int fq) const {
        EPI_ROWS_COLS;
#pragma unroll
        for (int ai = 0; ai < 2; ++ai)
#pragma unroll
            for (int m = 0; m < 4; ++m) { const int row = row0 + ai * HALF + m * 16;
#pragma unroll
                for (int bj = 0; bj < 2; ++bj) { const int c = col0 + bj * HALF;
                    const u32x4 ga = __builtin_nontemporal_load((const u32x4*)(proj + (size_t)row * DINP + C_GA + c)), gb = *(const u32x4*)(proj + (size_t)row * DINP + C_GB + c);
                    const float a[8] = {bf_lo(ga.x), bf_hi(ga.x), bf_lo(ga.y), bf_hi(ga.y), bf_lo(ga.z), bf_hi(ga.z), bf_lo(ga.w), bf_hi(ga.w)};
                    const float b[8] = {bf_lo(gb.x), bf_hi(gb.x), bf_lo(gb.y), bf_hi(gb.y), bf_lo(gb.z), bf_hi(gb.z), bf_lo(gb.w), bf_hi(gb.w)};
#pragma unroll
                    for (int j = 0; j < 8; ++j) { const float eb = __builtin_amdgcn_exp2f(-fmaxf(b[j], -30.0f) * 1.4426950408889634f);
                        const float q = (1.0f + eb) * fast_sigmoid(a[j]);
                        if (j < 4) acc[ai][bj][m][0][j] *= q; else acc[ai][bj][m][1][j - 4] *= q; } } }
    }
    __device__ __forceinline__ void operator()(const Acc& acc, const Unit& u, int wr, int wc, int fr, int fq) const {
        EPI_ROWS_COLS;
#pragma unroll
        for (int ai = 0; ai < 2; ++ai)
#pragma unroll
            for (int m = 0; m < 4; ++m) { const int row = row0 + ai * HALF + m * 16;
#pragma unroll
                for (int bj = 0; bj < 2; ++bj) { const int c = col0 + bj * HALF;
                    const u32x4 g = *(const u32x4*)(proj + (size_t)row * DINP + C_GB + c);
                    f32x4 s0 = {fast_sigmoid(fmaxf(bf_lo(g.x), -30.0f)), fast_sigmoid(fmaxf(bf_hi(g.x), -30.0f)), fast_sigmoid(fmaxf(bf_lo(g.y), -30.0f)), fast_sigmoid(fmaxf(bf_hi(g.y), -30.0f))};
                    f32x4 s1 = {fast_sigmoid(fmaxf(bf_lo(g.z), -30.0f)), fast_sigmoid(fmaxf(bf_hi(g.z), -30.0f)), fast_sigmoid(fmaxf(bf_lo(g.w), -30.0f)), fast_sigmoid(fmaxf(bf_hi(g.w), -30.0f))};
                    *(u32x4*)(O + (size_t)row * DM + c) = pack8(acc[ai][bj][m][0] * s0, acc[ai][bj][m][1] * s1); } }
    }
};
struct ResidGateF32 {
    static constexpr bool PREBIAS = false;
    static constexpr bool MIDHOOK = false;
    float* X1; const float* x; const float* gate;
    __device__ __forceinline__ void operator()(const Acc& acc, const Unit& u, int wr, int wc, int fr, int fq) const {
        EPI_ROWS_COLS;
        const float* gb = gate + (size_t)((u.pm * BM) / SEQ) * (6 * DM);
#pragma unroll
        for (int bj = 0; bj < 2; ++bj) { const int c = col0 + bj * HALF; const f32x4 g0 = *(const f32x4*)(gb + c), g1 = *(const f32x4*)(gb + c + 4);
#pragma unroll
            for (int ai = 0; ai < 2; ++ai)
#pragma unroll
                for (int m = 0; m < 4; ++m) { const int row = row0 + ai * HALF + m * 16; const float* xp = x + (size_t)row * DM + c; float* op = X1 + (size_t)row * DM + c;
                    const f32x4 x0 = __builtin_nontemporal_load((const f32x4*)xp), x1 = __builtin_nontemporal_load((const f32x4*)(xp + 4));
                    *(f32x4*)op = x0 + g0 * acc[ai][bj][m][0]; *(f32x4*)(op + 4) = x1 + g1 * acc[ai][bj][m][1]; } }
    }
};
struct SwiGlu {
    static constexpr bool MIDHOOK = false, PREBIAS = true;
    unsigned char* ACT; const float* b1;
    __device__ __forceinline__ void pre(const Unit& u, LAS float* dst, int lane) const {
        __builtin_amdgcn_global_load_lds((const unsigned*)(b1 + (size_t)u.aux * (2 * DEXP) + u.pn * BM + 4 * lane), (LAS unsigned*)dst, 16, 0, 0); }
    __device__ __forceinline__ void operator()(const Acc& acc, const Unit& u, int wr, int wc, int fr, int fq, const LAS float* bl) const {
        EPI_ROWS_COLS;
#pragma unroll
        for (int bj = 0; bj < 2; ++bj) { const int c = col0 + bj * HALF, cl = wc * 32 + 8 * fq + bj * HALF; const f32x4 bb0 = *(const LAS f32x4*)(bl + cl), bb1 = *(const LAS f32x4*)(bl + cl + 4);
#pragma unroll
            for (int ai = 0; ai < 2; ++ai)
#pragma unroll
                for (int m = 0; m < 4; ++m) { const int row = row0 + ai * HALF + m * 16;
                    const float un = 1.0f / (W8_SCALE * A8_SCALE);
                    const f32x4 v0 = acc[ai][bj][m][0] * un + bb0, v1 = acc[ai][bj][m][1] * un + bb1;
                    float o[4];
#pragma unroll
                    for (int p = 0; p < 4; ++p) { const float g = fminf(p < 2 ? v0[2 * p] : v1[2 * p - 4], 7.0f); float l = p < 2 ? v0[2 * p + 1] : v1[2 * p - 3]; l = fminf(fmaxf(l, -7.0f), 7.0f);
                        o[p] = g * fast_sigmoid(1.702f * g) * (l + 1.0f); }
                    *(unsigned*)(ACT + (size_t)row * DEXP + (c >> 1)) = pk4_fp8(o[0] * A8_SCALE, o[1] * A8_SCALE, o[2] * A8_SCALE, o[3] * A8_SCALE); } }
    }
};
struct BiasBf16 {
    static constexpr bool MIDHOOK = false, PREBIAS = true;
    unsigned char* Y; const float* b2;
    __device__ __forceinline__ void pre(const Unit& u, LAS float* dst, int lane) const {
        __builtin_amdgcn_global_load_lds((const unsigned*)(b2 + (size_t)u.aux * DM + u.pn * BM + 4 * lane), (LAS unsigned*)dst, 16, 0, 0); }
    __device__ __forceinline__ void operator()(const Acc& acc, const Unit& u, int wr, int wc, int fr, int fq, const LAS float* bl) const {
        EPI_ROWS_COLS;
#pragma unroll
        for (int bj = 0; bj < 2; ++bj) { const int c = col0 + bj * HALF, cl = wc * 32 + 8 * fq + bj * HALF; const f32x4 bb0 = *(const LAS f32x4*)(bl + cl) * Y8_SCALE, bb1 = *(const LAS f32x4*)(bl + cl + 4) * Y8_SCALE;
#pragma unroll
            for (int ai = 0; ai < 2; ++ai)
#pragma unroll
                for (int m = 0; m < 4; ++m) { const int row = row0 + ai * HALF + m * 16;
                    const float un = Y8_SCALE / (W8_SCALE * A8_SCALE);
                    const f32x4 v0 = acc[ai][bj][m][0] * un + bb0, v1 = acc[ai][bj][m][1] * un + bb1;
                    u32x2 w; w.x = pk4_fp8(v0[0], v0[1], v0[2], v0[3]); w.y = pk4_fp8(v1[0], v1[1], v1[2], v1[3]);
                    *(u32x2*)(Y + (size_t)row * DM + c) = w; } }
    }
};

struct MoeEpi {
    static constexpr bool MIDHOOK = false, PREBIAS = true;
    unsigned char* ACT; const float* b1; unsigned char* Y; const float* b2; unsigned* blk;
    __device__ __forceinline__ void pre(const Unit& u, LAS float* dst, int lane) const {
        const int e = u.aux & 255; const float* src = (u.aux >> 8) ? b2 + (size_t)e * DM + u.pn * BM + 4 * lane : b1 + (size_t)e * (2 * DEXP) + u.pn * BM + 4 * lane;
        __builtin_amdgcn_global_load_lds((const unsigned*)src, (LAS unsigned*)dst, 16, 0, 0); }
    __device__ __forceinline__ void operator()(const Acc& acc, const Unit& u, int wr, int wc, int fr, int fq, const LAS float* bl) const {
        EPI_ROWS_COLS;
        if ((u.aux >> 8) == 0) {
#pragma unroll
            for (int bj = 0; bj < 2; ++bj) { const int c = col0 + bj * HALF, cl = wc * 32 + 8 * fq + bj * HALF; const f32x4 bb0 = *(const LAS f32x4*)(bl + cl), bb1 = *(const LAS f32x4*)(bl + cl + 4);
#pragma unroll
                for (int ai = 0; ai < 2; ++ai)
#pragma unroll
                    for (int m = 0; m < 4; ++m) { const int row = row0 + ai * HALF + m * 16;
                        const float un = 1.0f / (W8_SCALE * A8_SCALE);
                        const f32x4 v0 = acc[ai][bj][m][0] * un + bb0, v1 = acc[ai][bj][m][1] * un + bb1;
                        float o[4];
#pragma unroll
                        for (int p = 0; p < 4; ++p) { const float g = fminf(p < 2 ? v0[2 * p] : v1[2 * p - 4], 7.0f); float l = p < 2 ? v0[2 * p + 1] : v1[2 * p - 3]; l = fminf(fmaxf(l, -7.0f), 7.0f);
                            o[p] = g * fast_sigmoid(1.702f * g) * (l + 1.0f); }
                        __hip_atomic_store((unsigned*)(ACT + (size_t)row * DEXP + (c >> 1)), pk4_fp8(o[0] * A8_SCALE, o[1] * A8_SCALE, o[2] * A8_SCALE, o[3] * A8_SCALE), __ATOMIC_RELAXED, __HIP_MEMORY_SCOPE_AGENT); } }
            asm volatile("s_waitcnt vmcnt(0)" ::: "memory");
            if (fr == 0 && fq == 0) __hip_atomic_fetch_add(blk + u.pm, 1u, __ATOMIC_RELAXED, __HIP_MEMORY_SCOPE_AGENT);
        } else {
#pragma unroll
            for (int bj = 0; bj < 2; ++bj) { const int c = col0 + bj * HALF, cl = wc * 32 + 8 * fq + bj * HALF; const f32x4 bb0 = *(const LAS f32x4*)(bl + cl) * Y8_SCALE, bb1 = *(const LAS f32x4*)(bl + cl + 4) * Y8_SCALE;
#pragma unroll
                for (int ai = 0; ai < 2; ++ai)
#pragma unroll
                    for (int m = 0; m < 4; ++m) { const int row = row0 + ai * HALF + m * 16;
                        const float un = Y8_SCALE / (W8_SCALE * A8_SCALE);
                        const f32x4 v0 = acc[ai][bj][m][0] * un + bb0, v1 = acc[ai][bj][m][1] * un + bb1;
                        u32x2 w; w.x = pk4_fp8(v0[0], v0[1], v0[2], v0[3]); w.y = pk4_fp8(v1[0], v1[1], v1[2], v1[3]);
                        *(u32x2*)(Y + (size_t)row * DM + c) = w; } }
        }
    }
};
#undef EPI_ROWS_COLS
}

constexpr size_t MiB = 1u << 20;
constexpr size_t WS_CTL = 0, CTL_ZERO_BYTES = 64 * 1024;
constexpr size_t WS_MOD = 512 * 1024;
constexpr size_t WS_FMOD = 640 * 1024;
constexpr size_t WS_RW = 1 * MiB + 256 * 1024;
constexpr size_t WS_RC = 1 * MiB + 768 * 1024;
constexpr size_t WS_RSQ = 1 * MiB + 800 * 1024;
constexpr size_t WS_RSKV = 1 * MiB + 832 * 1024;
constexpr size_t WS_CS = 2 * MiB;
constexpr size_t WS_TOPI = 4 * MiB;
constexpr size_t WS_TOPW = 4 * MiB + 256 * 1024;
constexpr size_t WS_ROWMAP = 5 * MiB;
constexpr size_t WS_DLAST = 6 * MiB;
constexpr size_t WS_KPE = 7 * MiB;
constexpr size_t WS_WQ = 8 * MiB, WS_WKV = 10 * MiB, WS_WOM = 12 * MiB, WS_WOUT = 20 * MiB, WS_WIN = 32 * MiB;
constexpr size_t WS_W1 = 64 * MiB, WS_W2 = 576 * MiB;
constexpr size_t WS_H = 832 * MiB;
constexpr size_t WS_PROJ = 864 * MiB;
constexpr size_t WS_Q = 992 * MiB, WS_KV = 1016 * MiB;
constexpr size_t WS_GCUM = 1048 * MiB;
constexpr size_t WS_UT = 1064 * MiB;
constexpr size_t WS_ST = 1128 * MiB;
constexpr size_t WS_ATTO = 1160 * MiB;
constexpr int BR_LD = 2048;
constexpr size_t WS_M1 = 1192 * MiB;
constexpr size_t WS_MERGED = 1256 * MiB;
constexpr size_t WS_X1 = 1288 * MiB;
constexpr size_t WS_ACT = 1352 * MiB;
constexpr size_t WS_Y = 2376 * MiB;
constexpr size_t WS_END = 3400 * MiB;
constexpr int CW_TMO = 0, CW_CODE = 1, CW_BAR = 4096, CW_CNT = 8192  , CW_GQ = 12288  , CW_GEMV = 12352  , CW_BLK = 13312  ;

constexpr int NWAVES = 8;
constexpr int RING_BYTES = 131072, LDSCTL_OFF = 161792, LDS_BYTES = 163840;
constexpr int LW_BAR = 0, LW_TMP = 4, LW_NBLK = 16, LW_USTART = 48, LW_CNT = 96, LW_UNITS = 192  ;

#define XB_TMO      128
#define XB_XCNT(j)  (256  + 64 * (j))
#define XB_XSUB(j)  (1280 + 64 * (j))
#define XB_XGEN(j)  (2304 + 64 * (j))
#define XB_TOP      3328
#define XB_TOPGEN   3392
#define XCD_BAR_WORDS 3456
#define XB_SPIN_CAP (1u << 18)
__device__ __forceinline__ unsigned xb_ld(unsigned* p)              { return __hip_atomic_load(p, __ATOMIC_RELAXED, __HIP_MEMORY_SCOPE_AGENT); }
__device__ __forceinline__ unsigned xb_add(unsigned* p, unsigned v) { return __hip_atomic_fetch_add(p, v, __ATOMIC_RELAXED, __HIP_MEMORY_SCOPE_AGENT); }
__device__ __forceinline__ unsigned xb_xcc_id() { return (unsigned)__builtin_amdgcn_s_getreg((3 << 11) | 20) & 0xFu; }
#define XB_SPIN(cond, bar) do { unsigned _sp = 0; while (cond) { __builtin_amdgcn_s_sleep(1); \
    if ((++_sp & 255u) == 0u) { if (xb_ld(&(bar)[XB_TMO])) break; if (_sp > XB_SPIN_CAP) { atomicAdd(&(bar)[XB_TMO], 1u); break; } } } } while (0)
struct XcdBarrier { unsigned* bar; unsigned x; volatile LAS unsigned* st; };
__device__ __forceinline__ XcdBarrier xcd_barrier_post(unsigned* bar, volatile LAS unsigned* st) {
    XcdBarrier b; b.bar = bar; b.x = xb_xcc_id(); b.st = st;
    if (threadIdx.x == 0) (void)xb_add(&bar[XB_XCNT(b.x)], 1u);
    return b;
}
__device__ __forceinline__ void xcd_barrier_complete(unsigned* bar, unsigned x, unsigned& nloc, unsigned& nx) {
    const unsigned G = gridDim.x * gridDim.y * gridDim.z;
    unsigned sum, cnt, mine, sp = 0u;
    for (;;) {
        sum = 0u; cnt = 0u; mine = 0u;
#pragma unroll
        for (unsigned j = 0; j < 16; ++j) { const unsigned c = xb_ld(&bar[XB_XCNT(j)]); sum += c; cnt += (c > 0u) ? 1u : 0u; mine = (j == x) ? c : mine; }
        if (sum == G) break;
        __builtin_amdgcn_s_sleep(1);
        if ((++sp & 255u) == 0u) { if (xb_ld(&bar[XB_TMO])) break; if (sp > XB_SPIN_CAP) { atomicAdd(&bar[XB_TMO], 1u); break; } }
    }
    nloc = mine > 0u ? mine : 1u; nx = cnt > 0u ? cnt : 1u;
}
__device__ __forceinline__ void xcd_barrier(const XcdBarrier& b) {
    asm volatile("s_waitcnt vmcnt(0)" ::: "memory");
    __syncthreads();
    if (threadIdx.x == 0) {
        unsigned* bar = b.bar;
        __builtin_amdgcn_s_waitcnt(0);
        unsigned nloc = b.st[0], nx = b.st[1];
        if (nloc == 0u) { xcd_barrier_complete(bar, b.x, nloc, nx); b.st[0] = nloc; b.st[1] = nx; }
        const unsigned old = xb_add(&bar[XB_XSUB(b.x)], 1u);
        const unsigned gen = old / nloc;
        if (old + 1u == (gen + 1u) * nloc) {
            __builtin_amdgcn_fence(__ATOMIC_RELEASE, "agent");
            asm volatile("s_waitcnt vmcnt(0)" ::: "memory");
            const unsigned og = xb_add(&bar[XB_TOP], 1u);
            const unsigned tg = og / nx;
            if (og + 1u == (tg + 1u) * nx) xb_add(&bar[XB_TOPGEN], 1u);
            else XB_SPIN(xb_ld(&bar[XB_TOPGEN]) == tg, bar);
            __builtin_amdgcn_fence(__ATOMIC_ACQUIRE, "agent");
            xb_add(&bar[XB_XGEN(b.x)], 1u);
            asm volatile("s_waitcnt vmcnt(0)" ::: "memory");
        } else {
            XB_SPIN(xb_ld(&bar[XB_XGEN(b.x)]) == gen, bar);
            __builtin_amdgcn_fence(__ATOMIC_ACQUIRE, "agent");
            asm volatile("s_waitcnt vmcnt(0)" ::: "memory");
        }
    }
    __syncthreads();
}

struct Frame {
    LAS unsigned char* lds;
    volatile LAS unsigned* LW;
    gu32* ctl;
    int tid, lane, wave, vcu, G;
    const float *x, *c; const int* pos;
    const float *w_ada, *b_ada, *norm_mix_w, *w_in, *q_norm_w, *w_q_b, *kv_norm_w, *w_kv_b, *w_gk_up, *b_gk_up, *gla_norm_w, *w_o_mla, *w_o_gla, *w_out, *norm_ffn_w, *w_router, *b_router,
        *w1, *b1, *w2, *b2, *w_ada_final, *b_ada_final, *norm_final_w;
    float* out;
    unsigned char* ws;
};
#define WSP(T, off) ((T*)(F.ws + (off)))

template <bool FP8>
__device__ __forceinline__ void p0_convert_item(const float* W, int K, int N, int nblk, void* WT, const float* kscale, LAS unsigned char* scr, int item, int lane, int ldk = 0, int koff = 0) {
    if (ldk == 0) ldk = K;
    constexpr int KT = FP8 ? 128 : 64, NG = KT / 16, PITCH = FP8 ? 132 : 136, EB = FP8 ? 1 : 2;
    const int kb = item / nblk, nb = item % nblk, k0 = KT * kb, n0 = 64 * nb, q = lane >> 4, n4 = lane & 15;
    const bool ok = n0 + 4 * n4 < N;
    const float* src = W + (size_t)(k0 + 4 * q) * N + n0 + 4 * n4;
#pragma unroll
    for (int gh = 0; gh < NG; gh += 4) {
        f32x4 v[4][4];
#pragma unroll
        for (int g = 0; g < 4; ++g)
#pragma unroll
            for (int r = 0; r < 4; ++r) v[g][r] = ok ? __builtin_nontemporal_load((const f32x4*)(src + (size_t)(16 * (gh + g) + r) * N)) : (f32x4){0.f, 0.f, 0.f, 0.f};
#pragma unroll
        for (int g = 0; g < 4; ++g) {
            if (kscale) {
#pragma unroll
                for (int r = 0; r < 4; ++r) v[g][r] = v[g][r] * kscale[k0 + 16 * (gh + g) + 4 * q + r]; }
#pragma unroll
            for (int c = 0; c < 4; ++c) { LAS unsigned char* p = scr + (4 * n4 + c) * PITCH + (16 * (gh + g) + 4 * q) * EB;
                if constexpr (FP8) *(LAS unsigned*)p = pk4_fp8(v[g][0][c] * W8_SCALE, v[g][1][c] * W8_SCALE, v[g][2][c] * W8_SCALE, v[g][3][c] * W8_SCALE);
                else { u32x2 w; w.x = cvt_pk_bf16(v[g][0][c], v[g][1][c]); w.y = cvt_pk_bf16(v[g][2][c], v[g][3][c]); *(LAS u32x2*)p = w; } }
        }
    }
    LDS_WAIT(); asm volatile("" ::: "memory");
#pragma unroll
    for (int i = 0; i < 8; ++i) { const int row = i * 8 + (lane >> 3), ch = lane & 7; const LAS unsigned* p = (const LAS unsigned*)(scr + row * PITCH + ch * 16);
        u32x4 o; o.x = p[0]; o.y = p[1]; o.z = p[2]; o.w = p[3];
        u32x4* dstp = (u32x4*)((unsigned char*)WT + ((size_t)(n0 + row) * ldk + koff + k0) * EB + ch * 16);
        if constexpr (FP8) __builtin_nontemporal_store(o, dstp); else *dstp = o; }
    LDS_WAIT(); asm volatile("" ::: "memory");
}
__device__ __forceinline__ void p0_prologue(Frame& F) {
    {
        LAS float* cond = (LAS float*)F.lds;
        LAS float* part = (LAS float*)(F.lds + 16384);
        for (int i = F.tid; i < NB * DM; i += NWAVES * 64) { const float v = F.c[i]; cond[i] = v * fast_sigmoid(v); }
        __syncthreads();
        for (int cg = F.vcu; cg < 256; cg += F.G) {
            const bool fin = cg >= 192; const float* W = fin ? F.w_ada_final : F.w_ada; const int N = fin ? 2 * DM : 6 * DM; const int col = (fin ? cg - 192 : cg) * 64 + F.lane;
            float a0 = 0.f, a1 = 0.f; const int kbeg = F.wave * 256;
            const float* wp = W + (size_t)kbeg * N + col;
            for (int kk = 0; kk < 256; kk += 32) { float w[32];
#pragma unroll
                for (int k = 0; k < 32; ++k) w[k] = __builtin_nontemporal_load(wp + (size_t)(kk + k) * N);
#pragma unroll
                for (int k = 0; k < 32; ++k) { a0 += cond[kbeg + kk + k] * w[k]; a1 += cond[DM + kbeg + kk + k] * w[k]; } }
            part[(F.wave * 2 + 0) * 64 + F.lane] = a0; part[(F.wave * 2 + 1) * 64 + F.lane] = a1;
            __syncthreads();
            if (F.tid < 128) { const int b = F.tid >> 6, l = F.tid & 63; float sres = 0.f;
#pragma unroll
                for (int w = 0; w < 8; ++w) sres += part[(w * 2 + b) * 64 + l];
                const int cc = (fin ? cg - 192 : cg) * 64 + l;
                if (fin) __hip_atomic_store(WSP(float, WS_FMOD) + b * (2 * DM) + cc, sres + F.b_ada_final[cc], RLX_AGENT); else __hip_atomic_store(WSP(float, WS_MOD) + b * (6 * DM) + cc, sres + F.b_ada[cc], RLX_AGENT); }
            asm volatile("s_waitcnt vmcnt(0)" ::: "memory");
            __syncthreads();
            if (F.tid == 0) __hip_atomic_fetch_add((unsigned*)(F.ctl + CW_GEMV), 1u, RLX_AGENT);
        }
    }
    {
        float* cs = WSP(float, WS_CS);
        for (int g = F.vcu * (NWAVES * 64) + F.tid; g < NTOK * 32; g += F.G * NWAVES * 64) {
            const int tok = g >> 5, i = g & 31;
            const float inv = powf(10000.0f, -(float)(2 * i) / 64.0f);
            const float ang = (float)F.pos[tok] * inv;
            const double r = (double)ang - 6.283185307179586 * rint((double)ang * 0.15915494309189535);
            const float rf = (float)r;
            cs[2 * g] = cosf(rf); cs[2 * g + 1] = sinf(rf);
        }
    }
    LAS unsigned char* scr = F.lds + F.wave * 16384;
    const int gw = F.vcu * NWAVES + F.wave, NGW = F.G * NWAVES;
    constexpr int I_IN = (DM / 64) * (DINP / 64), I_Q = (MLA_QR / 64) * (NQ / 64), I_KV = (MLA_KVR / 64) * (NKV / 64), I_OM = (1024 / 64) * (DM / 64), I_OG = I_OM, I_OUT = (DM / 64) * (DM / 64),
                  I_W1E = (DM / 128) * (2 * DEXP / 64), I_W2E = (DEXP / 128) * (DM / 64);
    constexpr int NITEMS = I_IN + I_Q + I_KV + I_OM + I_OG + I_OUT;
    (void)I_W1E; (void)I_W2E;
    for (int it = gw; it < NITEMS; it += NGW) {
        int r = it;
        if (r < I_IN) { p0_convert_item<false>(F.w_in, DM, DIN, DINP / 64, WSP(bf16_t, WS_WIN), nullptr, scr, r, F.lane); continue; } r -= I_IN;
        if (r < I_Q) { p0_convert_item<false>(F.w_q_b, MLA_QR, NQ, NQ / 64, WSP(bf16_t, WS_WQ), F.q_norm_w, scr, r, F.lane); continue; } r -= I_Q;
        if (r < I_KV) { p0_convert_item<false>(F.w_kv_b, MLA_KVR, NKV, NKV / 64, WSP(bf16_t, WS_WKV), F.kv_norm_w, scr, r, F.lane); continue; } r -= I_KV;
        if (r < I_OM) { p0_convert_item<false>(F.w_o_mla, 1024, DM, DM / 64, WSP(bf16_t, WS_WOM), nullptr, scr, r, F.lane, 2048, 0); continue; } r -= I_OM;
        if (r < I_OG) { p0_convert_item<false>(F.w_o_gla, 1024, DM, DM / 64, WSP(bf16_t, WS_WOM), nullptr, scr, r, F.lane, 2048, 1024); continue; } r -= I_OG;
        p0_convert_item<false>(F.w_out, DM, DM, DM / 64, WSP(bf16_t, WS_WOUT), nullptr, scr, r, F.lane);
    }
}
__device__ __forceinline__ void moe_convert(Frame& F, int cc, int ncv) {
    LAS unsigned char* scr = F.lds + F.wave * 16384;
    const int gw = cc * NWAVES + F.wave, NGW = ncv * NWAVES;
    constexpr int I_W1E = (DM / 128) * (2 * DEXP / 64), I_W2E = (DEXP / 128) * (DM / 64);
    for (int it = gw; it < NEXP * (I_W1E + I_W2E); it += NGW) {
        int r = it;
        if (r < NEXP * I_W1E) { const int e = r / I_W1E; p0_convert_item<true>(F.w1 + (size_t)e * DM * 2 * DEXP, DM, 2 * DEXP, 2 * DEXP / 64, WSP(unsigned char, WS_W1) + (size_t)e * 2 * DEXP * DM, nullptr, scr, r % I_W1E, F.lane); continue; } r -= NEXP * I_W1E;
        { const int e = r / I_W2E; p0_convert_item<true>(F.w2 + (size_t)e * DEXP * DM, DEXP, DM, DM / 64, WSP(unsigned char, WS_W2) + (size_t)e * DM * DEXP, nullptr, scr, r % I_W2E, F.lane); }
    }
}
__device__ __forceinline__ void wait_gemv(Frame& F) {
    if (F.tid == 0) { unsigned sp = 0;
        while (__hip_atomic_load((unsigned*)(F.ctl + CW_GEMV), RLX_AGENT) < 256u) { __builtin_amdgcn_s_sleep(2);
            if ((++sp & 255u) == 0u) { if (__hip_atomic_load((unsigned*)(F.ctl + CW_TMO), RLX_AGENT)) break; if (sp > (1u << 22)) { __hip_atomic_store((unsigned*)(F.ctl + CW_TMO), 1u, RLX_AGENT); break; } } }
        __builtin_amdgcn_fence(__ATOMIC_ACQUIRE, "agent");
        asm volatile("s_waitcnt vmcnt(0)" ::: "memory"); }
    __syncthreads();
}

template <bool FP8 = false>
__device__ __forceinline__ void norm_mod_row_bf16(const float* xrow, const float* gain, const float* shift, const float* scale, bf16_t* orow, int lane) {
    const f32x4* xr = (const f32x4*)xrow + lane;
    f32x4 v[8]; float s = 0.f;
#pragma unroll
    for (int j = 0; j < 8; ++j) { v[j] = FP8 ? xr[64 * j] : __builtin_nontemporal_load(xr + 64 * j); s += (v[j].x * v[j].x + v[j].y * v[j].y) + (v[j].z * v[j].z + v[j].w * v[j].w); }
    const float rs = 1.0f / sqrtf(wave_sum(s) * (1.0f / DM) + EPS);
#pragma unroll
    for (int j = 0; j < 8; ++j) { const int c = 4 * lane + 256 * j; const f32x4 g = *(const f32x4*)(gain + c), sc = *(const f32x4*)(scale + c), sh = *(const f32x4*)(shift + c);
        const f32x4 o = v[j] * rs * g * (sc + 1.0f) + sh;
        if constexpr (FP8) { *(unsigned*)((unsigned char*)orow + c) = pk4_fp8(o.x * A8_SCALE, o.y * A8_SCALE, o.z * A8_SCALE, o.w * A8_SCALE); }
        else { u32x2 w; w.x = cvt_pk_bf16(o.x, o.y); w.y = cvt_pk_bf16(o.z, o.w); *(u32x2*)(orow + c) = w; } }
}
__device__ __forceinline__ void p1_norm(Frame& F) {
    const int gw = F.vcu * NWAVES + F.wave, NGW = F.G * NWAVES;
    const float* mod = WSP(float, WS_MOD);
    for (int m = gw; m < NTOK; m += NGW) { const int b = m / SEQ;
        norm_mod_row_bf16(F.x + (size_t)m * DM, F.norm_mix_w, mod + b * 6 * DM + 0 * DM, mod + b * 6 * DM + 1 * DM, WSP(bf16_t, WS_H) + (size_t)m * DM, F.lane); }
    float* RW = WSP(float, WS_RW); float* RC = WSP(float, WS_RC);
    for (int g = F.vcu * (NWAVES * 64) + F.tid; g < NB * DM * NEXP; g += F.G * NWAVES * 64) { const int b = g / (DM * NEXP), k = (g / NEXP) % DM;
        RW[g] = F.norm_ffn_w[k] * (1.0f + mod[b * 6 * DM + 4 * DM + k]) * F.w_router[g % (DM * NEXP)]; }
    if (gw < NB * NEXP) { const int b = gw / NEXP, e = gw % NEXP; float s = 0.f;
        for (int k = F.lane; k < DM; k += 64) s += mod[b * 6 * DM + 3 * DM + k] * F.w_router[k * NEXP + e];
        s = wave_sum(s); if (F.lane == 0) RC[b * NEXP + e] = s + F.b_router[e]; }
}

__device__ __forceinline__ void p3_rows(Frame& F) {
    const int gw = F.vcu * NWAVES + F.wave, NGW = F.G * NWAVES;
    const bf16_t* proj = WSP(bf16_t, WS_PROJ); const float* cs = WSP(float, WS_CS);
    for (int m = gw; m < NTOK; m += NGW) { const bf16_t* pr = proj + (size_t)m * DINP;
        { const u32x4 w = *(const u32x4*)(pr + C_QLAT + 8 * F.lane);
          float s = bf_lo(w.x) * bf_lo(w.x) + bf_hi(w.x) * bf_hi(w.x) + bf_lo(w.y) * bf_lo(w.y) + bf_hi(w.y) * bf_hi(w.y) + bf_lo(w.z) * bf_lo(w.z) + bf_hi(w.z) * bf_hi(w.z) + bf_lo(w.w) * bf_lo(w.w) + bf_hi(w.w) * bf_hi(w.w);
          s = wave_sum(s); if (F.lane == 0) WSP(float, WS_RSQ)[m] = 1.0f / sqrtf(s * (1.0f / MLA_QR) + EPS); }
        { float s = 0.f;
          if (F.lane < 32) { const u32x4 w = *(const u32x4*)(pr + C_CKV + 8 * F.lane);
              s = bf_lo(w.x) * bf_lo(w.x) + bf_hi(w.x) * bf_hi(w.x) + bf_lo(w.y) * bf_lo(w.y) + bf_hi(w.y) * bf_hi(w.y) + bf_lo(w.z) * bf_lo(w.z) + bf_hi(w.z) * bf_hi(w.z) + bf_lo(w.w) * bf_lo(w.w) + bf_hi(w.w) * bf_hi(w.w); }
          s = wave_sum(s); if (F.lane == 0) WSP(float, WS_RSKV)[m] = 1.0f / sqrtf(s * (1.0f / MLA_KVR) + EPS); }
        if (F.lane < 32) { const unsigned w = *(const unsigned*)(pr + C_KPE + 2 * F.lane); const float re = bf_lo(w), im = bf_hi(w);
            const f32x2 t = *(const f32x2*)(cs + ((size_t)m * 32 + F.lane) * 2);
            *(unsigned*)(WSP(bf16_t, WS_KPE) + (size_t)m * MLA_ROPE + 2 * F.lane) = cvt_pk_bf16(re * t.x - im * t.y, re * t.y + im * t.x); }
    }
}

#define MFMA16(a, b, c) __builtin_amdgcn_mfma_f32_16x16x32_bf16((a), (b), (c), 0, 0, 0)
__device__ __forceinline__ void gla_stage_vt(Frame& F, LAS unsigned char* VT, const bf16_t* proj, int t0, int h) {
#pragma unroll
    for (int it = 0; it < 4; ++it) { const int idx = F.tid + it * 512, j = idx >> 5, v8 = (idx & 31) * 8;
        const u32x4 w = *(const u32x4*)(proj + (size_t)(t0 + j) * DINP + C_GV + h * GLA_DV + v8);
        LAS unsigned char* p = VT + v8 * 144 + j * 2;
        *(LAS bf16_t*)(p + 0 * 144) = (bf16_t)(w.x & 0xffffu); *(LAS bf16_t*)(p + 1 * 144) = (bf16_t)(w.x >> 16);
        *(LAS bf16_t*)(p + 2 * 144) = (bf16_t)(w.y & 0xffffu); *(LAS bf16_t*)(p + 3 * 144) = (bf16_t)(w.y >> 16);
        *(LAS bf16_t*)(p + 4 * 144) = (bf16_t)(w.z & 0xffffu); *(LAS bf16_t*)(p + 5 * 144) = (bf16_t)(w.z >> 16);
        *(LAS bf16_t*)(p + 6 * 144) = (bf16_t)(w.w & 0xffffu); *(LAS bf16_t*)(p + 7 * 144) = (bf16_t)(w.w >> 16); }
}
__device__ __forceinline__ void gla_pass1_unit(Frame& F, int u) {
    const int b = u >> 8, h = (u >> 6) & 3, n = u & 63, t0 = b * SEQ + n * GLA_C;
    LAS unsigned char* L = F.lds;
    LAS float* GZ = (LAS float*)(L + 0); LAS float* WG = (LAS float*)(L + 4096); LAS float* BG = (LAS float*)(L + 12288); LAS float* QS = (LAS float*)(L + 12800);
    LAS unsigned char* KDT = L + 16384; LAS unsigned char* VT = L + 36864;
    const bf16_t* proj = WSP(bf16_t, WS_PROJ);
    if (F.tid < 128) { const int row = F.tid >> 1, half = F.tid & 1; const u32x4 w = *(const u32x4*)(proj + (size_t)(t0 + row) * DINP + C_GLR + half * 8);
        LAS float* g = GZ + row * 16 + half * 8; g[0] = bf_lo(w.x); g[1] = bf_hi(w.x); g[2] = bf_lo(w.y); g[3] = bf_hi(w.y); g[4] = bf_lo(w.z); g[5] = bf_hi(w.z); g[6] = bf_lo(w.w); g[7] = bf_hi(w.w); }
    { const int r = F.tid >> 5, c = (F.tid & 31) * 4; *(LAS f32x4*)(WG + r * 128 + c) = *(const f32x4*)(F.w_gk_up + r * (GLA_H * GLA_DK) + h * GLA_DK + c); }
    if (F.tid < 128) BG[F.tid] = F.b_gk_up[h * GLA_DK + F.tid];
    gla_stage_vt(F, VT, proj, t0, h);
    __syncthreads();
    const int d = F.tid & 127, qtr = F.tid >> 7;
    float bq[16];
    { float wg[16];
#pragma unroll
      for (int r = 0; r < 16; ++r) wg[r] = WG[r * 128 + d];
      const float bias = BG[d]; float run = 0.f;
#pragma unroll
      for (int i = 0; i < 16; ++i) { const LAS float* gz = GZ + (qtr * 16 + i) * 16; float z = bias;
#pragma unroll
          for (int r = 0; r < 16; ++r) z += gz[r] * wg[r];
          const float ls = fminf(z, 0.f) - __logf(1.0f + __expf(-fabsf(z)));
          run += ls * (1.0f / 16.0f); bq[i] = run; }
      QS[qtr * 128 + d] = run; }
    __syncthreads();
    float off = 0.f, blast = 0.f;
#pragma unroll
    for (int q = 0; q < 4; ++q) { const float s = QS[q * 128 + d]; blast += s; if (q < qtr) off += s; }
    float* gc = WSP(float, WS_GCUM) + (size_t)(t0 + qtr * 16) * (GLA_H * GLA_DK) + h * GLA_DK + d;
    const bf16_t* kp = proj + (size_t)(t0 + qtr * 16) * DINP + C_GK + h * GLA_DK + d;
    float kd[16];
#pragma unroll
    for (int i = 0; i < 16; ++i) { bq[i] += off; gc[(size_t)i * (GLA_H * GLA_DK)] = bq[i]; kd[i] = bf2f(kp[(size_t)i * DINP]) * __expf(blast - bq[i]); }
    { u32x4 w0, w1; w0.x = cvt_pk_bf16(kd[0], kd[1]); w0.y = cvt_pk_bf16(kd[2], kd[3]); w0.z = cvt_pk_bf16(kd[4], kd[5]); w0.w = cvt_pk_bf16(kd[6], kd[7]);
      w1.x = cvt_pk_bf16(kd[8], kd[9]); w1.y = cvt_pk_bf16(kd[10], kd[11]); w1.z = cvt_pk_bf16(kd[12], kd[13]); w1.w = cvt_pk_bf16(kd[14], kd[15]);
      *(LAS u32x4*)(KDT + d * 144 + qtr * 32) = w0; *(LAS u32x4*)(KDT + d * 144 + qtr * 32 + 16) = w1; }
    if (qtr == 0) WSP(float, WS_DLAST)[u * GLA_DK + d] = __expf(blast);
    __syncthreads();
    const int l15 = F.lane & 15, quad = F.lane >> 4, w = F.wave;
    f32x4 acc[2][8];
#pragma unroll
    for (int mt = 0; mt < 2; ++mt)
#pragma unroll
        for (int nt = 0; nt < 8; ++nt) acc[mt][nt] = (f32x4){0.f, 0.f, 0.f, 0.f};
#pragma unroll
    for (int ks = 0; ks < 2; ++ks) { bf16x8 xf[2];
#pragma unroll
        for (int mt = 0; mt < 2; ++mt) xf[mt] = *(const LAS bf16x8*)(VT + (w * 32 + mt * 16 + l15) * 144 + (ks * 32 + quad * 8) * 2);
#pragma unroll
        for (int nt = 0; nt < 8; ++nt) { const bf16x8 yf = *(const LAS bf16x8*)(KDT + (nt * 16 + l15) * 144 + (ks * 32 + quad * 8) * 2);
#pragma unroll
            for (int mt = 0; mt < 2; ++mt) acc[mt][nt] = MFMA16(yf, xf[mt], acc[mt][nt]); } }
    bf16_t* UT = WSP(bf16_t, WS_UT) + (size_t)u * (GLA_DV * GLA_DK);
#pragma unroll
    for (int mt = 0; mt < 2; ++mt)
#pragma unroll
        for (int nt = 0; nt < 8; ++nt) { u32x2 w2; w2.x = cvt_pk_bf16(acc[mt][nt][0], acc[mt][nt][1]); w2.y = cvt_pk_bf16(acc[mt][nt][2], acc[mt][nt][3]);
            *(u32x2*)(UT + (size_t)(w * 32 + mt * 16 + l15) * GLA_DK + nt * 16 + quad * 4) = w2; }
    __syncthreads();
}
__device__ __forceinline__ void gla_pass2(Frame& F) {
    const bf16_t* UT = WSP(bf16_t, WS_UT); const float* DL = WSP(float, WS_DLAST); bf16_t* ST = WSP(bf16_t, WS_ST);
    for (int g = F.vcu * (NWAVES * 64) + F.tid; g < NB * GLA_H * GLA_DV * (GLA_DK / 2); g += F.G * NWAVES * 64) {
        const int bh = g >> 14, rem = g & 16383, v = rem >> 6, d2 = (rem & 63) * 2;
        f32x2 S = {0.f, 0.f};
#pragma unroll 16
        for (int n = 0; n < GLA_NCH; ++n) { const int u = bh * GLA_NCH + n; const size_t e = ((size_t)u * GLA_DV + v) * GLA_DK + d2;
            *(unsigned*)(ST + e) = cvt_pk_bf16(S.x, S.y);
            const unsigned uw = __builtin_nontemporal_load((const unsigned*)(UT + e)); const f32x2 U = {bf_lo(uw), bf_hi(uw)}, dl = *(const f32x2*)(DL + u * GLA_DK + d2);
            S = S * dl + U; }
    }
}
__device__ __forceinline__ void gla_pass3_unit(Frame& F, int u) {
    const int b = u >> 8, h = (u >> 6) & 3, n = u & 63, t0 = b * SEQ + n * GLA_C;
    LAS unsigned char* L = F.lds;
    LAS unsigned char* QD = L; LAS unsigned char* KD2 = L + 17408; LAS unsigned char* P = L + 34816; LAS unsigned char* VT = L + 44032; LAS float* RED = (LAS float*)(L + 80896);
    const bf16_t* proj = WSP(bf16_t, WS_PROJ); const float* gcum = WSP(float, WS_GCUM);
#pragma unroll
    for (int it = 0; it < 2; ++it) { const int idx = F.tid + it * 512, i = idx >> 4, d8 = (idx & 15) * 8;
        const u32x4 qw = *(const u32x4*)(proj + (size_t)(t0 + i) * DINP + C_GQ + h * GLA_DK + d8), kw = *(const u32x4*)(proj + (size_t)(t0 + i) * DINP + C_GK + h * GLA_DK + d8);
        const float* bp = gcum + (size_t)(t0 + i) * (GLA_H * GLA_DK) + h * GLA_DK + d8; const f32x4 b0 = *(const f32x4*)bp, b1 = *(const f32x4*)(bp + 4);
        const float sc = 0.08838834764831845f;
        float q[8] = {bf_lo(qw.x), bf_hi(qw.x), bf_lo(qw.y), bf_hi(qw.y), bf_lo(qw.z), bf_hi(qw.z), bf_lo(qw.w), bf_hi(qw.w)};
        float k[8] = {bf_lo(kw.x), bf_hi(kw.x), bf_lo(kw.y), bf_hi(kw.y), bf_lo(kw.z), bf_hi(kw.z), bf_lo(kw.w), bf_hi(kw.w)};
        float bb[8] = {b0.x, b0.y, b0.z, b0.w, b1.x, b1.y, b1.z, b1.w};
#pragma unroll
        for (int j = 0; j < 8; ++j) { q[j] *= sc * __expf(bb[j]); k[j] *= __expf(-bb[j]); }
        u32x4 qo, ko; qo.x = cvt_pk_bf16(q[0], q[1]); qo.y = cvt_pk_bf16(q[2], q[3]); qo.z = cvt_pk_bf16(q[4], q[5]); qo.w = cvt_pk_bf16(q[6], q[7]);
        ko.x = cvt_pk_bf16(k[0], k[1]); ko.y = cvt_pk_bf16(k[2], k[3]); ko.z = cvt_pk_bf16(k[4], k[5]); ko.w = cvt_pk_bf16(k[6], k[7]);
        *(LAS u32x4*)(QD + i * 272 + d8 * 2) = qo; *(LAS u32x4*)(KD2 + i * 272 + d8 * 2) = ko; }
    gla_stage_vt(F, VT, proj, t0, h);
    const int l15 = F.lane & 15, quad = F.lane >> 4, w = F.wave;
    const bf16_t* STu = WSP(bf16_t, WS_ST) + (size_t)u * (GLA_DV * GLA_DK);
    bf16x8 stf[4][2]; u32x2 gwf[4][2]; f32x4 nwf[2];
#pragma unroll
    for (int ks = 0; ks < 4; ++ks)
#pragma unroll
        for (int n2 = 0; n2 < 2; ++n2) stf[ks][n2] = *(const bf16x8*)(STu + (size_t)(w * 32 + n2 * 16 + l15) * GLA_DK + ks * 32 + quad * 8);
#pragma unroll
    for (int n2 = 0; n2 < 2; ++n2) { const int v0 = w * 32 + n2 * 16 + quad * 4; nwf[n2] = *(const f32x4*)(F.gla_norm_w + v0);
#pragma unroll
        for (int mt = 0; mt < 4; ++mt) gwf[mt][n2] = *(const u32x2*)(proj + (size_t)(t0 + mt * 16 + l15) * DINP + C_GOUT + h * GLA_DV + v0); }
    __syncthreads();
    { const int mt = w >> 1;
#pragma unroll
      for (int q2 = 0; q2 < 2; ++q2) { const int nt = (w & 1) * 2 + q2; f32x4 a = {0.f, 0.f, 0.f, 0.f};
          if (nt <= mt) {
#pragma unroll
              for (int ks = 0; ks < 4; ++ks) { const bf16x8 xf = *(const LAS bf16x8*)(QD + (mt * 16 + l15) * 272 + (ks * 32 + quad * 8) * 2), yf = *(const LAS bf16x8*)(KD2 + (nt * 16 + l15) * 272 + (ks * 32 + quad * 8) * 2);
                  a = MFMA16(yf, xf, a); } }
          const int i = mt * 16 + l15, j0 = nt * 16 + quad * 4;
          u32x2 pw; pw.x = cvt_pk_bf16(j0 + 0 <= i ? a[0] : 0.f, j0 + 1 <= i ? a[1] : 0.f); pw.y = cvt_pk_bf16(j0 + 2 <= i ? a[2] : 0.f, j0 + 3 <= i ? a[3] : 0.f);
          *(LAS u32x2*)(P + i * 144 + j0 * 2) = pw; } }
    __syncthreads();
    f32x4 acc[4][2];
#pragma unroll
    for (int mt = 0; mt < 4; ++mt) { acc[mt][0] = (f32x4){0.f, 0.f, 0.f, 0.f}; acc[mt][1] = (f32x4){0.f, 0.f, 0.f, 0.f}; }
#pragma unroll
    for (int ks = 0; ks < 4; ++ks) {
#pragma unroll
        for (int mt = 0; mt < 4; ++mt) { const bf16x8 xf = *(const LAS bf16x8*)(QD + (mt * 16 + l15) * 272 + (ks * 32 + quad * 8) * 2);
            acc[mt][0] = MFMA16(stf[ks][0], xf, acc[mt][0]); acc[mt][1] = MFMA16(stf[ks][1], xf, acc[mt][1]); } }
#pragma unroll
    for (int ks = 0; ks < 2; ++ks) { bf16x8 yf[2];
#pragma unroll
        for (int n2 = 0; n2 < 2; ++n2) yf[n2] = *(const LAS bf16x8*)(VT + (w * 32 + n2 * 16 + l15) * 144 + (ks * 32 + quad * 8) * 2);
#pragma unroll
        for (int mt = 0; mt < 4; ++mt) { const bf16x8 xf = *(const LAS bf16x8*)(P + (mt * 16 + l15) * 144 + (ks * 32 + quad * 8) * 2);
            acc[mt][0] = MFMA16(yf[0], xf, acc[mt][0]); acc[mt][1] = MFMA16(yf[1], xf, acc[mt][1]); } }
#pragma unroll
    for (int mt = 0; mt < 4; ++mt) { float ss = 0.f;
#pragma unroll
        for (int n2 = 0; n2 < 2; ++n2)
#pragma unroll
            for (int r = 0; r < 4; ++r) ss += acc[mt][n2][r] * acc[mt][n2][r];
        ss += __shfl_xor(ss, 16); ss += __shfl_xor(ss, 32);
        if (quad == 0) RED[w * 64 + mt * 16 + l15] = ss; }
    __syncthreads();
    bf16_t* GO = WSP(bf16_t, WS_ATTO) + MLA_H * MLA_V;
#pragma unroll
    for (int mt = 0; mt < 4; ++mt) { const int i = mt * 16 + l15; float tot = 0.f;
#pragma unroll
        for (int ww = 0; ww < 8; ++ww) tot += RED[ww * 64 + i];
        const float rs = 1.0f / sqrtf(tot * (1.0f / GLA_DV) + EPS);
#pragma unroll
        for (int n2 = 0; n2 < 2; ++n2) { const int v0 = w * 32 + n2 * 16 + quad * 4; const f32x4 nw = nwf[n2];
            const u32x2 gw = gwf[mt][n2];
            const float g0 = bf_lo(gw.x), g1 = bf_hi(gw.x), g2 = bf_lo(gw.y), g3 = bf_hi(gw.y);
            const f32x4 o = acc[mt][n2] * rs * nw;
            u32x2 ow; ow.x = cvt_pk_bf16(o.x * g0 * fast_sigmoid(g0), o.y * g1 * fast_sigmoid(g1)); ow.y = cvt_pk_bf16(o.z * g2 * fast_sigmoid(g2), o.w * g3 * fast_sigmoid(g3));
            *(u32x2*)(GO + (size_t)(t0 + i) * BR_LD + h * GLA_DV + v0) = ow; } }
    __syncthreads();
}

namespace att {
constexpr float SCALE = 0.07216878364870322f, THR = 8.f;
constexpr int SHM_V = 16384, SHM_KN = 16384, SHM_KP = 8192;
constexpr int OFF_V = 0, OFF_KN = 3 * SHM_V, OFF_KP = OFF_KN + 4 * SHM_KN, OFF_WS = OFF_KP + 4 * SHM_KP, ATT_LDS_END = OFF_WS + 2048 + 16;
constexpr int OFF_EXO = 0, OFF_EXS = 65536;
#define KSWZ(row, colB) ((row) * 256 + ((colB) ^ (((row) & 7) << 4)))
#define KPSWZ(row, colB) ((row) * 128 + ((colB) ^ (((row) & 7) << 4)))
#define SBAR() __builtin_amdgcn_sched_barrier(0)
__device__ __forceinline__ int v_rd_base(int lane) { return ((lane & 3) << 3) | (((lane >> 2) & 3) << 6) | (((lane >> 4) & 1) << 5) | (((lane >> 5) & 1) << 8); }
constexpr int v_rd_off(int d0, int ks, int half) { return d0 * 512 + ks * 4096 + half * 2048; }
__device__ __forceinline__ int crow(int r, int hi) { return (r & 3) + 8 * (r >> 2) + 4 * hi; }
__device__ __forceinline__ void mask_tile(f32x16& p0, f32x16& p1, int dq) {
    const float NEG = -__builtin_inff();
#pragma unroll
    for (int r = 0; r < 16; ++r) { const int c = (r & 3) + 8 * (r >> 2);
        if (dq - c < 0) p0[r] = NEG;
        if (dq - c - 32 < 0) p1[r] = NEG; }
}
__device__ __forceinline__ void partialSM(f32x16& p0, f32x16& p1, float& m_reg, float& mn, float& alpha) {
    float pmax = p0[0];
#pragma unroll
    for (int r = 1; r < 16; ++r) pmax = fmaxf(pmax, p0[r]);
#pragma unroll
    for (int r = 0; r < 16; ++r) pmax = fmaxf(pmax, p1[r]);
    { auto rr = __builtin_amdgcn_permlane32_swap(__float_as_uint(pmax), __float_as_uint(pmax), false, false);
      pmax = fmaxf(__uint_as_float(rr[0]), __uint_as_float(rr[1])); }
    constexpr float C2 = 1.4426950408889634f * SCALE;
    if (__builtin_expect(__all((pmax - m_reg) * SCALE <= THR), 1)) { mn = m_reg; alpha = 1.f; }
    else { mn = fmaxf(m_reg, pmax); alpha = __builtin_amdgcn_exp2f((m_reg - mn) * C2); m_reg = mn; }
    const float mnL = -mn * C2;
#pragma unroll
    for (int r = 0; r < 16; ++r) p0[r] = fmaf(p0[r], C2, mnL);
#pragma unroll
    for (int r = 0; r < 16; ++r) p1[r] = fmaf(p1[r], C2, mnL);
#pragma unroll
    for (int r = 0; r < 16; ++r) p0[r] = __builtin_amdgcn_exp2f(p0[r]);
}
__device__ __forceinline__ void finishSM(f32x16& p0, f32x16& p1, float alpha, float& l_reg, bf16x8& pa0, bf16x8& pa1, bf16x8& pa2, bf16x8& pa3) {
#pragma unroll
    for (int r = 0; r < 16; ++r) p1[r] = __builtin_amdgcn_exp2f(p1[r]);
    float ps = 0;
#pragma unroll
    for (int r = 0; r < 16; ++r) ps += p0[r];
#pragma unroll
    for (int r = 0; r < 16; ++r) ps += p1[r];
    { auto rr = __builtin_amdgcn_permlane32_swap(__float_as_uint(ps), __float_as_uint(ps), false, false);
      ps = __uint_as_float(rr[0]) + __uint_as_float(rr[1]); }
    l_reg = l_reg * alpha + ps;
#define PK4(P, B_, OUT) do { unsigned a0 = cvt_pk_bf16(P[B_+0], P[B_+1]), a1 = cvt_pk_bf16(P[B_+2], P[B_+3]);                          \
        unsigned b0 = cvt_pk_bf16(P[B_+4], P[B_+5]), b1 = cvt_pk_bf16(P[B_+6], P[B_+7]);                                             \
        auto r0 = __builtin_amdgcn_permlane32_swap(a0, b0, false, false); auto r1 = __builtin_amdgcn_permlane32_swap(a1, b1, false, false); \
        u32x4 w = {r0[0], r1[0], r0[1], r1[1]}; OUT = __builtin_bit_cast(bf16x8, w); } while (0)
    PK4(p0, 0, pa0); PK4(p0, 8, pa1); PK4(p1, 0, pa2); PK4(p1, 8, pa3);
#undef PK4
}
__device__ __forceinline__ void qkt(f32x16& p0, f32x16& p1, const int* kb, const int* pb, const bf16x8* qn, const bf16x8* qp) {
#define KRD(dst, base, off) asm volatile("ds_read_b128 %0, %1 offset:%2" : "=&v"(dst) : "v"(base), "i"(off) : "memory")
#define RN(S, d0) do { KRD(S##0, kb[(d0) & 3], ((d0) >> 2) * 128); KRD(S##1, kb[(d0) & 3], ((d0) >> 2) * 128 + 32 * 256); } while (0)
#define RP(S, d0) do { KRD(S##0, pb[d0], 0); KRD(S##1, pb[d0], 32 * 128); } while (0)
#define MN(S, d0) do { p0 = __builtin_amdgcn_mfma_f32_32x32x16_bf16(__builtin_bit_cast(bf16x8, S##0), qn[d0], p0, 0, 0, 0); p1 = __builtin_amdgcn_mfma_f32_32x32x16_bf16(__builtin_bit_cast(bf16x8, S##1), qn[d0], p1, 0, 0, 0); } while (0)
#define MP(S, d0) do { p0 = __builtin_amdgcn_mfma_f32_32x32x16_bf16(__builtin_bit_cast(bf16x8, S##0), qp[d0], p0, 0, 0, 0); p1 = __builtin_amdgcn_mfma_f32_32x32x16_bf16(__builtin_bit_cast(bf16x8, S##1), qp[d0], p1, 0, 0, 0); } while (0)
#define LW(n) asm volatile("s_waitcnt lgkmcnt(" #n ")" ::: "memory")
#pragma unroll
    for (int r = 0; r < 16; ++r) { p0[r] = 0.f; p1[r] = 0.f; }
    u32x4 A0, A1, B0, B1;
    RN(A, 0); RN(B, 1);
    __builtin_amdgcn_s_setprio(2);
    LW(2); SBAR(); MN(A, 0); SBAR(); RN(A, 2);
    LW(2); SBAR(); MN(B, 1); SBAR(); RN(B, 3);
    LW(2); SBAR(); MN(A, 2); SBAR(); RN(A, 4);
    LW(2); SBAR(); MN(B, 3); SBAR(); RN(B, 5);
    LW(2); SBAR(); MN(A, 4); SBAR(); RN(A, 6);
    LW(2); SBAR(); MN(B, 5); SBAR(); RN(B, 7);
    LW(2); SBAR(); MN(A, 6); SBAR(); RP(A, 0);
    LW(2); SBAR(); MN(B, 7); SBAR(); RP(B, 1);
    LW(2); SBAR(); MP(A, 0); SBAR(); RP(A, 2);
    LW(2); SBAR(); MP(B, 1); SBAR(); RP(B, 3);
    LW(2); SBAR(); MP(A, 2); SBAR();
    LW(0); SBAR(); MP(B, 3);
    __builtin_amdgcn_s_setprio(0);
#undef LW
#undef MP
#undef MN
#undef RP
#undef RN
#undef KRD
}
__device__ __forceinline__ void pv_tile(f32x16* o, int vb0, bf16x8 pa0, bf16x8 pa1, bf16x8 pa2, bf16x8 pa3) {
#define TRRD(dst, off) asm volatile("ds_read_b64_tr_b16 %0, %1 offset:%2" : "=&v"(dst) : "v"(vb0), "i"(off) : "memory")
#define VRD(ks, S) do { TRRD(S##l0, v_rd_off(0, ks, 0)); TRRD(S##h0, v_rd_off(0, ks, 1)); TRRD(S##l1, v_rd_off(1, ks, 0)); TRRD(S##h1, v_rd_off(1, ks, 1)); \
                        TRRD(S##l2, v_rd_off(2, ks, 0)); TRRD(S##h2, v_rd_off(2, ks, 1)); TRRD(S##l3, v_rd_off(3, ks, 0)); TRRD(S##h3, v_rd_off(3, ks, 1)); } while (0)
#define VMM(pa, S) do { \
        o[0] = __builtin_amdgcn_mfma_f32_32x32x16_bf16(pa, (bf16x8){S##l0[0], S##l0[1], S##l0[2], S##l0[3], S##h0[0], S##h0[1], S##h0[2], S##h0[3]}, o[0], 0, 0, 0); \
        o[1] = __builtin_amdgcn_mfma_f32_32x32x16_bf16(pa, (bf16x8){S##l1[0], S##l1[1], S##l1[2], S##l1[3], S##h1[0], S##h1[1], S##h1[2], S##h1[3]}, o[1], 0, 0, 0); \
        o[2] = __builtin_amdgcn_mfma_f32_32x32x16_bf16(pa, (bf16x8){S##l2[0], S##l2[1], S##l2[2], S##l2[3], S##h2[0], S##h2[1], S##h2[2], S##h2[3]}, o[2], 0, 0, 0); \
        o[3] = __builtin_amdgcn_mfma_f32_32x32x16_bf16(pa, (bf16x8){S##l3[0], S##l3[1], S##l3[2], S##l3[3], S##h3[0], S##h3[1], S##h3[2], S##h3[3]}, o[3], 0, 0, 0); } while (0)
    s16x4 Al0, Ah0, Al1, Ah1, Al2, Ah2, Al3, Ah3, Bl0, Bh0, Bl1, Bh1, Bl2, Bh2, Bl3, Bh3;
    VRD(0, A); VRD(1, B);
    __builtin_amdgcn_s_setprio(2);
    asm volatile("s_waitcnt lgkmcnt(8)" ::: "memory"); SBAR(); VMM(pa0, A); SBAR();
    VRD(2, A);
    asm volatile("s_waitcnt lgkmcnt(8)" ::: "memory"); SBAR(); VMM(pa1, B); SBAR();
    VRD(3, B);
    asm volatile("s_waitcnt lgkmcnt(8)" ::: "memory"); SBAR(); VMM(pa2, A); SBAR();
    asm volatile("s_waitcnt lgkmcnt(0)" ::: "memory"); SBAR(); VMM(pa3, B);
    __builtin_amdgcn_s_setprio(0);
#undef VMM
#undef VRD
#undef TRRD
}
}

__device__ __forceinline__ void attn_item(Frame& F, int item) {
    using namespace att;
    const int bh = item >> 4, x = item & 15, b = bh >> 3, h = bh & 7;
    const int wid = F.wave, lane = F.lane, r32 = lane & 31, hi = lane >> 5;
    const bool grpB = wid >= 4;
    const int NL = 2 * x + 2, NH = 64 - 2 * x;
    const int qloH = (31 - x) * 128 + (wid & 3) * 32;
    int qlo = grpB ? qloH : x * 128 + (wid & 3) * 32;
    LAS unsigned char* L = F.lds;
    const bf16_t* Q = WSP(bf16_t, WS_Q) + (size_t)(b * SEQ) * NQ + h * MLA_QK;
    const bf16_t* KV = WSP(bf16_t, WS_KV) + (size_t)(b * MLA_H + h) * SEQ * 256;
    const bf16_t* KPE = WSP(bf16_t, WS_KPE) + (size_t)(b * SEQ) * MLA_ROPE;
    bf16x8 qn[8], qp[4];
#define LOADQ() do { const bf16_t* qrow = Q + (size_t)(qlo + r32) * NQ; \
        _Pragma("unroll") for (int d0 = 0; d0 < 8; ++d0) qn[d0] = *(const bf16x8*)(qrow + d0 * 16 + hi * 8); \
        _Pragma("unroll") for (int d0 = 0; d0 < 4; ++d0) qp[d0] = *(const bf16x8*)(qrow + MLA_NOPE + d0 * 16 + hi * 8); } while (0)
    LOADQ();
#define GLDS(src, dst) __builtin_amdgcn_global_load_lds((const unsigned*)(src), (LAS unsigned*)(dst), 16, 0, 0)
    unsigned ofKn, ofKp, ofV;
    { const int p0_ = wid * 64 + lane;
      { const int row_ = p0_ >> 4, ch_ = (p0_ & 15) ^ (row_ & 7); ofKn = (unsigned)(row_ * 256 + ch_ * 8) * 2u; }
      { const int row_ = p0_ >> 3, ch_ = (p0_ & 7) ^ (row_ & 7); ofKp = (unsigned)(row_ * MLA_ROPE + ch_ * 8) * 2u; }
      { const int st_ = p0_ >> 5, wi_ = p0_ & 31, kk_ = (st_ >> 2) * 8 + (wi_ >> 2), k_ = (kk_ & ~0xC) | ((kk_ & 4) << 1) | ((kk_ & 8) >> 1), c_ = (st_ & 3) * 32 + (wi_ & 3) * 8; ofV = (unsigned)(k_ * 256 + MLA_NOPE + c_) * 2u; } }
#define ALOADK(k0, slot) do { const char* kvb = (const char*)(KV + (size_t)(k0) * 256); const char* kpb_ = (const char*)(KPE + (size_t)(k0) * MLA_ROPE); \
        GLDS(kvb + ofKn, L + OFF_KN + (slot) * SHM_KN + wid * 1024); GLDS(kvb + 16384 + ofKn, L + OFF_KN + (slot) * SHM_KN + (wid + 8) * 1024); \
        GLDS(kpb_ + ofKp, L + OFF_KP + (slot) * SHM_KP + wid * 1024); } while (0)
#define ALOADV(k0, slot) do { const char* kvb = (const char*)(KV + (size_t)(k0) * 256); \
        GLDS(kvb + ofV, L + OFF_V + (slot) * SHM_V + wid * 1024); GLDS(kvb + 16384 + ofV, L + OFF_V + (slot) * SHM_V + (wid + 8) * 1024); } while (0)
    LAS float* wsf = (LAS float*)(L + OFF_WS) + wid * 64; LAS float* li_l = wsf; LAS float* al_l = wsf + 32;
    const int lbase = (int)(unsigned)(size_t)L;
    const int vbase = lbase + OFF_V + v_rd_base(lane);
    float m_reg = -1e30f, l_reg = 0.f; f32x16 o[4];
#define ZERO_O() do { _Pragma("unroll") for (int d = 0; d < 4; ++d) _Pragma("unroll") for (int r = 0; r < 16; ++r) o[d][r] = 0.f; } while (0)
    ZERO_O();
#define ATT_X(T_, KS_) do { f32x16 p0, p1; float mn, al; \
        { int tq_ = threadIdx.x; asm volatile("" : "+v"(tq_)); const int r_ = tq_ & 31, h_ = (tq_ >> 5) & 1; \
          const int ksw0 = lbase + OFF_KN + KSWZ(r_, (h_ * 8) * 2) + (KS_) * SHM_KN, psw0 = lbase + OFF_KP + KPSWZ(r_, (h_ * 8) * 2) + (KS_) * SHM_KP; \
          int kb[4], pb[4]; _Pragma("unroll") for (int dd = 0; dd < 4; ++dd) { kb[dd] = ksw0 ^ (dd << 5); pb[dd] = psw0 ^ (dd << 5); } qkt(p0, p1, kb, pb, qn, qp); } \
        if ((T_) * 64 + 63 > qlo) mask_tile(p0, p1, qlo + r32 - 4 * hi - (T_) * 64); \
        partialSM(p0, p1, m_reg, mn, al); \
        if (__any(al < 1.f)) { if (hi == 0) al_l[r32] = al; asm volatile("s_waitcnt lgkmcnt(0)" ::: "memory"); \
            _Pragma("unroll") for (int d_ = 0; d_ < 4; ++d_) _Pragma("unroll") for (int r = 0; r < 16; ++r) o[d_][r] *= al_l[crow(r, hi)]; } \
        finishSM(p0, p1, al, l_reg, pa0, pa1, pa2, pa3); SBAR(); } while (0)
    LAS unsigned* vflag = (LAS unsigned*)(L + OFF_WS + 2048); unsigned vtarget = 0;
    if (F.tid == 0) { vflag[0] = 0u; vflag[1] = 0u; }
    ALOADK(0, 0); ALOADV(0, 0); ALOADK(64, 1); ALOADV(64, 1);
    asm volatile("s_waitcnt vmcnt(0)" ::: "memory"); __syncthreads();
    int ks = 0, vs = 0;
    for (int t = 0; t < NL; ++t) {
        { const int v2 = vs == 0 ? 2 : vs - 1; ALOADK((t + 2) * 64, (ks + 2) & 3); ALOADV((t + 2) * 64, v2); }
        if (t * 64 <= qlo + 31) {
            bf16x8 pa0, pa1, pa2, pa3;
            ATT_X(t, ks);
            pv_tile(o, vbase + vs * SHM_V, pa0, pa1, pa2, pa3);
        }
        if (t + 1 < NL) asm volatile("s_waitcnt vmcnt(5)" ::: "memory");
        else asm volatile("s_waitcnt vmcnt(0)" ::: "memory");
        __builtin_amdgcn_s_barrier();
        ks = (ks + 1) & 3; vs = vs == 2 ? 0 : vs + 1;
    }
    bf16_t* Ow = WSP(bf16_t, WS_ATTO) + (size_t)(b * SEQ) * BR_LD + h * MLA_V;
    if (!grpB) {
        if (hi == 0) li_l[r32] = l_reg; asm volatile("s_waitcnt lgkmcnt(0)" ::: "memory");
        bf16_t* Or = Ow + (size_t)qlo * BR_LD;
#pragma unroll
        for (int r = 0; r < 16; ++r) { const int orow = crow(r, hi); const float rl = __builtin_amdgcn_rcpf(li_l[orow]);
#pragma unroll
            for (int d0 = 0; d0 < 4; ++d0) { const float v = o[d0][r] * rl; const float vn = __shfl_xor(v, 1);
                if ((r32 & 1) == 0) *(unsigned*)(Or + (size_t)orow * BR_LD + d0 * 32 + r32) = cvt_pk_bf16(v, vn); } }
        qlo = qloH; LOADQ(); m_reg = -1e30f; l_reg = 0.f; ZERO_O();
    }
#define ALOADVG(k0, slot) do { const char* kvb = (const char*)(KV + (size_t)(k0) * 256) - (grpB ? 8192 : 0); const int w3_ = wid & 3; \
        GLDS(kvb + ofV, L + OFF_V + (slot) * SHM_V + w3_ * 1024); GLDS(kvb + 8192 + ofV, L + OFF_V + (slot) * SHM_V + (w3_ + 4) * 1024); \
        GLDS(kvb + 16384 + ofV, L + OFF_V + (slot) * SHM_V + (w3_ + 8) * 1024); GLDS(kvb + 24576 + ofV, L + OFF_V + (slot) * SHM_V + (w3_ + 12) * 1024); } while (0)
    LAS unsigned* gflag = vflag + (grpB ? 1 : 0);
    for (int a = NL; a < NH; a += 2) {
        const bool more = a + 2 < NH;
        const int v1 = vs == 2 ? 0 : vs + 1, v2 = vs == 0 ? 2 : vs - 1;
        if (grpB) { if (a > NL) ALOADVG((a + 1) * 64, v1);
                    if (more) { ALOADK((a + 2) * 64, (ks + 2) & 3); ALOADK((a + 3) * 64, (ks + 3) & 3); } }
        else if (more) { ALOADK((a + 2) * 64, (ks + 2) & 3); ALOADK((a + 3) * 64, (ks + 3) & 3); ALOADVG((a + 2) * 64, v2); }
        const int my = grpB ? a + 1 : a;
        const bool act = my * 64 <= qlo + 31;
        bf16x8 pa0, pa1, pa2, pa3;
        if (act) ATT_X(my, (grpB ? ks + 1 : ks) & 3);
        if (!more) asm volatile("s_waitcnt vmcnt(0)" ::: "memory");
        else if (grpB) asm volatile("s_waitcnt vmcnt(6)" ::: "memory");
        else asm volatile("s_waitcnt vmcnt(10)" ::: "memory");
        if (lane == 0) __hip_atomic_fetch_add(gflag, 1u, __ATOMIC_RELAXED, __HIP_MEMORY_SCOPE_WORKGROUP);
        vtarget += 4u;
        if (act) { while (*(volatile LAS unsigned*)gflag < vtarget) __builtin_amdgcn_s_sleep(1);
                   pv_tile(o, vbase + (grpB ? v1 : vs) * SHM_V, pa0, pa1, pa2, pa3); }
        if (more && !grpB) asm volatile("s_waitcnt vmcnt(4)" ::: "memory");
        else asm volatile("s_waitcnt vmcnt(0)" ::: "memory");
        __builtin_amdgcn_s_barrier();
        ks = (ks + 2) & 3; vs = v2;
    }
#undef ALOADVG
#undef ATT_X
#undef ZERO_O
#undef LOADQ
#undef ALOADV
#undef ALOADK
#undef GLDS
    { LAS float* EXO = (LAS float*)(L + OFF_EXO); LAS float* EXS = (LAS float*)(L + OFF_EXS);
      constexpr float C2 = 1.4426950408889634f * SCALE;
      if (!grpB) {
#pragma unroll
          for (int d = 0; d < 4; ++d)
#pragma unroll
              for (int r = 0; r < 16; ++r) EXO[((wid * 64) + d * 16 + r) * 64 + lane] = o[d][r];
          if (hi == 0) { EXS[(wid * 2 + 0) * 32 + r32] = m_reg; EXS[(wid * 2 + 1) * 32 + r32] = l_reg; }
      } else if (hi == 0) { li_l[r32] = l_reg; al_l[r32] = m_reg; }
      __syncthreads();
      if (grpB) { const int w4 = wid - 4; bf16_t* Or = Ow + (size_t)qlo * BR_LD;
#pragma unroll
          for (int r = 0; r < 16; ++r) { const int orow = crow(r, hi);
              const float mA = EXS[(w4 * 2 + 0) * 32 + orow], lA = EXS[(w4 * 2 + 1) * 32 + orow], mB = al_l[orow], lB = li_l[orow];
              const float M = fmaxf(mA, mB); float fa = __builtin_amdgcn_exp2f((mA - M) * C2), fb = __builtin_amdgcn_exp2f((mB - M) * C2);
              const float rl = __builtin_amdgcn_rcpf(lA * fa + lB * fb); fa *= rl; fb *= rl;
#pragma unroll
              for (int d0 = 0; d0 < 4; ++d0) { const float v = o[d0][r] * fb + EXO[((w4 * 64) + d0 * 16 + r) * 64 + lane] * fa; const float vn = __shfl_xor(v, 1);
                  if ((r32 & 1) == 0) *(unsigned*)(Or + (size_t)orow * BR_LD + d0 * 32 + r32) = cvt_pk_bf16(v, vn); } } }
      __syncthreads(); }
}

__device__ __forceinline__ void p8_router(Frame& F) {
    LAS unsigned char* L = F.lds;
    LAS float* RED = (LAS float*)L;
    LAS float* SSQ = (LAS float*)(L + 32768);
    LAS float* LG = (LAS float*)(L + 36864);
    LAS float* RS = (LAS float*)(L + 41472);
    LAS int* SEL = (LAS int*)(L + 41984);
    const float* X1 = WSP(float, WS_X1); const float* RW = WSP(float, WS_RW); const float* RC = WSP(float, WS_RC); const float* mod = WSP(float, WS_MOD);
    const int lane = F.lane, r = lane & 31, hh = lane >> 5;
    for (int task = F.vcu; task < NTOK / 32; task += F.G) {
        const int row0 = task * 32, b = row0 / SEQ, kbeg = F.wave * 256;
        const float* xa = X1 + (size_t)(row0 + r) * DM + kbeg + 4 * hh;
        const float* wb = RW + ((size_t)b * DM + kbeg + 4 * hh) * NEXP + r;
        f32x16 acc; float ss = 0.f;
#pragma unroll
        for (int i = 0; i < 16; ++i) acc[i] = 0.f;
#pragma unroll 4
        for (int m = 0; m < 32; ++m) { const f32x4 a = *(const f32x4*)(xa + 8 * m);
            const float w0 = wb[(8 * m + 0) * NEXP], w1 = wb[(8 * m + 1) * NEXP], w2 = wb[(8 * m + 2) * NEXP], w3 = wb[(8 * m + 3) * NEXP];
            acc = __builtin_amdgcn_mfma_f32_32x32x2f32(a.x, w0, acc, 0, 0, 0); acc = __builtin_amdgcn_mfma_f32_32x32x2f32(a.y, w1, acc, 0, 0, 0);
            acc = __builtin_amdgcn_mfma_f32_32x32x2f32(a.z, w2, acc, 0, 0, 0); acc = __builtin_amdgcn_mfma_f32_32x32x2f32(a.w, w3, acc, 0, 0, 0);
            ss += (a.x * a.x + a.y * a.y) + (a.z * a.z + a.w * a.w); }
#pragma unroll
        for (int i = 0; i < 16; ++i) RED[(F.wave * 32 + att::crow(i, hh)) * 32 + r] = acc[i];
        SSQ[(F.wave * 2 + hh) * 32 + r] = ss;
        __syncthreads();
#pragma unroll
        for (int q = 0; q < 2; ++q) { const int idx = F.tid + q * 512; float s = 0.f;
#pragma unroll
            for (int w = 0; w < 8; ++w) s += RED[w * 1024 + idx];
            LG[(idx >> 5) * 33 + (idx & 31)] = s; }
        if (F.tid < 32) { float s = 0.f;
#pragma unroll
            for (int w = 0; w < 16; ++w) s += SSQ[w * 32 + F.tid];
            RS[F.tid] = 1.0f / sqrtf(s * (1.0f / DM) + EPS); }
        __syncthreads();
        if (F.tid < 32) { const int row = F.tid; const float rs = RS[row];
            int s0 = -1, s1 = -1, s2 = -1, s3 = -1; float v0 = 0.f, v1 = 0.f, v2 = 0.f, v3 = 0.f;
#pragma unroll
            for (int k = 0; k < 4; ++k) { float best = -__builtin_inff(); int bi = 0;
                for (int e = 0; e < NEXP; ++e) { const float v = rs * LG[row * 33 + e] + RC[b * NEXP + e];
                    const bool taken = (e == s0) | (e == s1) | (e == s2) | (e == s3);
                    if (!taken && v > best) { best = v; bi = e; } }
                if (k == 0) { s0 = bi; v0 = best; } else if (k == 1) { s1 = bi; v1 = best; } else if (k == 2) { s2 = bi; v2 = best; } else { s3 = bi; v3 = best; } }
            const float e0 = 1.0f, e1 = __expf(v1 - v0), e2 = __expf(v2 - v0), e3 = __expf(v3 - v0), inv = 1.0f / (e0 + e1 + e2 + e3);
            *(f32x4*)(WSP(float, WS_TOPW) + (size_t)(row0 + row) * 4) = (f32x4){e0 * inv, e1 * inv, e2 * inv, e3 * inv};
            SEL[row * 4 + 0] = s0; SEL[row * 4 + 1] = s1; SEL[row * 4 + 2] = s2; SEL[row * 4 + 3] = s3; }
        __syncthreads();
        if (F.tid < 32) { const int e = F.tid; int nsel = 0;
            for (int i = 0; i < 128; ++i) nsel += (SEL[i] == e) ? 1 : 0;
            if (nsel) { int slot = (int)__hip_atomic_fetch_add((unsigned*)(F.ctl + CW_CNT + 64 * e), (unsigned)nsel, RLX_AGENT);
                int* rowmap = WSP(int, WS_ROWMAP) + (size_t)e * ECAP; int* topi = WSP(int, WS_TOPI);
                for (int i = 0; i < 128; ++i) if (SEL[i] == e) { rowmap[slot] = row0 + (i >> 2); topi[(size_t)(row0 + (i >> 2)) * 4 + (i & 3)] = e * ECAP + slot; ++slot; } } }
#pragma unroll
        for (int q = 0; q < 4; ++q) { const int m = row0 + F.wave * 4 + q;
            norm_mod_row_bf16<true>(X1 + (size_t)m * DM, F.norm_ffn_w, mod + b * 6 * DM + 3 * DM, mod + b * 6 * DM + 4 * DM, (bf16_t*)(WSP(unsigned char, WS_H) + (size_t)m * DM), F.lane); }
        __syncthreads();
    }
}

__device__ __forceinline__ void moe_tables(Frame& F, int npn, int G, int c) {
    if (F.tid < NEXP) { const unsigned cn = __hip_atomic_load((unsigned*)(F.ctl + CW_CNT + 64 * F.tid), RLX_AGENT); F.LW[LW_CNT + F.tid] = cn; F.LW[LW_NBLK + F.tid] = (cn + 255u) >> 8; }
    __syncthreads();
    if (F.tid == 0) { unsigned sacc = 0; for (int e = 0; e < NEXP; ++e) { F.LW[LW_USTART + e] = sacc; sacc += F.LW[LW_NBLK + e]; } F.LW[LW_USTART + NEXP] = sacc; }
    __syncthreads();
    if (F.tid < 16) { const unsigned Lx = (unsigned)(F.tid * G + c), total = F.LW[LW_USTART + NEXP] * (unsigned)npn;
        unsigned w0 = 0xffffffffu, w1 = 0, w2 = 0, w3 = 0;
        if (Lx < total) { int e = 0; while (Lx >= F.LW[LW_USTART + e + 1] * (unsigned)npn) ++e;
            const unsigned r = Lx - F.LW[LW_USTART + e] * (unsigned)npn, nb = F.LW[LW_NBLK + e], mb = r % nb;
            w0 = (unsigned)e * (ECAP / 256) + mb; w1 = r / nb; w2 = (unsigned)e; w3 = F.LW[LW_CNT + e] - mb * 256u; }
        F.LW[LW_UNITS + 4 * F.tid + 0] = w0; F.LW[LW_UNITS + 4 * F.tid + 1] = w1; F.LW[LW_UNITS + 4 * F.tid + 2] = w2; F.LW[LW_UNITS + 4 * F.tid + 3] = w3; }
    __syncthreads();
}
template <bool GATHER_>
struct MoeOrder {
    static constexpr bool GATHER = true, RGATHER = GATHER_, FP8 = true, DEPWAIT = false;
    const unsigned char* A; const unsigned char* Bt; int ldab, KB, npn; size_t bstride; const int* rowmap; volatile LAS unsigned* LW; int G, c;
    __device__ __forceinline__ bool next(int i, pg8::Unit& u) const {
        if (i >= 16) {
            const unsigned Lx = (unsigned)(i * G + c), total = LW[LW_USTART + NEXP] * (unsigned)npn; if (Lx >= total) return false;
            int e = 0; while (Lx >= LW[LW_USTART + e + 1] * (unsigned)npn) ++e;
            const unsigned r = Lx - LW[LW_USTART + e] * (unsigned)npn, nb = LW[LW_NBLK + e], mb = r % nb;
            u.pn = (int)(r / nb); u.pm = e * (ECAP / 256) + (int)mb; u.aux = e; u.cnt = (int)LW[LW_CNT + e] - (int)mb * 256; return true; }
        const unsigned w0 = LW[LW_UNITS + 4 * i]; if (w0 == 0xffffffffu) return false;
        u.pm = (int)w0; u.pn = (int)LW[LW_UNITS + 4 * i + 1]; u.aux = (int)LW[LW_UNITS + 4 * i + 2]; u.cnt = (int)LW[LW_UNITS + 4 * i + 3]; return true;
    }
    __device__ __forceinline__ const char* a_ptr(const pg8::Unit& u) const { return RGATHER ? (const char*)A : (const char*)A + (size_t)u.pm * 256 * ldab; }
    __device__ __forceinline__ unsigned a_off(const pg8::Unit& u, int row, int colb) const {
        if constexpr (RGATHER) { const int tok = row < u.cnt ? rowmap[(size_t)u.pm * 256 + row] : 0; return (unsigned)(tok * ldab + colb); }
        else return (unsigned)(row * ldab + colb);
    }
    __device__ __forceinline__ const char* b_ptr(const pg8::Unit& u) const { return (const char*)Bt + (size_t)u.aux * bstride + (size_t)u.pn * 256 * KB; }
};

__device__ __forceinline__ bool moe_both_decode(volatile LAS unsigned* LW, unsigned g, unsigned& w0, unsigned& w1, unsigned& w2, unsigned& w3) {
    const unsigned tot = LW[LW_USTART + NEXP], n9 = tot * ((2 * DEXP) / 256);
    unsigned kind = 0, npn = (2 * DEXP) / 256, Lx = g;
    if (g >= n9) { kind = 1; npn = DM / 256; Lx = g - n9; if (Lx >= tot * npn) return false; }
    int e = 0; while (Lx >= LW[LW_USTART + e + 1] * npn) ++e;
    const unsigned r = Lx - LW[LW_USTART + e] * npn, nb = LW[LW_NBLK + e], mb = r % nb;
    w0 = (unsigned)e * (ECAP / 256) + mb; w1 = r / nb; w2 = (unsigned)e | (kind << 8); w3 = LW[LW_CNT + e] - mb * 256u; return true;
}
__device__ __forceinline__ void moe_tables_both(Frame& F, int G, int c) {
    if (F.tid < NEXP) { const unsigned cn = __hip_atomic_load((unsigned*)(F.ctl + CW_CNT + 64 * F.tid), RLX_AGENT); F.LW[LW_CNT + F.tid] = cn; F.LW[LW_NBLK + F.tid] = (cn + 255u) >> 8; }
    __syncthreads();
    if (F.tid == 0) { unsigned sacc = 0; for (int e = 0; e < NEXP; ++e) { F.LW[LW_USTART + e] = sacc; sacc += F.LW[LW_NBLK + e]; } F.LW[LW_USTART + NEXP] = sacc; }
    __syncthreads();
    if (F.tid < 24) { unsigned w0 = 0xffffffffu, w1 = 0, w2 = 0, w3 = 0;
        if (!moe_both_decode(F.LW, (unsigned)(F.tid * G + c), w0, w1, w2, w3)) w0 = 0xffffffffu;
        F.LW[LW_UNITS + 4 * F.tid + 0] = w0; F.LW[LW_UNITS + 4 * F.tid + 1] = w1; F.LW[LW_UNITS + 4 * F.tid + 2] = w2; F.LW[LW_UNITS + 4 * F.tid + 3] = w3; }
    __syncthreads();
}
struct MoeBoth {
    static constexpr bool GATHER = true, FP8 = true, DEPWAIT = true;
    const unsigned char* H2; const unsigned char* ACT; const unsigned char* W1; const unsigned char* W2; int ldab, KB; const int* rowmap; volatile LAS unsigned* LW; const unsigned* blk; int G, c;
    __device__ __forceinline__ bool next(int i, pg8::Unit& u) const {
        unsigned w0, w1, w2, w3;
        if (i >= 24) { if (!moe_both_decode(LW, (unsigned)(i * G + c), w0, w1, w2, w3)) return false; }
        else { w0 = LW[LW_UNITS + 4 * i]; if (w0 == 0xffffffffu) return false; w1 = LW[LW_UNITS + 4 * i + 1]; w2 = LW[LW_UNITS + 4 * i + 2]; w3 = LW[LW_UNITS + 4 * i + 3]; }
        u.pm = (int)w0; u.pn = (int)w1; u.aux = (int)w2; u.cnt = (int)w3; return true;
    }
    __device__ __forceinline__ void wait_ready(const pg8::Unit& u) const {
        if (u.aux >> 8) { while (__hip_atomic_load(blk + u.pm, __ATOMIC_RELAXED, __HIP_MEMORY_SCOPE_AGENT) < 8u * ((2 * DEXP) / 256)) __builtin_amdgcn_s_sleep(2); }
    }
    __device__ __forceinline__ const char* a_ptr(const pg8::Unit& u) const { return (u.aux >> 8) ? (const char*)ACT + (size_t)u.pm * 256 * ldab : (const char*)H2; }
    __device__ __forceinline__ unsigned a_off(const pg8::Unit& u, int row, int colb) const {
        if (u.aux >> 8) return (unsigned)(row * ldab + colb);
        const int tok = row < u.cnt ? rowmap[(size_t)u.pm * 256 + row] : 0; return (unsigned)(tok * ldab + colb);
    }
    __device__ __forceinline__ int a_row(const pg8::Unit& u, int row) const {
        if (u.aux >> 8) return row;
        return row < u.cnt ? rowmap[(size_t)u.pm * 256 + row] : 0; }
    __device__ __forceinline__ const char* b_ptr(const pg8::Unit& u) const { const int e = u.aux & 255;
        return (u.aux >> 8) ? (const char*)W2 + (size_t)e * ((size_t)DM * DEXP) + (size_t)u.pn * 256 * KB : (const char*)W1 + (size_t)e * ((size_t)2 * DEXP * DM) + (size_t)u.pn * 256 * KB; }
};

__device__ __forceinline__ void p11_final(Frame& F) {
    const int gw = F.vcu * NWAVES + F.wave, NGW = F.G * NWAVES;
    const float* X1 = WSP(float, WS_X1); const float* mod = WSP(float, WS_MOD); const float* fmod = WSP(float, WS_FMOD); const unsigned char* Y = WSP(unsigned char, WS_Y);
    for (int m = gw; m < NTOK; m += NGW) { const int b = m / SEQ;
        const int* ti = WSP(int, WS_TOPI) + (size_t)m * 4; const f32x4 tw = *(const f32x4*)(WSP(float, WS_TOPW) + (size_t)m * 4);
        const unsigned char* y0 = Y + (size_t)ti[0] * DM; const unsigned char* y1 = Y + (size_t)ti[1] * DM; const unsigned char* y2 = Y + (size_t)ti[2] * DM; const unsigned char* y3 = Y + (size_t)ti[3] * DM;
        const f32x4 tws = tw * (1.0f / Y8_SCALE);
        const float* gf = mod + b * 6 * DM + 5 * DM;
        f32x4 v[8]; float s = 0.f;
#pragma unroll
        for (int j = 0; j < 8; ++j) { const int c = 4 * F.lane + 256 * j;
            const f32x4 xv = __builtin_nontemporal_load((const f32x4*)(X1 + (size_t)m * DM + c)), g = *(const f32x4*)(gf + c);
            const unsigned a0 = __builtin_nontemporal_load((const unsigned*)(y0 + c)), a1 = __builtin_nontemporal_load((const unsigned*)(y1 + c)), a2 = __builtin_nontemporal_load((const unsigned*)(y2 + c)), a3 = __builtin_nontemporal_load((const unsigned*)(y3 + c));
            const f32x2 l0 = __builtin_amdgcn_cvt_pk_f32_fp8((int)a0, false), h0 = __builtin_amdgcn_cvt_pk_f32_fp8((int)a0, true), l1 = __builtin_amdgcn_cvt_pk_f32_fp8((int)a1, false), h1 = __builtin_amdgcn_cvt_pk_f32_fp8((int)a1, true);
            const f32x2 l2 = __builtin_amdgcn_cvt_pk_f32_fp8((int)a2, false), h2 = __builtin_amdgcn_cvt_pk_f32_fp8((int)a2, true), l3 = __builtin_amdgcn_cvt_pk_f32_fp8((int)a3, false), h3 = __builtin_amdgcn_cvt_pk_f32_fp8((int)a3, true);
            f32x4 acc;
            acc.x = tws.x * l0.x + tws.y * l1.x + tws.z * l2.x + tws.w * l3.x;
            acc.y = tws.x * l0.y + tws.y * l1.y + tws.z * l2.y + tws.w * l3.y;
            acc.z = tws.x * h0.x + tws.y * h1.x + tws.z * h2.x + tws.w * h3.x;
            acc.w = tws.x * h0.y + tws.y * h1.y + tws.z * h2.y + tws.w * h3.y;
            v[j] = xv + g * acc; s += (v[j].x * v[j].x + v[j].y * v[j].y) + (v[j].z * v[j].z + v[j].w * v[j].w); }
        const float rs = 1.0f / sqrtf(wave_sum(s) * (1.0f / DM) + EPS);
#pragma unroll
        for (int j = 0; j < 8; ++j) { const int c = 4 * F.lane + 256 * j; const f32x4 g = *(const f32x4*)(F.norm_final_w + c), sh = *(const f32x4*)(fmod + b * 2 * DM + c), sc = *(const f32x4*)(fmod + b * 2 * DM + DM + c);
            __builtin_nontemporal_store(v[j] * rs * g * (sc + 1.0f) + sh, (f32x4*)(F.out + (size_t)m * DM + c)); }
    }
}

constexpr int NPHASE = 12;
struct Args { const void* in[27]; float* out; unsigned char* ws; int ph_lo, ph_hi, li, pad; };
__global__ void __launch_bounds__(NWAVES * 64, 2) mk_fwd(Args args) {
    extern __shared__ __attribute__((aligned(16))) unsigned char lds_raw[];
    Frame F;
    F.lds = (LAS unsigned char*)lds_raw;
    F.LW = (volatile LAS unsigned*)(F.lds + LDSCTL_OFF);
    F.tid = threadIdx.x; F.lane = F.tid & 63; F.wave = __builtin_amdgcn_readfirstlane(F.tid >> 6);
    F.G = gridDim.x; { const int bx = blockIdx.x; F.vcu = (F.G % 8 == 0) ? (bx % 8) * (F.G / 8) + bx / 8 : bx; }
    F.ws = args.ws; F.ctl = (gu32*)(args.ws + WS_CTL); F.out = args.out;
    F.x = (const float*)args.in[0]; F.c = (const float*)args.in[1]; F.pos = (const int*)args.in[2];
    F.w_ada = (const float*)args.in[3]; F.b_ada = (const float*)args.in[4]; F.norm_mix_w = (const float*)args.in[5]; F.w_in = (const float*)args.in[6];
    F.q_norm_w = (const float*)args.in[7]; F.w_q_b = (const float*)args.in[8]; F.kv_norm_w = (const float*)args.in[9]; F.w_kv_b = (const float*)args.in[10];
    F.w_gk_up = (const float*)args.in[11]; F.b_gk_up = (const float*)args.in[12]; F.gla_norm_w = (const float*)args.in[13];
    F.w_o_mla = (const float*)args.in[14]; F.w_o_gla = (const float*)args.in[15]; F.w_out = (const float*)args.in[16]; F.norm_ffn_w = (const float*)args.in[17];
    F.w_router = (const float*)args.in[18]; F.b_router = (const float*)args.in[19]; F.w1 = (const float*)args.in[20]; F.b1 = (const float*)args.in[21];
    F.w2 = (const float*)args.in[22]; F.b2 = (const float*)args.in[23]; F.w_ada_final = (const float*)args.in[24]; F.b_ada_final = (const float*)args.in[25]; F.norm_final_w = (const float*)args.in[26];
    for (int u = F.tid; u < (LDS_BYTES - LDSCTL_OFF) / 4; u += NWAVES * 64) ((LAS unsigned*)(F.lds + LDSCTL_OFF))[u] = 0u;
    __syncthreads();
    XcdBarrier bar; bar.bar = (unsigned*)(F.ctl + CW_BAR); bar.x = 0; bar.st = nullptr;
    if (MK_ONE_LAUNCH) bar = xcd_barrier_post((unsigned*)(F.ctl + CW_BAR), F.LW + LW_BAR);
    const int lo = args.ph_lo, hi = args.ph_hi;
#ifndef PH_MASK
#define PH_MASK 0xFFF
#endif
#define IN(k) (((PH_MASK >> (k)) & 1) && lo <= (k) && (k) < hi)
#define SEAM(k) do { if (IN(k) && IN((k) + 1)) xcd_barrier(bar); } while (0)
    const int cid = F.vcu;

    if (IN(0)) { p0_prologue(F); if (MK_ONE_LAUNCH) { wait_gemv(F); p1_norm(F); } } if (!MK_ONE_LAUNCH) SEAM(0);
    if (IN(1)) { if (!MK_ONE_LAUNCH) p1_norm(F); } SEAM(1);
    if (IN(2)) {
        constexpr int RP0 = 14, NX15 = 2;
        const bool split = (F.G == 256);
        const int idx = cid & 31, xc = cid >> 5;
        const int rpx = RP0 + (xc < NX15 ? 1 : 0), gbase = RP0 * xc + (xc < NX15 ? xc : NX15), cbase = (32 - RP0) * xc - (xc < NX15 ? xc : NX15);
        constexpr int NGW_ = 8 * RP0 + NX15, NCW_ = 256 - NGW_;
        if (!split || idx < rpx) {
            pg8::DenseOrder S; S.init(WSP(bf16_t, WS_H), DM, WSP(bf16_t, WS_WIN), NTOK, DINP, DM, split ? NGW_ : F.G, split ? gbase + idx : cid);
            epi::Bf16Plain E{WSP(bf16_t, WS_PROJ), DINP};
            pg8::gemm_phase_b3(F.lds, S, E);
        }
        if (!split) moe_convert(F, cid, F.G); else if (idx >= rpx) moe_convert(F, cbase + (idx - rpx), NCW_);
    } SEAM(2);
    if (IN(3)) {
        p3_rows(F);
        for (int u = cid; u < NB * GLA_H * GLA_NCH; u += F.G) gla_pass1_unit(F, u);
    } SEAM(3);
    if (IN(4)) {
        { pg8::DenseOrder S; S.init(WSP(bf16_t, WS_PROJ) + C_CKV, DINP, WSP(bf16_t, WS_WKV), NTOK, NKV, MLA_KVR, F.G, cid);
          epi::Bf16RowScale E{WSP(bf16_t, WS_KV), NKV, WSP(float, WS_RSKV)};
          pg8::gemm_phase(F.lds, S, E); }
        { pg8::DenseOrder S; S.init(WSP(bf16_t, WS_PROJ) + C_QLAT, DINP, WSP(bf16_t, WS_WQ), NTOK, NQ, MLA_QR, F.G, cid);
          epi::QRope E{WSP(bf16_t, WS_Q), WSP(float, WS_RSQ), WSP(float, WS_CS)};
          pg8::gemm_phase(F.lds, S, E); }
        gla_pass2(F);
    } SEAM(4);
    if (IN(5)) {
#ifndef NO_ATT
        for (int it = cid; it < NB * MLA_H * 16; it += F.G) attn_item(F, it);
#endif
#ifndef NO_GLA3
        for (;;) {
            if (F.tid == 0) F.LW[LW_TMP] = __hip_atomic_fetch_add((unsigned*)(F.ctl + CW_GQ), 1u, RLX_AGENT);
            __syncthreads();
            const int u = (int)F.LW[LW_TMP];
            __syncthreads();
            if (u >= NB * GLA_H * GLA_NCH) break;
            gla_pass3_unit(F, u);
        }
#endif
    } SEAM(5);
    if (IN(6)) {
        pg8::DenseOrder S; S.init(WSP(bf16_t, WS_ATTO), BR_LD, WSP(bf16_t, WS_WOM), NTOK, DM, 2048, F.G, cid);
        epi::GateMerge2 E{WSP(bf16_t, WS_MERGED), WSP(bf16_t, WS_PROJ)};
        pg8::gemm_phase(F.lds, S, E);
    } SEAM(6);
    if (IN(7)) {
        pg8::DenseOrder S; S.init(WSP(bf16_t, WS_MERGED), DM, WSP(bf16_t, WS_WOUT), NTOK, DM, DM, F.G, cid);
        epi::ResidGateF32 E{WSP(float, WS_X1), F.x, WSP(float, WS_MOD) + 2 * DM};
        pg8::gemm_phase(F.lds, S, E);
    } SEAM(7);
    if (IN(8)) { p8_router(F); } SEAM(8);
    if (IN(9)) {
        moe_tables_both(F, F.G, cid);
        MoeBoth S{WSP(unsigned char, WS_H), WSP(unsigned char, WS_ACT), WSP(unsigned char, WS_W1), WSP(unsigned char, WS_W2), DM, DM, WSP(int, WS_ROWMAP), F.LW, (const unsigned*)(F.ctl + CW_BLK), F.G, cid};
        epi::MoeEpi E{WSP(unsigned char, WS_ACT), F.b1, WSP(unsigned char, WS_Y), F.b2, (unsigned*)(F.ctl + CW_BLK)};
        pg8::gemm_phase_b3(F.lds, S, E);
    }
    SEAM(10);
    if (IN(11)) { p11_final(F); }
#undef IN
#undef SEAM
}

extern "C" void kernel_launch(void* const* d_in, const int* in_sizes, int n_in, void* d_out, int out_size, void* d_ws, size_t ws_size, hipStream_t stream) {
    static int grid = 0;
    if (grid == 0) {
        if (n_in != 27 || in_sizes[0] != NTOK * DM || out_size != NTOK * DM || ws_size < WS_END) { fprintf(stderr, "kernel_launch: unexpected shapes (n_in %d, in0 %d, out %d, ws %zu < %zu); nothing launched\n", n_in, n_in > 0 ? in_sizes[0] : -1, out_size, ws_size, (size_t)WS_END); grid = -1; return; }
        int dev = 0, cus = 0, per_cu = 0;
        if (hipGetDevice(&dev) != hipSuccess || hipDeviceGetAttribute(&cus, hipDeviceAttributeMultiprocessorCount, dev) != hipSuccess) { fprintf(stderr, "kernel_launch: device query failed\n"); grid = -1; return; }
        if (hipFuncSetAttribute((const void*)mk_fwd, hipFuncAttributeMaxDynamicSharedMemorySize, LDS_BYTES) != hipSuccess) { fprintf(stderr, "kernel_launch: hipFuncSetAttribute failed\n"); grid = -1; return; }
        if (hipOccupancyMaxActiveBlocksPerMultiprocessor(&per_cu, (const void*)mk_fwd, NWAVES * 64, LDS_BYTES) != hipSuccess || per_cu < 1) { fprintf(stderr, "kernel_launch: occupancy query reports %d workgroups per CU\n", per_cu); }
        (void)hipGetLastError();
        grid = cus;
    }
    if (grid < 0) return;
    if (hipMemsetAsync((char*)d_ws + WS_CTL, 0, CTL_ZERO_BYTES, stream) != hipSuccess) { fprintf(stderr, "kernel_launch: memset failed\n"); return; }
    Args a{};
    for (int i = 0; i < 27; ++i) a.in[i] = d_in[i];
    a.out = (float*)d_out; a.ws = (unsigned char*)d_ws; a.pad = 0;
#if MK_ONE_LAUNCH
    a.ph_lo = 0; a.ph_hi = NPHASE; a.li = 0;
    hipLaunchKernelGGL(mk_fwd, dim3(grid), dim3(NWAVES * 64), LDS_BYTES, stream, a);
#else
#ifndef REP_MASK
#define REP_MASK 0
#endif
#ifndef REP_CNT
#define REP_CNT 1
#endif
    for (int p = 0; p < NPHASE; ++p) for (int rep = 0; rep <= ((REP_MASK >> p) & 1) * REP_CNT; ++rep) { a.ph_lo = p; a.ph_hi = p + 1; a.li = p; hipLaunchKernelGGL(mk_fwd, dim3(grid), dim3(NWAVES * 64), LDS_BYTES, stream, a); }
#endif
    const hipError_t le = hipPeekAtLastError();
    if (le != hipSuccess) fprintf(stderr, "kernel_launch: launch failed: %s\n", hipGetErrorName(le));
}
```

```cpp
#include <hip/hip_runtime.h>
#include <cstdio>
#include <cstdint>

#ifndef MK_ONE_LAUNCH
#define MK_ONE_LAUNCH 1
#endif

#define GAS __attribute__((address_space(1)))
#define LAS __attribute__((address_space(3)))
typedef unsigned short bf16_t;
typedef short bf16x8 __attribute__((ext_vector_type(8)));
typedef short s16x4 __attribute__((ext_vector_type(4)));
typedef float f32x2 __attribute__((ext_vector_type(2)));
typedef float f32x4 __attribute__((ext_vector_type(4)));
typedef float f32x16 __attribute__((ext_vector_type(16)));
typedef unsigned u32x2 __attribute__((ext_vector_type(2)));
typedef unsigned u32x4 __attribute__((ext_vector_type(4)));
typedef GAS unsigned gu32;

constexpr int DM = 2048, NB = 2, SEQ = 4096, NTOK = NB * SEQ;
constexpr int MLA_H = 8, MLA_QR = 512, MLA_KVR = 256, MLA_NOPE = 128, MLA_ROPE = 64, MLA_V = 128, MLA_QK = MLA_NOPE + MLA_ROPE;
constexpr int GLA_H = 4, GLA_DK = 128, GLA_DV = 256, GLA_R = 16, GLA_C = 64, GLA_NCH = SEQ / GLA_C;
constexpr int NEXP = 32, TOPK = 4, DEXP = 2048;
constexpr float EPS = 1e-6f;
constexpr int DIN = 8016, DINP = 8192;
constexpr int C_QLAT = 0, C_CKV = 512, C_KPE = 768, C_GQ = 832, C_GK = 1344, C_GV = 1856, C_GLR = 2880, C_GOUT = 2896, C_GA = 3920, C_GB = 5968;
constexpr int NQ = MLA_H * MLA_QK;
constexpr int NKV = MLA_H * (MLA_NOPE + MLA_V);
constexpr int ECAP = NTOK;

typedef __bf16 bf16x2_hw __attribute__((ext_vector_type(2)));
__device__ __forceinline__ unsigned cvt_pk_bf16(float lo, float hi) { const f32x2 v = {lo, hi}; return __builtin_bit_cast(unsigned, __builtin_convertvector(v, bf16x2_hw)); }
__device__ __forceinline__ float bf_lo(unsigned w) { return __uint_as_float(w << 16); }
__device__ __forceinline__ float bf_hi(unsigned w) { return __uint_as_float(w & 0xffff0000u); }
__device__ __forceinline__ float bf2f(bf16_t b) { return __uint_as_float(((unsigned)b) << 16); }
__device__ __forceinline__ float fast_exp(float x) { return __builtin_amdgcn_exp2f(x * 1.4426950408889634f); }
__device__ __forceinline__ float fast_sigmoid(float x) { return __builtin_amdgcn_rcpf(1.0f + __builtin_amdgcn_exp2f(-x * 1.4426950408889634f)); }
__device__ __forceinline__ float wave_sum(float v) {
#pragma unroll
    for (int o = 1; o < 64; o <<= 1) v += __shfl_xor(v, o);
    return v;
}
__device__ __forceinline__ unsigned pk4_fp8(float a, float b, float c, float d) { int w = 0; w = __builtin_amdgcn_cvt_pk_fp8_f32(a, b, w, false); w = __builtin_amdgcn_cvt_pk_fp8_f32(c, d, w, true); return (unsigned)w; }
constexpr float W8_SCALE = 256.0f, A8_SCALE = 4.0f, Y8_SCALE = 16.0f;
#define LDS_WAIT() asm volatile("s_waitcnt lgkmcnt(0)" ::: "memory")
#define VM_WAIT() asm volatile("s_waitcnt vmcnt(0)" ::: "memory")
#define RLX_AGENT __ATOMIC_RELAXED, __HIP_MEMORY_SCOPE_AGENT

namespace pg8 {
constexpr int BM = 256, BK = 64, HALF = 128, HTB = HALF * BK * 2, STAGE_BYTES = 8 * HTB, NXCD = 8, WGM = 8;
__host__ __device__ __forceinline__ int lds_byte(int r, int c) { const int st = (r >> 4) * 2 + (c >> 5), rr = r & 15, cc = c & 31, ob = rr * 64 + cc * 2; return st * 1024 + (ob ^ (((ob >> 9) & 1) << 5)); }
__host__ __device__ __forceinline__ void stage_rc(int b, int& R, int& C) { const int st = b / 1024, sb = b % 1024, swz = sb ^ (((sb >> 9) & 1) << 5); R = (st >> 1) * 16 + swz / 64; C = (st & 1) * 32 + (swz % 64) / 2; }
__host__ __device__ __forceinline__ int perm32(int rho) { const int n = rho >> 4, i = rho & 15; return 8 * (i >> 2) + 4 * n + (i & 3); }

struct Unit { int pm, pn, aux, cnt; };
typedef int v4i_t __attribute__((ext_vector_type(4)));
typedef int v8i_t __attribute__((ext_vector_type(8)));
__device__ __forceinline__ v8i_t ld_frag8(const LAS unsigned char* p) {
    const v4i_t lo = *(const LAS v4i_t*)p, hi = *(const LAS v4i_t*)(p + 1024);
    return __builtin_shufflevector(lo, hi, 0, 1, 2, 3, 4, 5, 6, 7);
}
template <bool FP8> struct FragT { typedef bf16x8 T[2]; };
template <> struct FragT<true> { typedef v8i_t T; };

struct DenseOrder {
    static constexpr bool GATHER = false, FP8 = false, DEPWAIT = false;
    const bf16_t* A; const bf16_t* Bt; int ldab, KB;
    int nM, nN, nwg, G, c;
    __device__ __forceinline__ void init(const bf16_t* A_, int lda_, const bf16_t* Bt_, int M, int N, int K_, int G_, int c_) { A = A_; ldab = lda_ * 2; Bt = Bt_; KB = K_ * 2; nM = M / BM; nN = N / BM; nwg = nM * nN; G = G_; c = c_; }
    __device__ __forceinline__ bool next(int i, Unit& u) const {
        const long L = (long)i * G + c; if (L >= nwg) return false;
        int wgid = (int)L; { const int q = nwg / NXCD, r = nwg % NXCD, xcd = wgid % NXCD, off = wgid / NXCD; wgid = (xcd < r ? xcd * (q + 1) : r * (q + 1) + (xcd - r) * q) + off; }
        const int nig = WGM * nN, gid = wgid / nig, fm = gid * WGM, gsz = (nM - fm) < WGM ? (nM - fm) : WGM;
        u.pm = fm + ((wgid % nig) % gsz); u.pn = (wgid % nig) / gsz; u.aux = 0; u.cnt = 0; return true;
    }
    __device__ __forceinline__ const char* a_ptr(const Unit& u) const { return (const char*)A + (size_t)u.pm * BM * ldab; }
    __device__ __forceinline__ unsigned a_off(const Unit&, int row, int colb) const { return (unsigned)(row * ldab + colb); }
    __device__ __forceinline__ int a_row(const Unit&, int row) const { return row; }
    __device__ __forceinline__ const char* b_ptr(const Unit& u) const { return (const char*)Bt + (size_t)u.pn * BM * KB; }
};

template <class Epi, class Sched>
__device__ __forceinline__ void gemm_phase(LAS unsigned char* lds, const Sched& S, const Epi& E) {
    const int tid = threadIdx.x, wid = __builtin_amdgcn_readfirstlane(tid >> 6), lane = tid & 63, wr = wid >> 2, wc = wid & 3, fr = lane & 15, fq = lane >> 4;
    int KB = S.KB; asm volatile("" : "+s"(KB));
    const int nt = KB / (BK * 2);
    int sR[2], sC[2]; unsigned voffB[2];
#pragma unroll
    for (int i = 0; i < 2; ++i) { int R, C; stage_rc(tid * 16 + i * 8192, R, C); sR[i] = R; sC[i] = 2 * C; const int Rb = (R & ~31) + perm32(R & 31); voffB[i] = (unsigned)(Rb * KB + 2 * C); }
    const size_t kstep = (size_t)(BK * 2);
    const size_t hstep = (size_t)HALF * KB;
    const unsigned ldsw = (unsigned)wid * 1024u;
    const int aoff = lds_byte(wr * 64 + fr, fq * 8), boff = lds_byte(wc * 32 + fr, fq * 8);
#define PG8_SA(b, h) (((b) * 2 + (h)) * HTB)
#define PG8_SB(b, h) ((4 + (b) * 2 + (h)) * HTB)
#define PG8_STAGE(bufoff, gbase, v0, v1) do { \
        __builtin_amdgcn_global_load_lds((const unsigned*)((const char*)(gbase) + (v0)), (LAS unsigned*)(lds + (bufoff) + ldsw), 16, 0, 0); \
        __builtin_amdgcn_global_load_lds((const unsigned*)((const char*)(gbase) + (v1)), (LAS unsigned*)(lds + (bufoff) + ldsw + 8192), 16, 0, 0); } while (0)
#define PG8_STAGEB(bufoff, gbase) PG8_STAGE(bufoff, gbase, voffB[0], voffB[1])
#define PG8_LDA(dst, b, h) do { _Pragma("unroll") for (int m = 0; m < 4; ++m) { if constexpr (Sched::FP8) dst[m] = ld_frag8(lds + PG8_SA(b, h) + aoff + m * 2048); \
        else { _Pragma("unroll") for (int k = 0; k < 2; ++k) dst[m][k] = *(const LAS bf16x8*)(lds + PG8_SA(b, h) + aoff + m * 2048 + k * 1024); } } } while (0)
#define PG8_LDB(dst, b, h) do { _Pragma("unroll") for (int n = 0; n < 2; ++n) { if constexpr (Sched::FP8) dst[n] = ld_frag8(lds + PG8_SB(b, h) + boff + n * 2048); \
        else { _Pragma("unroll") for (int k = 0; k < 2; ++k) dst[n][k] = *(const LAS bf16x8*)(lds + PG8_SB(b, h) + boff + n * 2048 + k * 1024); } } } while (0)
#define PG8_MMA(ai, bj, At, Bt) do { __builtin_amdgcn_s_setprio(1); _Pragma("unroll") for (int m = 0; m < 4; ++m) _Pragma("unroll") for (int n = 0; n < 2; ++n) { \
        if constexpr (Sched::FP8) acc[ai][bj][m][n] = __builtin_amdgcn_mfma_scale_f32_16x16x128_f8f6f4(Bt[n], At[m], acc[ai][bj][m][n], 0, 0, 0, 0x7F7F7F7F, 0, 0x7F7F7F7F); \
        else { _Pragma("unroll") for (int k = 0; k < 2; ++k) acc[ai][bj][m][n] = __builtin_amdgcn_mfma_f32_16x16x32_bf16(Bt[n][k], At[m][k], acc[ai][bj][m][n], 0, 0, 0); } } \
        __builtin_amdgcn_s_setprio(0); } while (0)
#define PG8_WAIT_V(n) asm volatile("s_waitcnt vmcnt(" #n ")" ::: "memory")
#define PG8_WAIT_L(n) asm volatile("s_waitcnt lgkmcnt(" #n ")" ::: "memory")
#define PG8_BAR __builtin_amdgcn_s_barrier()
#define PG8_SCHED __builtin_amdgcn_sched_barrier(0)
#define PG8_KITER(t) do { \
            const bool last = (t == nt - 2); \
            const char* a1 = cA + (size_t)(t + 1) * kstep; \
            const char* a2 = last ? nA : cA + (size_t)(t + 2) * kstep; const char* b2 = last ? nB : cB + (size_t)(t + 2) * kstep; \
            const char* a3 = a2 + kstep; const char* b3 = b2 + kstep; \
            PG8_LDB(B0, 0, 0); PG8_LDB(B1, 0, 1); PG8_SCHED; PG8_LDA(At, 0, 0); PG8_STAGE(PG8_SA(1, 1), a1, vc[1][0], vc[1][1]); \
            if constexpr (Sched::GATHER) { if (last) { \
                _Pragma("unroll") \
                for (int h = 0; h < 2; ++h) \
                _Pragma("unroll") \
                    for (int i = 0; i < 2; ++i) vc[h][i] = vn[h][i]; } } \
            PG8_WAIT_V(8); PG8_WAIT_L(0); PG8_BAR; PG8_MMA(0, 0, At, B0); PG8_MMA(0, 1, At, B1); PG8_BAR; PG8_SCHED; \
            PG8_LDA(At, 0, 1); PG8_STAGEB(PG8_SB(0, 0), b2); PG8_STAGEB(PG8_SB(0, 1), b2 + hstep); PG8_STAGE(PG8_SA(0, 0), a2, vc[0][0], vc[0][1]); \
            PG8_WAIT_V(8); PG8_WAIT_L(0); PG8_BAR; PG8_MMA(1, 0, At, B0); PG8_MMA(1, 1, At, B1); PG8_BAR; PG8_SCHED; \
            PG8_LDB(B0, 1, 0); PG8_LDB(B1, 1, 1); PG8_SCHED; PG8_LDA(At, 1, 0); PG8_STAGE(PG8_SA(0, 1), a2, vc[1][0], vc[1][1]); \
            PG8_WAIT_V(8); PG8_WAIT_L(0); PG8_BAR; PG8_MMA(0, 0, At, B0); PG8_MMA(0, 1, At, B1); PG8_BAR; PG8_SCHED; \
            PG8_LDA(At, 1, 1); PG8_STAGEB(PG8_SB(1, 0), b3); PG8_STAGEB(PG8_SB(1, 1), b3 + hstep); PG8_STAGE(PG8_SA(1, 0), a3, vc[0][0], vc[0][1]); \
            PG8_WAIT_V(8); PG8_WAIT_L(0); PG8_BAR; PG8_MMA(1, 0, At, B0); PG8_MMA(1, 1, At, B1); PG8_BAR; PG8_SCHED; \
        } while (0)
    Unit cur, nxt; int ui = 0;
    if (!S.next(0, cur)) return;
    f32x4 acc[2][2][4][2];
#pragma unroll
    for (int a = 0; a < 2; ++a)
#pragma unroll
        for (int b = 0; b < 2; ++b)
#pragma unroll
            for (int m = 0; m < 4; ++m)
#pragma unroll
                for (int n = 0; n < 2; ++n) acc[a][b][m][n] = (f32x4){0.f, 0.f, 0.f, 0.f};
    typename FragT<Sched::FP8>::T At[4], B0[2], B1[2];
    unsigned vc[2][2], vn[2][2];
#pragma unroll
    for (int h = 0; h < 2; ++h)
#pragma unroll
        for (int i = 0; i < 2; ++i) { vc[h][i] = S.a_off(cur, 128 * h + sR[i], sC[i]); asm volatile("" : "+v"(vc[h][i])); vn[h][i] = vc[h][i]; }
    const char* cA = S.a_ptr(cur); const char* cB = S.b_ptr(cur);
    if constexpr (Sched::DEPWAIT) S.wait_ready(cur);
    if constexpr (Epi::PREBIAS) { if (wid == 0) E.pre(cur, (LAS float*)(lds + STAGE_BYTES), lane); }
    PG8_STAGEB(PG8_SB(0, 0), cB); PG8_STAGEB(PG8_SB(0, 1), cB + hstep); PG8_STAGE(PG8_SA(0, 0), cA, vc[0][0], vc[0][1]); PG8_STAGE(PG8_SA(0, 1), cA, vc[1][0], vc[1][1]);
    if (wr == 1) PG8_BAR;
    PG8_WAIT_V(2); PG8_BAR;
    PG8_STAGEB(PG8_SB(1, 0), cB + kstep); PG8_STAGE(PG8_SA(1, 0), cA + kstep, vc[0][0], vc[0][1]); PG8_STAGEB(PG8_SB(1, 1), cB + hstep + kstep);
    PG8_WAIT_V(6); PG8_BAR;
    for (;;) {
        const bool has_next = S.next(ui + 1, nxt);
        const char* nA = has_next ? S.a_ptr(nxt) : cA; const char* nB = has_next ? S.b_ptr(nxt) : cB;
        if constexpr (Sched::GATHER) {
            if (has_next) {
                int tz = threadIdx.x; asm volatile("" : "+v"(tz));
#pragma unroll
                for (int h = 0; h < 2; ++h)
#pragma unroll
                    for (int i = 0; i < 2; ++i) { int R, C; stage_rc(tz * 16 + i * 8192, R, C); vn[h][i] = S.a_off(nxt, 128 * h + R, 2 * C); }
            }
        }
        if constexpr (Epi::MIDHOOK) {
            for (int t = 0; t < nt / 2; t += 2) PG8_KITER(t);
            { int tz = threadIdx.x; asm volatile("" : "+v"(tz)); const int we = tz >> 6, le = tz & 63; E.mid(acc, cur, we >> 2, we & 3, le & 15, le >> 4); }
            for (int t = nt / 2; t < nt; t += 2) PG8_KITER(t);
        } else if constexpr (Sched::DEPWAIT) {
            for (int t = 0; t < nt; t += 2) { if (t == nt - 2 && has_next) S.wait_ready(nxt); PG8_KITER(t); }
        } else { for (int t = 0; t < nt; t += 2) PG8_KITER(t); }
        if (wr == 0) PG8_BAR;
        { int tz = threadIdx.x; asm volatile("" : "+v"(tz)); const int we = tz >> 6, le = tz & 63;
          if constexpr (Epi::PREBIAS) E(acc, cur, we >> 2, we & 3, le & 15, le >> 4, (const LAS float*)(lds + STAGE_BYTES + (ui & 1) * 1024)); else E(acc, cur, we >> 2, we & 3, le & 15, le >> 4); }
        if (!has_next) break;
#pragma unroll
        for (int a = 0; a < 2; ++a)
#pragma unroll
            for (int b = 0; b < 2; ++b)
#pragma unroll
                for (int m = 0; m < 4; ++m)
#pragma unroll
                    for (int n = 0; n < 2; ++n) acc[a][b][m][n] = (f32x4){0.f, 0.f, 0.f, 0.f};
        cur = nxt; cA = nA; cB = nB; ++ui;
        if constexpr (Epi::PREBIAS) { if (wid == 0) E.pre(cur, (LAS float*)(lds + STAGE_BYTES + (ui & 1) * 1024), lane); }
        if (wr == 1) PG8_BAR;
    }
    PG8_WAIT_V(0);
    PG8_BAR;
#undef PG8_SA
#undef PG8_SB
#undef PG8_STAGE
#undef PG8_STAGEB
#undef PG8_LDA
#undef PG8_LDB
#undef PG8_MMA
#undef PG8_WAIT_V
#undef PG8_WAIT_L
#undef PG8_BAR
#undef PG8_SCHED
#undef PG8_KITER
}

template <class Epi, class Sched>
__device__ __forceinline__ void gemm_phase_b3(LAS unsigned char* lds, const Sched& S, const Epi& E) {
    const int tid = threadIdx.x, wid = __builtin_amdgcn_readfirstlane(tid >> 6), lane = tid & 63, wr = wid >> 2, wc = wid & 3, fr = lane & 15, fq = lane >> 4;
    const bool roleB = wc < 2; const int jr = wr * 2 + (wc & 1);
    int KB = S.KB; asm volatile("" : "+s"(KB));
    const int nt = KB / (BK * 2);
    constexpr int B_BASE = 5 * HTB, B_STAGE = 2 * HTB, BIAS_OFF = B_BASE + 2 * B_STAGE;
    const size_t kstep = (size_t)(BK * 2), hstep = (size_t)HALF * KB;
    const int aoff = lds_byte(wr * 64 + fr, fq * 8), boff = lds_byte(wc * 32 + fr, fq * 8);
    const unsigned pw = (unsigned)jr * 1024u;
    unsigned vs[8];
    LAS u32x4* park = (LAS u32x4*)(lds + BIAS_OFF + 2048) + tid;
#pragma unroll
    for (int i = 0; i < 4; ++i) { int R, C; stage_rc((jr + 4 * i) * 1024 + lane * 16, R, C); const int Rb = (R & ~31) + perm32(R & 31); vs[i] = (unsigned)(Rb * KB + 2 * C); vs[4 + i] = 0u; }
#define B3_STAGE4(ldsoff, gbase, v) do { _Pragma("unroll") for (int i_ = 0; i_ < 4; ++i_) \
        __builtin_amdgcn_global_load_lds((const unsigned*)((const char*)(gbase) + (v)[i_]), (LAS unsigned*)(lds + (ldsoff) + pw + 4096 * i_), 16, 0, 0); } while (0)
#define B3_LDA(dst, base) do { _Pragma("unroll") for (int m = 0; m < 4; ++m) { if constexpr (Sched::FP8) dst[m] = ld_frag8(lds + (base) + aoff + m * 2048); \
        else { _Pragma("unroll") for (int k = 0; k < 2; ++k) dst[m][k] = *(const LAS bf16x8*)(lds + (base) + aoff + m * 2048 + k * 1024); } } } while (0)
#define B3_LDB(dst, base) do { _Pragma("unroll") for (int n = 0; n < 2; ++n) { if constexpr (Sched::FP8) dst[n] = ld_frag8(lds + (base) + boff + n * 2048); \
        else { _Pragma("unroll") for (int k = 0; k < 2; ++k) dst[n][k] = *(const LAS bf16x8*)(lds + (base) + boff + n * 2048 + k * 1024); } } } while (0)
#define B3_MMA(ai, bj, At, Bt) do { __builtin_amdgcn_s_setprio(1); _Pragma("unroll") for (int m = 0; m < 4; ++m) _Pragma("unroll") for (int n = 0; n < 2; ++n) { \
        if constexpr (Sched::FP8) acc[ai][bj][m][n] = __builtin_amdgcn_mfma_scale_f32_16x16x128_f8f6f4(Bt[n], At[m], acc[ai][bj][m][n], 0, 0, 0, 0x7F7F7F7F, 0, 0x7F7F7F7F); \
        else { _Pragma("unroll") for (int k = 0; k < 2; ++k) acc[ai][bj][m][n] = __builtin_amdgcn_mfma_f32_16x16x32_bf16(Bt[n][k], At[m][k], acc[ai][bj][m][n], 0, 0, 0); } } \
        __builtin_amdgcn_s_setprio(0); } while (0)
#define B3_PIN(ai) do { _Pragma("unroll") for (int b_ = 0; b_ < 2; ++b_) _Pragma("unroll") for (int m_ = 0; m_ < 4; ++m_) \
        asm volatile("" : "+v"(acc[ai][b_][m_][0]), "+v"(acc[ai][b_][m_][1])); } while (0)
#define B3_WAIT_L0 asm volatile("s_waitcnt lgkmcnt(0)" ::: "memory")
#define B3_BAR __builtin_amdgcn_s_barrier()
#define B3_SCHED __builtin_amdgcn_sched_barrier(0)
    Unit cur, nxt; int ui = 0;
    if (!S.next(0, cur)) return;
    f32x4 acc[2][2][4][2];
#pragma unroll
    for (int a = 0; a < 2; ++a)
#pragma unroll
        for (int b = 0; b < 2; ++b)
#pragma unroll
            for (int m = 0; m < 4; ++m)
#pragma unroll
                for (int n = 0; n < 2; ++n) acc[a][b][m][n] = (f32x4){0.f, 0.f, 0.f, 0.f};
    typename FragT<Sched::FP8>::T At[4], B0[2], B1[2];
#define B3_ROWS(dst, U_) do { int tz_ = threadIdx.x; asm volatile("" : "+v"(tz_)); const int jr_ = ((tz_ >> 8) & 1) * 2 + ((tz_ >> 6) & 1), ln_ = tz_ & 63; \
        _Pragma("unroll") for (int h_ = 0; h_ < 2; ++h_) _Pragma("unroll") for (int i_ = 0; i_ < 4; i_ += 2) { int R0_, C0_, R1_, C1_; stage_rc((jr_ + 4 * i_) * 1024 + ln_ * 16, R0_, C0_); stage_rc((jr_ + 4 * i_ + 4) * 1024 + ln_ * 16, R1_, C1_); \
            dst[h_ * 2 + (i_ >> 1)] = (unsigned)S.a_row(U_, 128 * h_ + R0_) | ((unsigned)S.a_row(U_, 128 * h_ + R1_) << 16); } } while (0)
#define B3_UNPACK(srcp) do { int tz_ = threadIdx.x; asm volatile("" : "+v"(tz_)); const int jr_ = ((tz_ >> 8) & 1) * 2 + ((tz_ >> 6) & 1), ln_ = tz_ & 63; \
        _Pragma("unroll") for (int h_ = 0; h_ < 2; ++h_) _Pragma("unroll") for (int i_ = 0; i_ < 4; ++i_) { int R_, C_; stage_rc((jr_ + 4 * i_) * 1024 + ln_ * 16, R_, C_); \
            const unsigned rw_ = (srcp[h_ * 2 + (i_ >> 1)] >> ((i_ & 1) * 16)) & 0xffffu; vs[h_ * 4 + i_] = rw_ * (unsigned)S.ldab + 2u * (unsigned)C_; } } while (0)
    if (!roleB) { if constexpr (Sched::DEPWAIT) S.wait_ready(cur); unsigned vnp[4]; B3_ROWS(vnp, cur); B3_UNPACK(vnp); *park = (u32x4){vnp[0], vnp[1], vnp[2], vnp[3]}; }
    const char* cA = S.a_ptr(cur); const char* cB = S.b_ptr(cur);
    if constexpr (Epi::PREBIAS) { if (wid == 0) E.pre(cur, (LAS float*)(lds + BIAS_OFF), lane); }
    if (roleB) {
#pragma unroll
        for (int s = 0; s < 2; ++s) { B3_STAGE4(B_BASE + s * B_STAGE, cB + s * kstep, vs); B3_STAGE4(B_BASE + s * B_STAGE + HTB, cB + s * kstep + hstep, vs); }
    } else { B3_STAGE4(0, cA, vs); B3_STAGE4(HTB, cA, (vs + 4)); B3_STAGE4(2 * HTB, cA + kstep, vs); B3_STAGE4(3 * HTB, cA + kstep, (vs + 4)); }
    if (wr == 1) B3_BAR;
    asm volatile("s_waitcnt vmcnt(0)" ::: "memory"); B3_BAR; B3_BAR;
    int aL = 0, sB = 0;
    for (;;) {
        const bool has_next = S.next(ui + 1, nxt);
        const char* nA = has_next ? S.a_ptr(nxt) : cA; const char* nB = has_next ? S.b_ptr(nxt) : cB;
        if (has_next && !roleB) { unsigned vnp[4]; B3_ROWS(vnp, nxt); *park = (u32x4){vnp[0], vnp[1], vnp[2], vnp[3]}; }
        for (int t = 0; t < nt; ++t) {
            const bool lastt = (t == nt - 2);
            if constexpr (Epi::MIDHOOK) { if (t == nt / 2) { int tz = threadIdx.x; asm volatile("" : "+v"(tz)); const int we = tz >> 6, le = tz & 63; E.mid(acc, cur, we >> 2, we & 3, le & 15, le >> 4); } }
            if (lastt && !roleB) { if constexpr (Sched::DEPWAIT) { if (has_next) S.wait_ready(nxt); } const u32x4 pk = *park; const unsigned vnp[4] = {pk.x, pk.y, pk.z, pk.w}; B3_UNPACK(vnp); }
            const char* aSrc = (t + 2 < nt) ? cA + (size_t)(t + 2) * kstep : nA + (size_t)(t + 2 - nt) * kstep;
            const char* bSrc = (t + 2 < nt) ? cB + (size_t)(t + 2) * kstep : nB + (size_t)(t + 2 - nt) * kstep;
            const int aU = aL == 4 ? 0 : aL + 1, aN = aL == 0 ? 4 : aL - 1;
            const int bb = B_BASE + sB * B_STAGE;
            B3_LDB(B0, bb); B3_LDB(B1, bb + HTB); B3_SCHED; B3_LDA(At, aL * HTB);
            if (!roleB) { B3_STAGE4(aN * HTB, aSrc, vs); asm volatile("s_waitcnt vmcnt(12)" ::: "memory"); }
            B3_WAIT_L0; B3_BAR; B3_MMA(0, 0, At, B0); B3_MMA(0, 1, At, B1); B3_PIN(0); B3_BAR; B3_SCHED;
            B3_LDA(At, aU * HTB);
            if (!roleB) { B3_STAGE4(aL * HTB, aSrc, (vs + 4)); asm volatile("s_waitcnt vmcnt(12)" ::: "memory"); }
            else { B3_STAGE4(bb, bSrc, vs); B3_STAGE4(bb + HTB, bSrc + hstep, vs); asm volatile("s_waitcnt vmcnt(8)" ::: "memory"); }
            B3_WAIT_L0; B3_BAR; B3_MMA(1, 0, At, B0); B3_MMA(1, 1, At, B1); B3_PIN(1); B3_BAR; B3_SCHED;
            aL = aL >= 3 ? aL - 3 : aL + 2; sB ^= 1;
        }
        if (wr == 0) B3_BAR;
        { int tz = threadIdx.x; asm volatile("" : "+v"(tz)); const int we = tz >> 6, le = tz & 63;
          if constexpr (Epi::PREBIAS) E(acc, cur, we >> 2, we & 3, le & 15, le >> 4, (const LAS float*)(lds + BIAS_OFF + (ui & 1) * 1024)); else E(acc, cur, we >> 2, we & 3, le & 15, le >> 4); }
        if (!has_next) break;
#pragma unroll
        for (int a = 0; a < 2; ++a)
#pragma unroll
            for (int b = 0; b < 2; ++b)
#pragma unroll
                for (int m = 0; m < 4; ++m)
#pragma unroll
                    for (int n = 0; n < 2; ++n) acc[a][b][m][n] = (f32x4){0.f, 0.f, 0.f, 0.f};
        cur = nxt; cA = nA; cB = nB; ++ui;
        if constexpr (Epi::PREBIAS) { if (wid == 0) E.pre(cur, (LAS float*)(lds + BIAS_OFF + (ui & 1) * 1024), lane); }
        if (wr == 1) B3_BAR;
    }
    asm volatile("s_waitcnt vmcnt(0)" ::: "memory");
    B3_BAR;
#undef B3_STAGE4
#undef B3_LDA
#undef B3_LDB
#undef B3_MMA
#undef B3_WAIT_L0
#undef B3_PIN
#undef B3_BAR
#undef B3_SCHED
#undef B3_ROWS
#undef B3_UNPACK
}
}

namespace epi {
using pg8::Unit; using pg8::BM; using pg8::HALF;
typedef f32x4 Acc[2][2][4][2];
#define EPI_ROWS_COLS const int row0 = u.pm * BM + wr * 64 + fr, col0 = u.pn * BM + wc * 32 + 8 * fq
__device__ __forceinline__ u32x4 pack8(f32x4 v0, f32x4 v1) { u32x4 w; w.x = cvt_pk_bf16(v0[0], v0[1]); w.y = cvt_pk_bf16(v0[2], v0[3]); w.z = cvt_pk_bf16(v1[0], v1[1]); w.w = cvt_pk_bf16(v1[2], v1[3]); return w; }

struct Bf16Plain {
    static constexpr bool PREBIAS = false;
    static constexpr bool MIDHOOK = false;
    bf16_t* O; int ldc;
    __device__ __forceinline__ void operator()(const Acc& acc, const Unit& u, int wr, int wc, int fr, int fq) const {
        EPI_ROWS_COLS;
#pragma unroll
        for (int ai = 0; ai < 2; ++ai)
#pragma unroll
            for (int m = 0; m < 4; ++m) { bf16_t* rowp = O + (size_t)(row0 + ai * HALF + m * 16) * ldc + col0;
#pragma unroll
                for (int bj = 0; bj < 2; ++bj) *(u32x4*)(rowp + bj * HALF) = pack8(acc[ai][bj][m][0], acc[ai][bj][m][1]); }
    }
};
struct Bf16RowScale {
    static constexpr bool PREBIAS = false;
    static constexpr bool MIDHOOK = false;
    bf16_t* O; int ldc; const float* rs;
    __device__ __forceinline__ void operator()(const Acc& acc, const Unit& u, int wr, int wc, int fr, int fq) const {
        const int row0 = u.pm * BM + wr * 64 + fr, cin = wc * 32 + 8 * fq;
#pragma unroll
        for (int ai = 0; ai < 2; ++ai)
#pragma unroll
            for (int m = 0; m < 4; ++m) { const int row = row0 + ai * HALF + m * 16; const float sc = rs[row]; const int bb = row / SEQ, ss = row % SEQ;
                bf16_t* rowp = O + ((size_t)(bb * MLA_H + u.pn) * SEQ + ss) * 256 + cin;
#pragma unroll
                for (int bj = 0; bj < 2; ++bj) *(u32x4*)(rowp + bj * HALF) = pack8(acc[ai][bj][m][0] * sc, acc[ai][bj][m][1] * sc); }
    }
};
struct QRope {
    static constexpr bool PREBIAS = false;
    static constexpr bool MIDHOOK = false;
    bf16_t* O; const float* rs; const float* cs;
    __device__ __forceinline__ void operator()(const Acc& acc, const Unit& u, int wr, int wc, int fr, int fq) const {
        EPI_ROWS_COLS;
#pragma unroll
        for (int ai = 0; ai < 2; ++ai)
#pragma unroll
            for (int m = 0; m < 4; ++m) { const int row = row0 + ai * HALF + m * 16; const float s = rs[row]; bf16_t* rowp = O + (size_t)row * NQ + col0;
#pragma unroll
                for (int bj = 0; bj < 2; ++bj) {
                    f32x4 v0 = acc[ai][bj][m][0] * s, v1 = acc[ai][bj][m][1] * s;
                    const int c = col0 + bj * HALF, o = c % MLA_QK;
                    if (o >= MLA_NOPE) { const int i0 = (o - MLA_NOPE) >> 1; const f32x4* t = (const f32x4*)(cs + ((size_t)row * 32 + i0) * 2);
                        const f32x4 t0 = t[0], t1 = t[1];
                        f32x4 r0, r1;
                        r0[0] = v0[0] * t0[0] - v0[1] * t0[1]; r0[1] = v0[0] * t0[1] + v0[1] * t0[0];
                        r0[2] = v0[2] * t0[2] - v0[3] * t0[3]; r0[3] = v0[2] * t0[3] + v0[3] * t0[2];
                        r1[0] = v1[0] * t1[0] - v1[1] * t1[1]; r1[1] = v1[0] * t1[1] + v1[1] * t1[0];
                        r1[2] = v1[2] * t1[2] - v1[3] * t1[3]; r1[3] = v1[2] * t1[3] + v1[3] * t1[2];
                        v0 = r0; v1 = r1; }
                    *(u32x4*)(rowp + bj * HALF) = pack8(v0, v1); } }
    }
};
struct GateStoreF32 {
    static constexpr bool PREBIAS = false;
    static constexpr bool MIDHOOK = false;
    float* M1; const bf16_t* proj; int gcol;
    __device__ __forceinline__ void operator()(const Acc& acc, const Unit& u, int wr, int wc, int fr, int fq) const {
        EPI_ROWS_COLS;
#pragma unroll
        for (int ai = 0; ai < 2; ++ai)
#pragma unroll
            for (int m = 0; m < 4; ++m) { const int row = row0 + ai * HALF + m * 16;
#pragma unroll
                for (int bj = 0; bj < 2; ++bj) { const int c = col0 + bj * HALF;
                    const u32x4 g = *(const u32x4*)(proj + (size_t)row * DINP + gcol + c);
                    f32x4 s0 = {fast_sigmoid(bf_lo(g.x)), fast_sigmoid(bf_hi(g.x)), fast_sigmoid(bf_lo(g.y)), fast_sigmoid(bf_hi(g.y))};
                    f32x4 s1 = {fast_sigmoid(bf_lo(g.z)), fast_sigmoid(bf_hi(g.z)), fast_sigmoid(bf_lo(g.w)), fast_sigmoid(bf_hi(g.w))};
                    float* p = M1 + (size_t)row * DM + c;
                    *(f32x4*)p = acc[ai][bj][m][0] * s0; *(f32x4*)(p + 4) = acc[ai][bj][m][1] * s1; } }
    }
};
struct GateMergeBf16 {
    static constexpr bool PREBIAS = false;
    static constexpr bool MIDHOOK = false;
    bf16_t* O; const float* M1; const bf16_t* proj; int gcol;
    __device__ __forceinline__ void operator()(const Acc& acc, const Unit& u, int wr, int wc, int fr, int fq) const {
        EPI_ROWS_COLS;
#pragma unroll
        for (int ai = 0; ai < 2; ++ai)
#pragma unroll
            for (int m = 0; m < 4; ++m) { const int row = row0 + ai * HALF + m * 16;
#pragma unroll
                for (int bj = 0; bj < 2; ++bj) { const int c = col0 + bj * HALF;
                    const u32x4 g = *(const u32x4*)(proj + (size_t)row * DINP + gcol + c);
                    f32x4 s0 = {fast_sigmoid(bf_lo(g.x)), fast_sigmoid(bf_hi(g.x)), fast_sigmoid(bf_lo(g.y)), fast_sigmoid(bf_hi(g.y))};
                    f32x4 s1 = {fast_sigmoid(bf_lo(g.z)), fast_sigmoid(bf_hi(g.z)), fast_sigmoid(bf_lo(g.w)), fast_sigmoid(bf_hi(g.w))};
                    const float* p = M1 + (size_t)row * DM + c;
                    const f32x4 a0 = *(const f32x4*)p, a1 = *(const f32x4*)(p + 4);
                    *(u32x4*)(O + (size_t)row * DM + c) = pack8(a0 + acc[ai][bj][m][0] * s0, a1 + acc[ai][bj][m][1] * s1); } }
    }
};
struct GateMerge2 {
    static constexpr bool PREBIAS = false;
    static constexpr bool MIDHOOK = true;
    bf16_t* O; const bf16_t* proj;
    __device__ __forceinline__ void mid(Acc& acc, const Unit& u, int wr, int wc, int fr, int fq) const {
        EPI_ROWS_COLS;
#pragma unroll
        for (int ai = 0; ai < 2; ++ai)
#pragma unroll
            for (int m = 0; m < 4; ++m) { const int row = row0 + ai * HALF + m * 16;
#pragma unroll
                for (int bj = 0; bj < 2; ++bj) { const int c = col0 + bj * HALF;
                    const u32x4 ga = __builtin_nontemporal_load((const u32x4*)(proj + (size_t)row * DINP + C_GA + c)), gb = *(const u32x4*)(proj + (size_t)row * DINP + C_GB + c);
                    const float a[8] = {bf_lo(ga.x), bf_hi(ga.x), bf_lo(ga.y), bf_hi(ga.y), bf_lo(ga.z), bf_hi(ga.z), bf_lo(ga.w), bf_hi(ga.w)};
                    const float b[8] = {bf_lo(gb.x), bf_hi(gb.x), bf_lo(gb.y), bf_hi(gb.y), bf_lo(gb.z), bf_hi(gb.z), bf_lo(gb.w), bf_hi(gb.w)};
#pragma unroll
                    for (int j = 0; j < 8; ++j) { const float eb = __builtin_amdgcn_exp2f(-fmaxf(b[j], -30.0f) * 1.4426950408889634f);
                        const float q = (1.0f + eb) * fast_sigmoid(a[j]);
                        if (j < 4) acc[ai][bj][m][0][j] *= q; else acc[ai][bj][m][1][j - 4] *= q; } } }
    }
    __device__ __forceinline__ void operator()(const Acc& acc, const Unit& u, int wr, int wc, int fr, int fq) const {
        EPI_ROWS_COLS;
#pragma unroll
        for (int ai = 0; ai < 2; ++ai)
#pragma unroll
            for (int m = 0; m < 4; ++m) { const int row = row0 + ai * HALF + m * 16;
#pragma unroll
                for (int bj = 0; bj < 2; ++bj) { const int c = col0 + bj * HALF;
                    const u32x4 g = *(const u32x4*)(proj + (size_t)row * DINP + C_GB + c);
                    f32x4 s0 = {fast_sigmoid(fmaxf(bf_lo(g.x), -30.0f)), fast_sigmoid(fmaxf(bf_hi(g.x), -30.0f)), fast_sigmoid(fmaxf(bf_lo(g.y), -30.0f)), fast_sigmoid(fmaxf(bf_hi(g.y), -30.0f))};
                    f32x4 s1 = {fast_sigmoid(fmaxf(bf_lo(g.z), -30.0f)), fast_sigmoid(fmaxf(bf_hi(g.z), -30.0f)), fast_sigmoid(fmaxf(bf_lo(g.w), -30.0f)), fast_sigmoid(fmaxf(bf_hi(g.w), -30.0f))};
                    *(u32x4*)(O + (size_t)row * DM + c) = pack8(acc[ai][bj][m][0] * s0, acc[ai][bj][m][1] * s1); } }
    }
};
struct ResidGateF32 {
    static constexpr bool PREBIAS = false;
    static constexpr bool MIDHOOK = false;
    float* X1; const float* x; const float* gate;
    __device__ __forceinline__ void operator()(const Acc& acc, const Unit& u, int wr, int wc, int fr, int fq) const {
        EPI_ROWS_COLS;
        const float* gb = gate + (size_t)((u.pm * BM) / SEQ) * (6 * DM);
#pragma unroll
        for (int bj = 0; bj < 2; ++bj) { const int c = col0 + bj * HALF; const f32x4 g0 = *(const f32x4*)(gb + c), g1 = *(const f32x4*)(gb + c + 4);
#pragma unroll
            for (int ai = 0; ai < 2; ++ai)
#pragma unroll
                for (int m = 0; m < 4; ++m) { const int row = row0 + ai * HALF + m * 16; const float* xp = x + (size_t)row * DM + c; float* op = X1 + (size_t)row * DM + c;
                    const f32x4 x0 = __builtin_nontemporal_load((const f32x4*)xp), x1 = __builtin_nontemporal_load((const f32x4*)(xp + 4));
                    *(f32x4*)op = x0 + g0 * acc[ai][bj][m][0]; *(f32x4*)(op + 4) = x1 + g1 * acc[ai][bj][m][1]; } }
    }
};
struct SwiGlu {
    static constexpr bool MIDHOOK = false, PREBIAS = true;
    unsigned char* ACT; const float* b1;
    __device__ __forceinline__ void pre(const Unit& u, LAS float* dst, int lane) const {
        __builtin_amdgcn_global_load_lds((const unsigned*)(b1 + (size_t)u.aux * (2 * DEXP) + u.pn * BM + 4 * lane), (LAS unsigned*)dst, 16, 0, 0); }
    __device__ __forceinline__ void operator()(const Acc& acc, const Unit& u, int wr, int wc, int fr, int fq, const LAS float* bl) const {
        EPI_ROWS_COLS;
#pragma unroll
        for (int bj = 0; bj < 2; ++bj) { const int c = col0 + bj * HALF, cl = wc * 32 + 8 * fq + bj * HALF; const f32x4 bb0 = *(const LAS f32x4*)(bl + cl), bb1 = *(const LAS f32x4*)(bl + cl + 4);
#pragma unroll
            for (int ai = 0; ai < 2; ++ai)
#pragma unroll
                for (int m = 0; m < 4; ++m) { const int row = row0 + ai * HALF + m * 16;
                    const float un = 1.0f / (W8_SCALE * A8_SCALE);
                    const f32x4 v0 = acc[ai][bj][m][0] * un + bb0, v1 = acc[ai][bj][m][1] * un + bb1;
                    float o[4];
#pragma unroll
                    for (int p = 0; p < 4; ++p) { const float g = fminf(p < 2 ? v0[2 * p] : v1[2 * p - 4], 7.0f); float l = p < 2 ? v0[2 * p + 1] : v1[2 * p - 3]; l = fminf(fmaxf(l, -7.0f), 7.0f);
                        o[p] = g * fast_sigmoid(1.702f * g) * (l + 1.0f); }
                    *(unsigned*)(ACT + (size_t)row * DEXP + (c >> 1)) = pk4_fp8(o[0] * A8_SCALE, o[1] * A8_SCALE, o[2] * A8_SCALE, o[3] * A8_SCALE); } }
    }
};
struct BiasBf16 {
    static constexpr bool MIDHOOK = false, PREBIAS = true;
    unsigned char* Y; const float* b2;
    __device__ __forceinline__ void pre(const Unit& u, LAS float* dst, int lane) const {
        __builtin_amdgcn_global_load_lds((const unsigned*)(b2 + (size_t)u.aux * DM + u.pn * BM + 4 * lane), (LAS unsigned*)dst, 16, 0, 0); }
    __device__ __forceinline__ void operator()(const Acc& acc, const Unit& u, int wr, int wc, int fr, int fq, const LAS float* bl) const {
        EPI_ROWS_COLS;
#pragma unroll
        for (int bj = 0; bj < 2; ++bj) { const int c = col0 + bj * HALF, cl = wc * 32 + 8 * fq + bj * HALF; const f32x4 bb0 = *(const LAS f32x4*)(bl + cl) * Y8_SCALE, bb1 = *(const LAS f32x4*)(bl + cl + 4) * Y8_SCALE;
#pragma unroll
            for (int ai = 0; ai < 2; ++ai)
#pragma unroll
                for (int m = 0; m < 4; ++m) { const int row = row0 + ai * HALF + m * 16;
                    const float un = Y8_SCALE / (W8_SCALE * A8_SCALE);
                    const f32x4 v0 = acc[ai][bj][m][0] * un + bb0, v1 = acc[ai][bj][m][1] * un + bb1;
                    u32x2 w; w.x = pk4_fp8(v0[0], v0[1], v0[2], v0[3]); w.y = pk4_fp8(v1[0], v1[1], v1[2], v1[3]);
                    *(u32x2*)(Y + (size_t)row * DM + c) = w; } }
    }
};

struct MoeEpi {
    static constexpr bool MIDHOOK = false, PREBIAS = true;
    unsigned char* ACT; const float* b1; unsigned char* Y; const float* b2; unsigned* blk;
    __device__ __forceinline__ void pre(const Unit& u, LAS float* dst, int lane) const {
        const int e = u.aux & 255; const float* src = (u.aux >> 8) ? b2 + (size_t)e * DM + u.pn * BM + 4 * lane : b1 + (size_t)e * (2 * DEXP) + u.pn * BM + 4 * lane;
        __builtin_amdgcn_global_load_lds((const unsigned*)src, (LAS unsigned*)dst, 16, 0, 0); }
    __device__ __forceinline__ void operator()(const Acc& acc, const Unit& u, int wr, int wc, int fr, int fq, const LAS float* bl) const {
        EPI_ROWS_COLS;
        if ((u.aux >> 8) == 0) {
#pragma unroll
            for (int bj = 0; bj < 2; ++bj) { const int c = col0 + bj * HALF, cl = wc * 32 + 8 * fq + bj * HALF; const f32x4 bb0 = *(const LAS f32x4*)(bl + cl), bb1 = *(const LAS f32x4*)(bl + cl + 4);
                const f32x4 bg = {bb0[0], bb0[2], bb1[0], bb1[2]}, bv = {bb0[1], bb0[3], bb1[1], bb1[3]};
#pragma unroll
                for (int ai = 0; ai < 2; ++ai)
#pragma unroll
                    for (int m = 0; m < 4; ++m) { const int row = row0 + ai * HALF + m * 16;
                        const float un = 1.0f / (W8_SCALE * A8_SCALE);
                        f32x4 g = acc[ai][bj][m][0] * un + bg, l = acc[ai][bj][m][1] * un + bv, e, r;
#pragma unroll
                        for (int p = 0; p < 4; ++p) { g[p] = fminf(g[p], 7.0f); l[p] = fminf(fmaxf(l[p], -7.0f), 7.0f); }
                        const f32x4 t = g * (-1.702f * 1.4426950408889634f);
#pragma unroll
                        for (int p = 0; p < 4; ++p) e[p] = __builtin_amdgcn_exp2f(t[p]);
                        const f32x4 d = e + 1.0f;
#pragma unroll
                        for (int p = 0; p < 4; ++p) r[p] = __builtin_amdgcn_rcpf(d[p]);
                        const f32x4 o = (g * (l * A8_SCALE + A8_SCALE)) * r;
                        __hip_atomic_store((unsigned*)(ACT + (size_t)row * DEXP + (c >> 1)), pk4_fp8(o[0], o[1], o[2], o[3]), __ATOMIC_RELAXED, __HIP_MEMORY_SCOPE_AGENT); } }
            asm volatile("s_waitcnt vmcnt(0)" ::: "memory");
            if (fr == 0 && fq == 0) __hip_atomic_fetch_add(blk + u.pm, 1u, __ATOMIC_RELAXED, __HIP_MEMORY_SCOPE_AGENT);
        } else {
#pragma unroll
            for (int bj = 0; bj < 2; ++bj) { const int c = col0 + bj * HALF, cl = wc * 32 + 8 * fq + bj * HALF; const f32x4 bb0 = *(const LAS f32x4*)(bl + cl) * Y8_SCALE, bb1 = *(const LAS f32x4*)(bl + cl + 4) * Y8_SCALE;
#pragma unroll
                for (int ai = 0; ai < 2; ++ai)
#pragma unroll
                    for (int m = 0; m < 4; ++m) { const int row = row0 + ai * HALF + m * 16;
                        const float un = Y8_SCALE / (W8_SCALE * A8_SCALE);
                        const f32x4 v0 = acc[ai][bj][m][0] * un + bb0, v1 = acc[ai][bj][m][1] * un + bb1;
                        u32x2 w; w.x = pk4_fp8(v0[0], v0[1], v0[2], v0[3]); w.y = pk4_fp8(v1[0], v1[1], v1[2], v1[3]);
                        *(u32x2*)(Y + (size_t)row * DM + c) = w; } }
        }
    }
};
#undef EPI_ROWS_COLS
}

constexpr size_t MiB = 1u << 20;
constexpr size_t WS_CTL = 0, CTL_ZERO_BYTES = 64 * 1024;
constexpr size_t WS_MOD = 512 * 1024;
constexpr size_t WS_FMOD = 640 * 1024;
constexpr size_t WS_RW = 1 * MiB + 256 * 1024;
constexpr size_t WS_RC = 1 * MiB + 768 * 1024;
constexpr size_t WS_RSQ = 1 * MiB + 800 * 1024;
constexpr size_t WS_RSKV = 1 * MiB + 832 * 1024;
constexpr size_t WS_CS = 2 * MiB;
constexpr size_t WS_TOPI = 4 * MiB;
constexpr size_t WS_TOPW = 4 * MiB + 256 * 1024;
constexpr size_t WS_ROWMAP = 5 * MiB;
constexpr size_t WS_DLAST = 6 * MiB;
constexpr size_t WS_KPE = 7 * MiB;
constexpr size_t WS_WQ = 8 * MiB, WS_WKV = 10 * MiB, WS_WOM = 12 * MiB, WS_WOUT = 20 * MiB, WS_WIN = 32 * MiB;
constexpr size_t WS_W1 = 64 * MiB, WS_W2 = 576 * MiB;
constexpr size_t WS_H = 832 * MiB;
constexpr size_t WS_PROJ = 864 * MiB;
constexpr size_t WS_Q = 992 * MiB, WS_KV = 1016 * MiB;
constexpr size_t WS_GCUM = 1048 * MiB;
constexpr size_t WS_UT = 1064 * MiB;
constexpr size_t WS_ST = 1128 * MiB;
constexpr size_t WS_ATTO = 1160 * MiB;
constexpr int BR_LD = 2048;
constexpr size_t WS_M1 = 1192 * MiB;
constexpr size_t WS_MERGED = 1256 * MiB;
constexpr size_t WS_X1 = 1288 * MiB;
constexpr size_t WS_ACT = 1352 * MiB;
constexpr size_t WS_Y = 2376 * MiB;
constexpr size_t WS_END = 3400 * MiB;
constexpr int CW_TMO = 0, CW_CODE = 1, CW_BAR = 4096, CW_CNT = 8192  , CW_GQ = 12288  , CW_GEMV = 12352  , CW_BLK = 13312  ;

constexpr int NWAVES = 8;
constexpr int RING_BYTES = 131072, LDSCTL_OFF = 161792, LDS_BYTES = 163840;
constexpr int LW_BAR = 0, LW_TMP = 4, LW_NBLK = 16, LW_USTART = 48, LW_CNT = 96, LW_UNITS = 192  ;

#define XB_TMO      128
#define XB_XCNT(j)  (256  + 64 * (j))
#define XB_XSUB(j)  (1280 + 64 * (j))
#define XB_XGEN(j)  (2304 + 64 * (j))
#define XB_TOP      3328
#define XB_TOPGEN   3392
#define XCD_BAR_WORDS 3456
#define XB_SPIN_CAP (1u << 18)
__device__ __forceinline__ unsigned xb_ld(unsigned* p)              { return __hip_atomic_load(p, __ATOMIC_RELAXED, __HIP_MEMORY_SCOPE_AGENT); }
__device__ __forceinline__ unsigned xb_add(unsigned* p, unsigned v) { return __hip_atomic_fetch_add(p, v, __ATOMIC_RELAXED, __HIP_MEMORY_SCOPE_AGENT); }
__device__ __forceinline__ unsigned xb_xcc_id() { return (unsigned)__builtin_amdgcn_s_getreg((3 << 11) | 20) & 0xFu; }
#define XB_SPIN(cond, bar) do { unsigned _sp = 0; while (cond) { __builtin_amdgcn_s_sleep(1); \
    if ((++_sp & 255u) == 0u) { if (xb_ld(&(bar)[XB_TMO])) break; if (_sp > XB_SPIN_CAP) { atomicAdd(&(bar)[XB_TMO], 1u); break; } } } } while (0)
struct XcdBarrier { unsigned* bar; unsigned x; volatile LAS unsigned* st; };
__device__ __forceinline__ XcdBarrier xcd_barrier_post(unsigned* bar, volatile LAS unsigned* st) {
    XcdBarrier b; b.bar = bar; b.x = xb_xcc_id(); b.st = st;
    if (threadIdx.x == 0) (void)xb_add(&bar[XB_XCNT(b.x)], 1u);
    return b;
}
__device__ __forceinline__ void xcd_barrier_complete(unsigned* bar, unsigned x, unsigned& nloc, unsigned& nx) {
    const unsigned G = gridDim.x * gridDim.y * gridDim.z;
    unsigned sum, cnt, mine, sp = 0u;
    for (;;) {
        sum = 0u; cnt = 0u; mine = 0u;
#pragma unroll
        for (unsigned j = 0; j < 16; ++j) { const unsigned c = xb_ld(&bar[XB_XCNT(j)]); sum += c; cnt += (c > 0u) ? 1u : 0u; mine = (j == x) ? c : mine; }
        if (sum == G) break;
        __builtin_amdgcn_s_sleep(1);
        if ((++sp & 255u) == 0u) { if (xb_ld(&bar[XB_TMO])) break; if (sp > XB_SPIN_CAP) { atomicAdd(&bar[XB_TMO], 1u); break; } }
    }
    nloc = mine > 0u ? mine : 1u; nx = cnt > 0u ? cnt : 1u;
}
__device__ __forceinline__ void xcd_barrier(const XcdBarrier& b) {
    asm volatile("s_waitcnt vmcnt(0)" ::: "memory");
    __syncthreads();
    if (threadIdx.x == 0) {
        unsigned* bar = b.bar;
        __builtin_amdgcn_s_waitcnt(0);
        unsigned nloc = b.st[0], nx = b.st[1];
        if (nloc == 0u) { xcd_barrier_complete(bar, b.x, nloc, nx); b.st[0] = nloc; b.st[1] = nx; }
        const unsigned old = xb_add(&bar[XB_XSUB(b.x)], 1u);
        const unsigned gen = old / nloc;
        if (old + 1u == (gen + 1u) * nloc) {
            __builtin_amdgcn_fence(__ATOMIC_RELEASE, "agent");
            asm volatile("s_waitcnt vmcnt(0)" ::: "memory");
            const unsigned og = xb_add(&bar[XB_TOP], 1u);
            const unsigned tg = og / nx;
            if (og + 1u == (tg + 1u) * nx) xb_add(&bar[XB_TOPGEN], 1u);
            else XB_SPIN(xb_ld(&bar[XB_TOPGEN]) == tg, bar);
            __builtin_amdgcn_fence(__ATOMIC_ACQUIRE, "agent");
            xb_add(&bar[XB_XGEN(b.x)], 1u);
            asm volatile("s_waitcnt vmcnt(0)" ::: "memory");
        } else {
            XB_SPIN(xb_ld(&bar[XB_XGEN(b.x)]) == gen, bar);
            __builtin_amdgcn_fence(__ATOMIC_ACQUIRE, "agent");
            asm volatile("s_waitcnt vmcnt(0)" ::: "memory");
        }
    }
    __syncthreads();
}

struct Frame {
    LAS unsigned char* lds;
    volatile LAS unsigned* LW;
    gu32* ctl;
    int tid, lane, wave, vcu, G;
    const float *x, *c; const int* pos;
    const float *w_ada, *b_ada, *norm_mix_w, *w_in, *q_norm_w, *w_q_b, *kv_norm_w, *w_kv_b, *w_gk_up, *b_gk_up, *gla_norm_w, *w_o_mla, *w_o_gla, *w_out, *norm_ffn_w, *w_router, *b_router,
        *w1, *b1, *w2, *b2, *w_ada_final, *b_ada_final, *norm_final_w;
    float* out;
    unsigned char* ws;
};
#define WSP(T, off) ((T*)(F.ws + (off)))

template <bool FP8>
__device__ __forceinline__ void p0_convert_item(const float* W, int K, int N, int nblk, void* WT, const float* kscale, LAS unsigned char* scr, int item, int lane, int ldk = 0, int koff = 0, bool pairsplit = false) {
    if (ldk == 0) ldk = K;
    constexpr int KT = FP8 ? 128 : 64, NG = KT / 16, PITCH = FP8 ? 132 : 136, EB = FP8 ? 1 : 2;
    const int kb = item / nblk, nb = item % nblk, k0 = KT * kb, n0 = 64 * nb, q = lane >> 4, n4 = lane & 15;
    const bool ok = n0 + 4 * n4 < N;
    const float* src = W + (size_t)(k0 + 4 * q) * N + n0 + 4 * n4;
#pragma unroll
    for (int gh = 0; gh < NG; gh += 4) {
        f32x4 v[4][4];
#pragma unroll
        for (int g = 0; g < 4; ++g)
#pragma unroll
            for (int r = 0; r < 4; ++r) v[g][r] = ok ? __builtin_nontemporal_load((const f32x4*)(src + (size_t)(16 * (gh + g) + r) * N)) : (f32x4){0.f, 0.f, 0.f, 0.f};
#pragma unroll
        for (int g = 0; g < 4; ++g) {
            if (kscale) {
#pragma unroll
                for (int r = 0; r < 4; ++r) v[g][r] = v[g][r] * kscale[k0 + 16 * (gh + g) + 4 * q + r]; }
#pragma unroll
            for (int c = 0; c < 4; ++c) { LAS unsigned char* p = scr + (4 * n4 + c) * PITCH + (16 * (gh + g) + 4 * q) * EB;
                if constexpr (FP8) *(LAS unsigned*)p = pk4_fp8(v[g][0][c] * W8_SCALE, v[g][1][c] * W8_SCALE, v[g][2][c] * W8_SCALE, v[g][3][c] * W8_SCALE);
                else { u32x2 w; w.x = cvt_pk_bf16(v[g][0][c], v[g][1][c]); w.y = cvt_pk_bf16(v[g][2][c], v[g][3][c]); *(LAS u32x2*)p = w; } }
        }
    }
    LDS_WAIT(); asm volatile("" ::: "memory");
#pragma unroll
    for (int i = 0; i < 8; ++i) { const int row = i * 8 + (lane >> 3), ch = lane & 7; const LAS unsigned* p = (const LAS unsigned*)(scr + row * PITCH + ch * 16);
        u32x4 o; o.x = p[0]; o.y = p[1]; o.z = p[2]; o.w = p[3];
        const int drow = pairsplit ? (row & ~7) | ((row & 7) >> 1) | ((row & 1) << 2) : row;
        u32x4* dstp = (u32x4*)((unsigned char*)WT + ((size_t)(n0 + drow) * ldk + koff + k0) * EB + ch * 16);
        if constexpr (FP8) __builtin_nontemporal_store(o, dstp); else *dstp = o; }
    LDS_WAIT(); asm volatile("" ::: "memory");
}
__device__ __forceinline__ void p0_prologue(Frame& F) {
    {
        LAS float* cond = (LAS float*)F.lds;
        LAS float* part = (LAS float*)(F.lds + 16384);
        for (int i = F.tid; i < NB * DM; i += NWAVES * 64) { const float v = F.c[i]; cond[i] = v * fast_sigmoid(v); }
        __syncthreads();
        for (int cg = F.vcu; cg < 256; cg += F.G) {
            const bool fin = cg >= 192; const float* W = fin ? F.w_ada_final : F.w_ada; const int N = fin ? 2 * DM : 6 * DM; const int col = (fin ? cg - 192 : cg) * 64 + F.lane;
            float a0 = 0.f, a1 = 0.f; const int kbeg = F.wave * 256;
            const float* wp = W + (size_t)kbeg * N + col;
            for (int kk = 0; kk < 256; kk += 32) { float w[32];
#pragma unroll
                for (int k = 0; k < 32; ++k) w[k] = __builtin_nontemporal_load(wp + (size_t)(kk + k) * N);
#pragma unroll
                for (int k = 0; k < 32; ++k) { a0 += cond[kbeg + kk + k] * w[k]; a1 += cond[DM + kbeg + kk + k] * w[k]; } }
            part[(F.wave * 2 + 0) * 64 + F.lane] = a0; part[(F.wave * 2 + 1) * 64 + F.lane] = a1;
            __syncthreads();
            if (F.tid < 128) { const int b = F.tid >> 6, l = F.tid & 63; float sres = 0.f;
#pragma unroll
                for (int w = 0; w < 8; ++w) sres += part[(w * 2 + b) * 64 + l];
                const int cc = (fin ? cg - 192 : cg) * 64 + l;
                if (fin) __hip_atomic_store(WSP(float, WS_FMOD) + b * (2 * DM) + cc, sres + F.b_ada_final[cc], RLX_AGENT); else __hip_atomic_store(WSP(float, WS_MOD) + b * (6 * DM) + cc, sres + F.b_ada[cc], RLX_AGENT); }
            asm volatile("s_waitcnt vmcnt(0)" ::: "memory");
            __syncthreads();
            if (F.tid == 0) __hip_atomic_fetch_add((unsigned*)(F.ctl + CW_GEMV), 1u, RLX_AGENT);
        }
    }
    {
        float* cs = WSP(float, WS_CS);
        for (int g = F.vcu * (NWAVES * 64) + F.tid; g < NTOK * 32; g += F.G * NWAVES * 64) {
            const int tok = g >> 5, i = g & 31;
            const float inv = powf(10000.0f, -(float)(2 * i) / 64.0f);
            const float ang = (float)F.pos[tok] * inv;
            const double r = (double)ang - 6.283185307179586 * rint((double)ang * 0.15915494309189535);
            const float rf = (float)r;
            cs[2 * g] = cosf(rf); cs[2 * g + 1] = sinf(rf);
        }
    }
    LAS unsigned char* scr = F.lds + F.wave * 16384;
    const int gw = F.vcu * NWAVES + F.wave, NGW = F.G * NWAVES;
    constexpr int I_IN = (DM / 64) * (DINP / 64), I_Q = (MLA_QR / 64) * (NQ / 64), I_KV = (MLA_KVR / 64) * (NKV / 64), I_OM = (1024 / 64) * (DM / 64), I_OG = I_OM, I_OUT = (DM / 64) * (DM / 64),
                  I_W1E = (DM / 128) * (2 * DEXP / 64), I_W2E = (DEXP / 128) * (DM / 64);
    constexpr int NITEMS = I_IN + I_Q + I_KV + I_OM + I_OG + I_OUT;
    (void)I_W1E; (void)I_W2E;
    for (int it = gw; it < NITEMS; it += NGW) {
        int r = it;
        if (r < I_IN) { p0_convert_item<false>(F.w_in, DM, DIN, DINP / 64, WSP(bf16_t, WS_WIN), nullptr, scr, r, F.lane); continue; } r -= I_IN;
        if (r < I_Q) { p0_convert_item<false>(F.w_q_b, MLA_QR, NQ, NQ / 64, WSP(bf16_t, WS_WQ), F.q_norm_w, scr, r, F.lane); continue; } r -= I_Q;
        if (r < I_KV) { p0_convert_item<false>(F.w_kv_b, MLA_KVR, NKV, NKV / 64, WSP(bf16_t, WS_WKV), F.kv_norm_w, scr, r, F.lane); continue; } r -= I_KV;
        if (r < I_OM) { p0_convert_item<false>(F.w_o_mla, 1024, DM, DM / 64, WSP(bf16_t, WS_WOM), nullptr, scr, r, F.lane, 2048, 0); continue; } r -= I_OM;
        if (r < I_OG) { p0_convert_item<false>(F.w_o_gla, 1024, DM, DM / 64, WSP(bf16_t, WS_WOM), nullptr, scr, r, F.lane, 2048, 1024); continue; } r -= I_OG;
        p0_convert_item<false>(F.w_out, DM, DM, DM / 64, WSP(bf16_t, WS_WOUT), nullptr, scr, r, F.lane);
    }
}
__device__ __forceinline__ void moe_convert(Frame& F, int cc, int ncv) {
    LAS unsigned char* scr = F.lds + F.wave * 16384;
    const int gw = cc * NWAVES + F.wave, NGW = ncv * NWAVES;
    constexpr int I_W1E = (DM / 128) * (2 * DEXP / 64), I_W2E = (DEXP / 128) * (DM / 64);
    for (int it = gw; it < NEXP * (I_W1E + I_W2E); it += NGW) {
        int r = it;
        if (r < NEXP * I_W1E) { const int e = r / I_W1E; p0_convert_item<true>(F.w1 + (size_t)e * DM * 2 * DEXP, DM, 2 * DEXP, 2 * DEXP / 64, WSP(unsigned char, WS_W1) + (size_t)e * 2 * DEXP * DM, nullptr, scr, r % I_W1E, F.lane, 0, 0, true); continue; } r -= NEXP * I_W1E;
        { const int e = r / I_W2E; p0_convert_item<true>(F.w2 + (size_t)e * DEXP * DM, DEXP, DM, DM / 64, WSP(unsigned char, WS_W2) + (size_t)e * DM * DEXP, nullptr, scr, r % I_W2E, F.lane); }
    }
}
__device__ __forceinline__ void wait_gemv(Frame& F) {
    if (F.tid == 0) { unsigned sp = 0;
        while (__hip_atomic_load((unsigned*)(F.ctl + CW_GEMV), RLX_AGENT) < 256u) { __builtin_amdgcn_s_sleep(2);
            if ((++sp & 255u) == 0u) { if (__hip_atomic_load((unsigned*)(F.ctl + CW_TMO), RLX_AGENT)) break; if (sp > (1u << 22)) { __hip_atomic_store((unsigned*)(F.ctl + CW_TMO), 1u, RLX_AGENT); break; } } }
        __builtin_amdgcn_fence(__ATOMIC_ACQUIRE, "agent");
        asm volatile("s_waitcnt vmcnt(0)" ::: "memory"); }
    __syncthreads();
}

template <bool FP8 = false>
__device__ __forceinline__ void norm_mod_row_bf16(const float* xrow, const float* gain, const float* shift, const float* scale, bf16_t* orow, int lane) {
    const f32x4* xr = (const f32x4*)xrow + lane;
    f32x4 v[8]; float s = 0.f;
#pragma unroll
    for (int j = 0; j < 8; ++j) { v[j] = FP8 ? xr[64 * j] : __builtin_nontemporal_load(xr + 64 * j); s += (v[j].x * v[j].x + v[j].y * v[j].y) + (v[j].z * v[j].z + v[j].w * v[j].w); }
    const float rs = 1.0f / sqrtf(wave_sum(s) * (1.0f / DM) + EPS);
#pragma unroll
    for (int j = 0; j < 8; ++j) { const int c = 4 * lane + 256 * j; const f32x4 g = *(const f32x4*)(gain + c), sc = *(const f32x4*)(scale + c), sh = *(const f32x4*)(shift + c);
        const f32x4 o = v[j] * rs * g * (sc + 1.0f) + sh;
        if constexpr (FP8) { *(unsigned*)((unsigned char*)orow + c) = pk4_fp8(o.x * A8_SCALE, o.y * A8_SCALE, o.z * A8_SCALE, o.w * A8_SCALE); }
        else { u32x2 w; w.x = cvt_pk_bf16(o.x, o.y); w.y = cvt_pk_bf16(o.z, o.w); *(u32x2*)(orow + c) = w; } }
}
__device__ __forceinline__ void p1_norm(Frame& F) {
    const int gw = F.vcu * NWAVES + F.wave, NGW = F.G * NWAVES;
    const float* mod = WSP(float, WS_MOD);
    for (int m = gw; m < NTOK; m += NGW) { const int b = m / SEQ;
        norm_mod_row_bf16(F.x + (size_t)m * DM, F.norm_mix_w, mod + b * 6 * DM + 0 * DM, mod + b * 6 * DM + 1 * DM, WSP(bf16_t, WS_H) + (size_t)m * DM, F.lane); }
    float* RW = WSP(float, WS_RW); float* RC = WSP(float, WS_RC);
    for (int g = F.vcu * (NWAVES * 64) + F.tid; g < NB * DM * NEXP; g += F.G * NWAVES * 64) { const int b = g / (DM * NEXP), k = (g / NEXP) % DM;
        RW[g] = F.norm_ffn_w[k] * (1.0f + mod[b * 6 * DM + 4 * DM + k]) * F.w_router[g % (DM * NEXP)]; }
    if (gw < NB * NEXP) { const int b = gw / NEXP, e = gw % NEXP; float s = 0.f;
        for (int k = F.lane; k < DM; k += 64) s += mod[b * 6 * DM + 3 * DM + k] * F.w_router[k * NEXP + e];
        s = wave_sum(s); if (F.lane == 0) RC[b * NEXP + e] = s + F.b_router[e]; }
}

__device__ __forceinline__ void p3_rows(Frame& F) {
    const int gw = F.vcu * NWAVES + F.wave, NGW = F.G * NWAVES;
    const bf16_t* proj = WSP(bf16_t, WS_PROJ); const float* cs = WSP(float, WS_CS);
    for (int m = gw; m < NTOK; m += NGW) { const bf16_t* pr = proj + (size_t)m * DINP;
        { const u32x4 w = *(const u32x4*)(pr + C_QLAT + 8 * F.lane);
          float s = bf_lo(w.x) * bf_lo(w.x) + bf_hi(w.x) * bf_hi(w.x) + bf_lo(w.y) * bf_lo(w.y) + bf_hi(w.y) * bf_hi(w.y) + bf_lo(w.z) * bf_lo(w.z) + bf_hi(w.z) * bf_hi(w.z) + bf_lo(w.w) * bf_lo(w.w) + bf_hi(w.w) * bf_hi(w.w);
          s = wave_sum(s); if (F.lane == 0) WSP(float, WS_RSQ)[m] = 1.0f / sqrtf(s * (1.0f / MLA_QR) + EPS); }
        { float s = 0.f;
          if (F.lane < 32) { const u32x4 w = *(const u32x4*)(pr + C_CKV + 8 * F.lane);
              s = bf_lo(w.x) * bf_lo(w.x) + bf_hi(w.x) * bf_hi(w.x) + bf_lo(w.y) * bf_lo(w.y) + bf_hi(w.y) * bf_hi(w.y) + bf_lo(w.z) * bf_lo(w.z) + bf_hi(w.z) * bf_hi(w.z) + bf_lo(w.w) * bf_lo(w.w) + bf_hi(w.w) * bf_hi(w.w); }
          s = wave_sum(s); if (F.lane == 0) WSP(float, WS_RSKV)[m] = 1.0f / sqrtf(s * (1.0f / MLA_KVR) + EPS); }
        if (F.lane < 32) { const unsigned w = *(const unsigned*)(pr + C_KPE + 2 * F.lane); const float re = bf_lo(w), im = bf_hi(w);
            const f32x2 t = *(const f32x2*)(cs + ((size_t)m * 32 + F.lane) * 2);
            *(unsigned*)(WSP(bf16_t, WS_KPE) + (size_t)m * MLA_ROPE + 2 * F.lane) = cvt_pk_bf16(re * t.x - im * t.y, re * t.y + im * t.x); }
    }
}

#define MFMA16(a, b, c) __builtin_amdgcn_mfma_f32_16x16x32_bf16((a), (b), (c), 0, 0, 0)
__device__ __forceinline__ void gla_stage_vt(Frame& F, LAS unsigned char* VT, const bf16_t* proj, int t0, int h) {
#pragma unroll
    for (int it = 0; it < 4; ++it) { const int idx = F.tid + it * 512, j = idx >> 5, v8 = (idx & 31) * 8;
        const u32x4 w = *(const u32x4*)(proj + (size_t)(t0 + j) * DINP + C_GV + h * GLA_DV + v8);
        LAS unsigned char* p = VT + v8 * 144 + j * 2;
        *(LAS bf16_t*)(p + 0 * 144) = (bf16_t)(w.x & 0xffffu); *(LAS bf16_t*)(p + 1 * 144) = (bf16_t)(w.x >> 16);
        *(LAS bf16_t*)(p + 2 * 144) = (bf16_t)(w.y & 0xffffu); *(LAS bf16_t*)(p + 3 * 144) = (bf16_t)(w.y >> 16);
        *(LAS bf16_t*)(p + 4 * 144) = (bf16_t)(w.z & 0xffffu); *(LAS bf16_t*)(p + 5 * 144) = (bf16_t)(w.z >> 16);
        *(LAS bf16_t*)(p + 6 * 144) = (bf16_t)(w.w & 0xffffu); *(LAS bf16_t*)(p + 7 * 144) = (bf16_t)(w.w >> 16); }
}
__device__ __forceinline__ void gla_pass1_unit(Frame& F, int u) {
    const int b = u >> 8, h = (u >> 6) & 3, n = u & 63, t0 = b * SEQ + n * GLA_C;
    LAS unsigned char* L = F.lds;
    LAS float* GZ = (LAS float*)(L + 0); LAS float* WG = (LAS float*)(L + 4096); LAS float* BG = (LAS float*)(L + 12288); LAS float* QS = (LAS float*)(L + 12800);
    LAS unsigned char* KDT = L + 16384; LAS unsigned char* VT = L + 36864;
    const bf16_t* proj = WSP(bf16_t, WS_PROJ);
    if (F.tid < 128) { const int row = F.tid >> 1, half = F.tid & 1; const u32x4 w = *(const u32x4*)(proj + (size_t)(t0 + row) * DINP + C_GLR + half * 8);
        LAS float* g = GZ + row * 16 + half * 8; g[0] = bf_lo(w.x); g[1] = bf_hi(w.x); g[2] = bf_lo(w.y); g[3] = bf_hi(w.y); g[4] = bf_lo(w.z); g[5] = bf_hi(w.z); g[6] = bf_lo(w.w); g[7] = bf_hi(w.w); }
    { const int r = F.tid >> 5, c = (F.tid & 31) * 4; *(LAS f32x4*)(WG + r * 128 + c) = *(const f32x4*)(F.w_gk_up + r * (GLA_H * GLA_DK) + h * GLA_DK + c); }
    if (F.tid < 128) BG[F.tid] = F.b_gk_up[h * GLA_DK + F.tid];
    gla_stage_vt(F, VT, proj, t0, h);
    __syncthreads();
    const int d = F.tid & 127, qtr = F.tid >> 7;
    float bq[16];
    { float wg[16];
#pragma unroll
      for (int r = 0; r < 16; ++r) wg[r] = WG[r * 128 + d];
      const float bias = BG[d]; float run = 0.f;
#pragma unroll
      for (int i = 0; i < 16; ++i) { const LAS float* gz = GZ + (qtr * 16 + i) * 16; float z = bias;
#pragma unroll
          for (int r = 0; r < 16; ++r) z += gz[r] * wg[r];
          const float ls = fminf(z, 0.f) - __logf(1.0f + __expf(-fabsf(z)));
          run += ls * (1.0f / 16.0f); bq[i] = run; }
      QS[qtr * 128 + d] = run; }
    __syncthreads();
    float off = 0.f, blast = 0.f;
#pragma unroll
    for (int q = 0; q < 4; ++q) { const float s = QS[q * 128 + d]; blast += s; if (q < qtr) off += s; }
    float* gc = WSP(float, WS_GCUM) + (size_t)(t0 + qtr * 16) * (GLA_H * GLA_DK) + h * GLA_DK + d;
    const bf16_t* kp = proj + (size_t)(t0 + qtr * 16) * DINP + C_GK + h * GLA_DK + d;
    float kd[16];
#pragma unroll
    for (int i = 0; i < 16; ++i) { bq[i] += off; gc[(size_t)i * (GLA_H * GLA_DK)] = bq[i]; kd[i] = bf2f(kp[(size_t)i * DINP]) * __expf(blast - bq[i]); }
    { u32x4 w0, w1; w0.x = cvt_pk_bf16(kd[0], kd[1]); w0.y = cvt_pk_bf16(kd[2], kd[3]); w0.z = cvt_pk_bf16(kd[4], kd[5]); w0.w = cvt_pk_bf16(kd[6], kd[7]);
      w1.x = cvt_pk_bf16(kd[8], kd[9]); w1.y = cvt_pk_bf16(kd[10], kd[11]); w1.z = cvt_pk_bf16(kd[12], kd[13]); w1.w = cvt_pk_bf16(kd[14], kd[15]);
      *(LAS u32x4*)(KDT + d * 144 + qtr * 32) = w0; *(LAS u32x4*)(KDT + d * 144 + qtr * 32 + 16) = w1; }
    if (qtr == 0) WSP(float, WS_DLAST)[u * GLA_DK + d] = __expf(blast);
    __syncthreads();
    const int l15 = F.lane & 15, quad = F.lane >> 4, w = F.wave;
    f32x4 acc[2][8];
#pragma unroll
    for (int mt = 0; mt < 2; ++mt)
#pragma unroll
        for (int nt = 0; nt < 8; ++nt) acc[mt][nt] = (f32x4){0.f, 0.f, 0.f, 0.f};
#pragma unroll
    for (int ks = 0; ks < 2; ++ks) { bf16x8 xf[2];
#pragma unroll
        for (int mt = 0; mt < 2; ++mt) xf[mt] = *(const LAS bf16x8*)(VT + (w * 32 + mt * 16 + l15) * 144 + (ks * 32 + quad * 8) * 2);
#pragma unroll
        for (int nt = 0; nt < 8; ++nt) { const bf16x8 yf = *(const LAS bf16x8*)(KDT + (nt * 16 + l15) * 144 + (ks * 32 + quad * 8) * 2);
#pragma unroll
            for (int mt = 0; mt < 2; ++mt) acc[mt][nt] = MFMA16(yf, xf[mt], acc[mt][nt]); } }
    bf16_t* UT = WSP(bf16_t, WS_UT) + (size_t)u * (GLA_DV * GLA_DK);
#pragma unroll
    for (int mt = 0; mt < 2; ++mt)
#pragma unroll
        for (int nt = 0; nt < 8; ++nt) { u32x2 w2; w2.x = cvt_pk_bf16(acc[mt][nt][0], acc[mt][nt][1]); w2.y = cvt_pk_bf16(acc[mt][nt][2], acc[mt][nt][3]);
            *(u32x2*)(UT + (size_t)(w * 32 + mt * 16 + l15) * GLA_DK + nt * 16 + quad * 4) = w2; }
    __syncthreads();
}
__device__ __forceinline__ void gla_pass2(Frame& F) {
    const bf16_t* UT = WSP(bf16_t, WS_UT); const float* DL = WSP(float, WS_DLAST); bf16_t* ST = WSP(bf16_t, WS_ST);
    for (int g = F.vcu * (NWAVES * 64) + F.tid; g < NB * GLA_H * GLA_DV * (GLA_DK / 2); g += F.G * NWAVES * 64) {
        const int bh = g >> 14, rem = g & 16383, v = rem >> 6, d2 = (rem & 63) * 2;
        f32x2 S = {0.f, 0.f};
#pragma unroll 16
        for (int n = 0; n < GLA_NCH; ++n) { const int u = bh * GLA_NCH + n; const size_t e = ((size_t)u * GLA_DV + v) * GLA_DK + d2;
            *(unsigned*)(ST + e) = cvt_pk_bf16(S.x, S.y);
            const unsigned uw = __builtin_nontemporal_load((const unsigned*)(UT + e)); const f32x2 U = {bf_lo(uw), bf_hi(uw)}, dl = *(const f32x2*)(DL + u * GLA_DK + d2);
            S = S * dl + U; }
    }
}
__device__ __forceinline__ void gla_pass3_unit(Frame& F, int u) {
    const int b = u >> 8, h = (u >> 6) & 3, n = u & 63, t0 = b * SEQ + n * GLA_C;
    LAS unsigned char* L = F.lds;
    LAS unsigned char* QD = L; LAS unsigned char* KD2 = L + 17408; LAS unsigned char* P = L + 34816; LAS unsigned char* VT = L + 44032; LAS float* RED = (LAS float*)(L + 80896);
    const bf16_t* proj = WSP(bf16_t, WS_PROJ); const float* gcum = WSP(float, WS_GCUM);
#pragma unroll
    for (int it = 0; it < 2; ++it) { const int idx = F.tid + it * 512, i = idx >> 4, d8 = (idx & 15) * 8;
        const u32x4 qw = *(const u32x4*)(proj + (size_t)(t0 + i) * DINP + C_GQ + h * GLA_DK + d8), kw = *(const u32x4*)(proj + (size_t)(t0 + i) * DINP + C_GK + h * GLA_DK + d8);
        const float* bp = gcum + (size_t)(t0 + i) * (GLA_H * GLA_DK) + h * GLA_DK + d8; const f32x4 b0 = *(const f32x4*)bp, b1 = *(const f32x4*)(bp + 4);
        const float sc = 0.08838834764831845f;
        float q[8] = {bf_lo(qw.x), bf_hi(qw.x), bf_lo(qw.y), bf_hi(qw.y), bf_lo(qw.z), bf_hi(qw.z), bf_lo(qw.w), bf_hi(qw.w)};
        float k[8] = {bf_lo(kw.x), bf_hi(kw.x), bf_lo(kw.y), bf_hi(kw.y), bf_lo(kw.z), bf_hi(kw.z), bf_lo(kw.w), bf_hi(kw.w)};
        float bb[8] = {b0.x, b0.y, b0.z, b0.w, b1.x, b1.y, b1.z, b1.w};
#pragma unroll
        for (int j = 0; j < 8; ++j) { q[j] *= sc * __expf(bb[j]); k[j] *= __expf(-bb[j]); }
        u32x4 qo, ko; qo.x = cvt_pk_bf16(q[0], q[1]); qo.y = cvt_pk_bf16(q[2], q[3]); qo.z = cvt_pk_bf16(q[4], q[5]); qo.w = cvt_pk_bf16(q[6], q[7]);
        ko.x = cvt_pk_bf16(k[0], k[1]); ko.y = cvt_pk_bf16(k[2], k[3]); ko.z = cvt_pk_bf16(k[4], k[5]); ko.w = cvt_pk_bf16(k[6], k[7]);
        *(LAS u32x4*)(QD + i * 272 + d8 * 2) = qo; *(LAS u32x4*)(KD2 + i * 272 + d8 * 2) = ko; }
    gla_stage_vt(F, VT, proj, t0, h);
    const int l15 = F.lane & 15, quad = F.lane >> 4, w = F.wave;
    const bf16_t* STu = WSP(bf16_t, WS_ST) + (size_t)u * (GLA_DV * GLA_DK);
    bf16x8 stf[4][2]; u32x2 gwf[4][2]; f32x4 nwf[2];
#pragma unroll
    for (int ks = 0; ks < 4; ++ks)
#pragma unroll
        for (int n2 = 0; n2 < 2; ++n2) stf[ks][n2] = *(const bf16x8*)(STu + (size_t)(w * 32 + n2 * 16 + l15) * GLA_DK + ks * 32 + quad * 8);
#pragma unroll
    for (int n2 = 0; n2 < 2; ++n2) { const int v0 = w * 32 + n2 * 16 + quad * 4; nwf[n2] = *(const f32x4*)(F.gla_norm_w + v0);
#pragma unroll
        for (int mt = 0; mt < 4; ++mt) gwf[mt][n2] = *(const u32x2*)(proj + (size_t)(t0 + mt * 16 + l15) * DINP + C_GOUT + h * GLA_DV + v0); }
    __syncthreads();
    { const int mt = w >> 1;
#pragma unroll
      for (int q2 = 0; q2 < 2; ++q2) { const int nt = (w & 1) * 2 + q2; f32x4 a = {0.f, 0.f, 0.f, 0.f};
          if (nt <= mt) {
#pragma unroll
              for (int ks = 0; ks < 4; ++ks) { const bf16x8 xf = *(const LAS bf16x8*)(QD + (mt * 16 + l15) * 272 + (ks * 32 + quad * 8) * 2), yf = *(const LAS bf16x8*)(KD2 + (nt * 16 + l15) * 272 + (ks * 32 + quad * 8) * 2);
                  a = MFMA16(yf, xf, a); } }
          const int i = mt * 16 + l15, j0 = nt * 16 + quad * 4;
          u32x2 pw; pw.x = cvt_pk_bf16(j0 + 0 <= i ? a[0] : 0.f, j0 + 1 <= i ? a[1] : 0.f); pw.y = cvt_pk_bf16(j0 + 2 <= i ? a[2] : 0.f, j0 + 3 <= i ? a[3] : 0.f);
          *(LAS u32x2*)(P + i * 144 + j0 * 2) = pw; } }
    __syncthreads();
    f32x4 acc[4][2];
#pragma unroll
    for (int mt = 0; mt < 4; ++mt) { acc[mt][0] = (f32x4){0.f, 0.f, 0.f, 0.f}; acc[mt][1] = (f32x4){0.f, 0.f, 0.f, 0.f}; }
#pragma unroll
    for (int ks = 0; ks < 4; ++ks) {
#pragma unroll
        for (int mt = 0; mt < 4; ++mt) { const bf16x8 xf = *(const LAS bf16x8*)(QD + (mt * 16 + l15) * 272 + (ks * 32 + quad * 8) * 2);
            acc[mt][0] = MFMA16(stf[ks][0], xf, acc[mt][0]); acc[mt][1] = MFMA16(stf[ks][1], xf, acc[mt][1]); } }
#pragma unroll
    for (int ks = 0; ks < 2; ++ks) { bf16x8 yf[2];
#pragma unroll
        for (int n2 = 0; n2 < 2; ++n2) yf[n2] = *(const LAS bf16x8*)(VT + (w * 32 + n2 * 16 + l15) * 144 + (ks * 32 + quad * 8) * 2);
#pragma unroll
        for (int mt = 0; mt < 4; ++mt) { const bf16x8 xf = *(const LAS bf16x8*)(P + (mt * 16 + l15) * 144 + (ks * 32 + quad * 8) * 2);
            acc[mt][0] = MFMA16(yf[0], xf, acc[mt][0]); acc[mt][1] = MFMA16(yf[1], xf, acc[mt][1]); } }
#pragma unroll
    for (int mt = 0; mt < 4; ++mt) { float ss = 0.f;
#pragma unroll
        for (int n2 = 0; n2 < 2; ++n2)
#pragma unroll
            for (int r = 0; r < 4; ++r) ss += acc[mt][n2][r] * acc[mt][n2][r];
        ss += __shfl_xor(ss, 16); ss += __shfl_xor(ss, 32);
        if (quad == 0) RED[w * 64 + mt * 16 + l15] = ss; }
    __syncthreads();
    bf16_t* GO = WSP(bf16_t, WS_ATTO) + MLA_H * MLA_V;
#pragma unroll
    for (int mt = 0; mt < 4; ++mt) { const int i = mt * 16 + l15; float tot = 0.f;
#pragma unroll
        for (int ww = 0; ww < 8; ++ww) tot += RED[ww * 64 + i];
        const float rs = 1.0f / sqrtf(tot * (1.0f / GLA_DV) + EPS);
#pragma unroll
        for (int n2 = 0; n2 < 2; ++n2) { const int v0 = w * 32 + n2 * 16 + quad * 4; const f32x4 nw = nwf[n2];
            const u32x2 gw = gwf[mt][n2];
            const float g0 = bf_lo(gw.x), g1 = bf_hi(gw.x), g2 = bf_lo(gw.y), g3 = bf_hi(gw.y);
            const f32x4 o = acc[mt][n2] * rs * nw;
            u32x2 ow; ow.x = cvt_pk_bf16(o.x * g0 * fast_sigmoid(g0), o.y * g1 * fast_sigmoid(g1)); ow.y = cvt_pk_bf16(o.z * g2 * fast_sigmoid(g2), o.w * g3 * fast_sigmoid(g3));
            *(u32x2*)(GO + (size_t)(t0 + i) * BR_LD + h * GLA_DV + v0) = ow; } }
    __syncthreads();
}

namespace att {
constexpr float SCALE = 0.07216878364870322f, THR = 8.f;
constexpr int SHM_V = 16384, SHM_KN = 16384, SHM_KP = 8192;
constexpr int OFF_V = 0, OFF_KN = 3 * SHM_V, OFF_KP = OFF_KN + 4 * SHM_KN, OFF_WS = OFF_KP + 4 * SHM_KP, ATT_LDS_END = OFF_WS + 2048 + 16;
constexpr int OFF_EXO = 0, OFF_EXS = 65536;
#define KSWZ(row, colB) ((row) * 256 + ((colB) ^ (((row) & 7) << 4)))
#define KPSWZ(row, colB) ((row) * 128 + ((colB) ^ (((row) & 7) << 4)))
#define SBAR() __builtin_amdgcn_sched_barrier(0)
__device__ __forceinline__ int v_rd_base(int lane) { return ((lane & 3) << 3) | (((lane >> 2) & 3) << 6) | (((lane >> 4) & 1) << 5) | (((lane >> 5) & 1) << 8); }
constexpr int v_rd_off(int d0, int ks, int half) { return d0 * 512 + ks * 4096 + half * 2048; }
__device__ __forceinline__ int crow(int r, int hi) { return (r & 3) + 8 * (r >> 2) + 4 * hi; }
__device__ __forceinline__ void mask_tile(f32x16& p0, f32x16& p1, int dq) {
    const float NEG = -__builtin_inff();
#pragma unroll
    for (int r = 0; r < 16; ++r) { const int c = (r & 3) + 8 * (r >> 2);
        if (dq - c < 0) p0[r] = NEG;
        if (dq - c - 32 < 0) p1[r] = NEG; }
}
__device__ __forceinline__ void partialSM(f32x16& p0, f32x16& p1, float& m_reg, float& mn, float& alpha) {
    float pmax = p0[0];
#pragma unroll
    for (int r = 1; r < 16; ++r) pmax = fmaxf(pmax, p0[r]);
#pragma unroll
    for (int r = 0; r < 16; ++r) pmax = fmaxf(pmax, p1[r]);
    { auto rr = __builtin_amdgcn_permlane32_swap(__float_as_uint(pmax), __float_as_uint(pmax), false, false);
      pmax = fmaxf(__uint_as_float(rr[0]), __uint_as_float(rr[1])); }
    constexpr float C2 = 1.4426950408889634f * SCALE;
    if (__builtin_expect(__all((pmax - m_reg) * SCALE <= THR), 1)) { mn = m_reg; alpha = 1.f; }
    else { mn = fmaxf(m_reg, pmax); alpha = __builtin_amdgcn_exp2f((m_reg - mn) * C2); m_reg = mn; }
    const float mnL = -mn * C2;
#pragma unroll
    for (int r = 0; r < 16; ++r) p0[r] = fmaf(p0[r], C2, mnL);
#pragma unroll
    for (int r = 0; r < 16; ++r) p1[r] = fmaf(p1[r], C2, mnL);
#pragma unroll
    for (int r = 0; r < 16; ++r) p0[r] = __builtin_amdgcn_exp2f(p0[r]);
}
__device__ __forceinline__ void finishSM(f32x16& p0, f32x16& p1, float alpha, float& l_reg, bf16x8& pa0, bf16x8& pa1, bf16x8& pa2, bf16x8& pa3) {
#pragma unroll
    for (int r = 0; r < 16; ++r) p1[r] = __builtin_amdgcn_exp2f(p1[r]);
    float ps = 0;
#pragma unroll
    for (int r = 0; r < 16; ++r) ps += p0[r];
#pragma unroll
    for (int r = 0; r < 16; ++r) ps += p1[r];
    { auto rr = __builtin_amdgcn_permlane32_swap(__float_as_uint(ps), __float_as_uint(ps), false, false);
      ps = __uint_as_float(rr[0]) + __uint_as_float(rr[1]); }
    l_reg = l_reg * alpha + ps;
#define PK4(P, B_, OUT) do { unsigned a0 = cvt_pk_bf16(P[B_+0], P[B_+1]), a1 = cvt_pk_bf16(P[B_+2], P[B_+3]);                          \
        unsigned b0 = cvt_pk_bf16(P[B_+4], P[B_+5]), b1 = cvt_pk_bf16(P[B_+6], P[B_+7]);                                             \
        auto r0 = __builtin_amdgcn_permlane32_swap(a0, b0, false, false); auto r1 = __builtin_amdgcn_permlane32_swap(a1, b1, false, false); \
        u32x4 w = {r0[0], r1[0], r0[1], r1[1]}; OUT = __builtin_bit_cast(bf16x8, w); } while (0)
    PK4(p0, 0, pa0); PK4(p0, 8, pa1); PK4(p1, 0, pa2); PK4(p1, 8, pa3);
#undef PK4
}
__device__ __forceinline__ void qkt(f32x16& p0, f32x16& p1, const int* kb, const int* pb, const bf16x8* qn, const bf16x8* qp) {
#define KRD(dst, base, off) asm volatile("ds_read_b128 %0, %1 offset:%2" : "=&v"(dst) : "v"(base), "i"(off) : "memory")
#define RN(S, d0) do { KRD(S##0, kb[(d0) & 3], ((d0) >> 2) * 128); KRD(S##1, kb[(d0) & 3], ((d0) >> 2) * 128 + 32 * 256); } while (0)
#define RP(S, d0) do { KRD(S##0, pb[d0], 0); KRD(S##1, pb[d0], 32 * 128); } while (0)
#define MN(S, d0) do { p0 = __builtin_amdgcn_mfma_f32_32x32x16_bf16(__builtin_bit_cast(bf16x8, S##0), qn[d0], p0, 0, 0, 0); p1 = __builtin_amdgcn_mfma_f32_32x32x16_bf16(__builtin_bit_cast(bf16x8, S##1), qn[d0], p1, 0, 0, 0); } while (0)
#define MP(S, d0) do { p0 = __builtin_amdgcn_mfma_f32_32x32x16_bf16(__builtin_bit_cast(bf16x8, S##0), qp[d0], p0, 0, 0, 0); p1 = __builtin_amdgcn_mfma_f32_32x32x16_bf16(__builtin_bit_cast(bf16x8, S##1), qp[d0], p1, 0, 0, 0); } while (0)
#define LW(n) asm volatile("s_waitcnt lgkmcnt(" #n ")" ::: "memory")
#pragma unroll
    for (int r = 0; r < 16; ++r) { p0[r] = 0.f; p1[r] = 0.f; }
    u32x4 A0, A1, B0, B1;
    RN(A, 0); RN(B, 1);
    __builtin_amdgcn_s_setprio(2);
    LW(2); SBAR(); MN(A, 0); SBAR(); RN(A, 2);
    LW(2); SBAR(); MN(B, 1); SBAR(); RN(B, 3);
    LW(2); SBAR(); MN(A, 2); SBAR(); RN(A, 4);
    LW(2); SBAR(); MN(B, 3); SBAR(); RN(B, 5);
    LW(2); SBAR(); MN(A, 4); SBAR(); RN(A, 6);
    LW(2); SBAR(); MN(B, 5); SBAR(); RN(B, 7);
    LW(2); SBAR(); MN(A, 6); SBAR(); RP(A, 0);
    LW(2); SBAR(); MN(B, 7); SBAR(); RP(B, 1);
    LW(2); SBAR(); MP(A, 0); SBAR(); RP(A, 2);
    LW(2); SBAR(); MP(B, 1); SBAR(); RP(B, 3);
    LW(2); SBAR(); MP(A, 2); SBAR();
    LW(0); SBAR(); MP(B, 3);
    __builtin_amdgcn_s_setprio(0);
#undef LW
#undef MP
#undef MN
#undef RP
#undef RN
#undef KRD
}
__device__ __forceinline__ void pv_tile(f32x16* o, int vb0, bf16x8 pa0, bf16x8 pa1, bf16x8 pa2, bf16x8 pa3) {
#define TRRD(dst, off) asm volatile("ds_read_b64_tr_b16 %0, %1 offset:%2" : "=&v"(dst) : "v"(vb0), "i"(off) : "memory")
#define VRD(ks, S) do { TRRD(S##l0, v_rd_off(0, ks, 0)); TRRD(S##h0, v_rd_off(0, ks, 1)); TRRD(S##l1, v_rd_off(1, ks, 0)); TRRD(S##h1, v_rd_off(1, ks, 1)); \
                        TRRD(S##l2, v_rd_off(2, ks, 0)); TRRD(S##h2, v_rd_off(2, ks, 1)); TRRD(S##l3, v_rd_off(3, ks, 0)); TRRD(S##h3, v_rd_off(3, ks, 1)); } while (0)
#define VMM(pa, S) do { \
        o[0] = __builtin_amdgcn_mfma_f32_32x32x16_bf16(pa, (bf16x8){S##l0[0], S##l0[1], S##l0[2], S##l0[3], S##h0[0], S##h0[1], S##h0[2], S##h0[3]}, o[0], 0, 0, 0); \
        o[1] = __builtin_amdgcn_mfma_f32_32x32x16_bf16(pa, (bf16x8){S##l1[0], S##l1[1], S##l1[2], S##l1[3], S##h1[0], S##h1[1], S##h1[2], S##h1[3]}, o[1], 0, 0, 0); \
        o[2] = __builtin_amdgcn_mfma_f32_32x32x16_bf16(pa, (bf16x8){S##l2[0], S##l2[1], S##l2[2], S##l2[3], S##h2[0], S##h2[1], S##h2[2], S##h2[3]}, o[2], 0, 0, 0); \
        o[3] = __builtin_amdgcn_mfma_f32_32x32x16_bf16(pa, (bf16x8){S##l3[0], S##l3[1], S##l3[2], S##l3[3], S##h3[0], S##h3[1], S##h3[2], S##h3[3]}, o[3], 0, 0, 0); } while (0)
    s16x4 Al0, Ah0, Al1, Ah1, Al2, Ah2, Al3, Ah3, Bl0, Bh0, Bl1, Bh1, Bl2, Bh2, Bl3, Bh3;
    VRD(0, A); VRD(1, B);
    __builtin_amdgcn_s_setprio(2);
    asm volatile("s_waitcnt lgkmcnt(8)" ::: "memory"); SBAR(); VMM(pa0, A); SBAR();
    VRD(2, A);
    asm volatile("s_waitcnt lgkmcnt(8)" ::: "memory"); SBAR(); VMM(pa1, B); SBAR();
    VRD(3, B);
    asm volatile("s_waitcnt lgkmcnt(8)" ::: "memory"); SBAR(); VMM(pa2, A); SBAR();
    asm volatile("s_waitcnt lgkmcnt(0)" ::: "memory"); SBAR(); VMM(pa3, B);
    __builtin_amdgcn_s_setprio(0);
#undef VMM
#undef VRD
#undef TRRD
}
}

__device__ __forceinline__ void attn_item(Frame& F, int item) {
    using namespace att;
    const int bh = item >> 4, x = item & 15, b = bh >> 3, h = bh & 7;
    const int wid = F.wave, lane = F.lane, r32 = lane & 31, hi = lane >> 5;
    const bool grpB = wid >= 4;
    const int NL = 2 * x + 2, NH = 64 - 2 * x;
    const int qloH = (31 - x) * 128 + (wid & 3) * 32;
    int qlo = grpB ? qloH : x * 128 + (wid & 3) * 32;
    LAS unsigned char* L = F.lds;
    const bf16_t* Q = WSP(bf16_t, WS_Q) + (size_t)(b * SEQ) * NQ + h * MLA_QK;
    const bf16_t* KV = WSP(bf16_t, WS_KV) + (size_t)(b * MLA_H + h) * SEQ * 256;
    const bf16_t* KPE = WSP(bf16_t, WS_KPE) + (size_t)(b * SEQ) * MLA_ROPE;
    bf16x8 qn[8], qp[4];
#define LOADQ() do { const bf16_t* qrow = Q + (size_t)(qlo + r32) * NQ; \
        _Pragma("unroll") for (int d0 = 0; d0 < 8; ++d0) qn[d0] = *(const bf16x8*)(qrow + d0 * 16 + hi * 8); \
        _Pragma("unroll") for (int d0 = 0; d0 < 4; ++d0) qp[d0] = *(const bf16x8*)(qrow + MLA_NOPE + d0 * 16 + hi * 8); } while (0)
    LOADQ();
#define GLDS(src, dst) __builtin_amdgcn_global_load_lds((const unsigned*)(src), (LAS unsigned*)(dst), 16, 0, 0)
    unsigned ofKn, ofKp, ofV;
    { const int p0_ = wid * 64 + lane;
      { const int row_ = p0_ >> 4, ch_ = (p0_ & 15) ^ (row_ & 7); ofKn = (unsigned)(row_ * 256 + ch_ * 8) * 2u; }
      { const int row_ = p0_ >> 3, ch_ = (p0_ & 7) ^ (row_ & 7); ofKp = (unsigned)(row_ * MLA_ROPE + ch_ * 8) * 2u; }
      { const int st_ = p0_ >> 5, wi_ = p0_ & 31, kk_ = (st_ >> 2) * 8 + (wi_ >> 2), k_ = (kk_ & ~0xC) | ((kk_ & 4) << 1) | ((kk_ & 8) >> 1), c_ = (st_ & 3) * 32 + (wi_ & 3) * 8; ofV = (unsigned)(k_ * 256 + MLA_NOPE + c_) * 2u; } }
#define ALOADK(k0, slot) do { const char* kvb = (const char*)(KV + (size_t)(k0) * 256); const char* kpb_ = (const char*)(KPE + (size_t)(k0) * MLA_ROPE); \
        GLDS(kvb + ofKn, L + OFF_KN + (slot) * SHM_KN + wid * 1024); GLDS(kvb + 16384 + ofKn, L + OFF_KN + (slot) * SHM_KN + (wid + 8) * 1024); \
        GLDS(kpb_ + ofKp, L + OFF_KP + (slot) * SHM_KP + wid * 1024); } while (0)
#define ALOADV(k0, slot) do { const char* kvb = (const char*)(KV + (size_t)(k0) * 256); \
        GLDS(kvb + ofV, L + OFF_V + (slot) * SHM_V + wid * 1024); GLDS(kvb + 16384 + ofV, L + OFF_V + (slot) * SHM_V + (wid + 8) * 1024); } while (0)
    LAS float* wsf = (LAS float*)(L + OFF_WS) + wid * 64; LAS float* li_l = wsf; LAS float* al_l = wsf + 32;
    const int lbase = (int)(unsigned)(size_t)L;
    const int vbase = lbase + OFF_V + v_rd_base(lane);
    float m_reg = -1e30f, l_reg = 0.f; f32x16 o[4];
#define ZERO_O() do { _Pragma("unroll") for (int d = 0; d < 4; ++d) _Pragma("unroll") for (int r = 0; r < 16; ++r) o[d][r] = 0.f; } while (0)
    ZERO_O();
#define ATT_X(T_, KS_) do { f32x16 p0, p1; float mn, al; \
        { int tq_ = threadIdx.x; asm volatile("" : "+v"(tq_)); const int r_ = tq_ & 31, h_ = (tq_ >> 5) & 1; \
          const int ksw0 = lbase + OFF_KN + KSWZ(r_, (h_ * 8) * 2) + (KS_) * SHM_KN, psw0 = lbase + OFF_KP + KPSWZ(r_, (h_ * 8) * 2) + (KS_) * SHM_KP; \
          int kb[4], pb[4]; _Pragma("unroll") for (int dd = 0; dd < 4; ++dd) { kb[dd] = ksw0 ^ (dd << 5); pb[dd] = psw0 ^ (dd << 5); } qkt(p0, p1, kb, pb, qn, qp); } \
        if ((T_) * 64 + 63 > qlo) mask_tile(p0, p1, qlo + r32 - 4 * hi - (T_) * 64); \
        partialSM(p0, p1, m_reg, mn, al); \
        if (__any(al < 1.f)) { if (hi == 0) al_l[r32] = al; asm volatile("s_waitcnt lgkmcnt(0)" ::: "memory"); \
            _Pragma("unroll") for (int d_ = 0; d_ < 4; ++d_) _Pragma("unroll") for (int r = 0; r < 16; ++r) o[d_][r] *= al_l[crow(r, hi)]; } \
        finishSM(p0, p1, al, l_reg, pa0, pa1, pa2, pa3); SBAR(); } while (0)
    LAS unsigned* vflag = (LAS unsigned*)(L + OFF_WS + 2048); unsigned vtarget = 0;
    if (F.tid == 0) { vflag[0] = 0u; vflag[1] = 0u; }
    ALOADK(0, 0); ALOADV(0, 0); ALOADK(64, 1); ALOADV(64, 1);
    asm volatile("s_waitcnt vmcnt(0)" ::: "memory"); __syncthreads();
    int ks = 0, vs = 0;
    for (int t = 0; t < NL; ++t) {
        { const int v2 = vs == 0 ? 2 : vs - 1; ALOADK((t + 2) * 64, (ks + 2) & 3); ALOADV((t + 2) * 64, v2); }
        if (t * 64 <= qlo + 31) {
            bf16x8 pa0, pa1, pa2, pa3;
            ATT_X(t, ks);
            pv_tile(o, vbase + vs * SHM_V, pa0, pa1, pa2, pa3);
        }
        if (t + 1 < NL) asm volatile("s_waitcnt vmcnt(5)" ::: "memory");
        else asm volatile("s_waitcnt vmcnt(0)" ::: "memory");
        __builtin_amdgcn_s_barrier();
        ks = (ks + 1) & 3; vs = vs == 2 ? 0 : vs + 1;
    }
    bf16_t* Ow = WSP(bf16_t, WS_ATTO) + (size_t)(b * SEQ) * BR_LD + h * MLA_V;
    if (!grpB) {
        if (hi == 0) li_l[r32] = l_reg; asm volatile("s_waitcnt lgkmcnt(0)" ::: "memory");
        bf16_t* Or = Ow + (size_t)qlo * BR_LD;
#pragma unroll
        for (int r = 0; r < 16; ++r) { const int orow = crow(r, hi); const float rl = __builtin_amdgcn_rcpf(li_l[orow]);
#pragma unroll
            for (int d0 = 0; d0 < 4; ++d0) { const float v = o[d0][r] * rl; const float vn = __shfl_xor(v, 1);
                if ((r32 & 1) == 0) *(unsigned*)(Or + (size_t)orow * BR_LD + d0 * 32 + r32) = cvt_pk_bf16(v, vn); } }
        qlo = qloH; LOADQ(); m_reg = -1e30f; l_reg = 0.f; ZERO_O();
    }
#define ALOADVG(k0, slot) do { const char* kvb = (const char*)(KV + (size_t)(k0) * 256) - (grpB ? 8192 : 0); const int w3_ = wid & 3; \
        GLDS(kvb + ofV, L + OFF_V + (slot) * SHM_V + w3_ * 1024); GLDS(kvb + 8192 + ofV, L + OFF_V + (slot) * SHM_V + (w3_ + 4) * 1024); \
        GLDS(kvb + 16384 + ofV, L + OFF_V + (slot) * SHM_V + (w3_ + 8) * 1024); GLDS(kvb + 24576 + ofV, L + OFF_V + (slot) * SHM_V + (w3_ + 12) * 1024); } while (0)
    LAS unsigned* gflag = vflag + (grpB ? 1 : 0);
    for (int a = NL; a < NH; a += 2) {
        const bool more = a + 2 < NH;
        const int v1 = vs == 2 ? 0 : vs + 1, v2 = vs == 0 ? 2 : vs - 1;
        if (grpB) { if (a > NL) ALOADVG((a + 1) * 64, v1);
                    if (more) { ALOADK((a + 2) * 64, (ks + 2) & 3); ALOADK((a + 3) * 64, (ks + 3) & 3); } }
        else if (more) { ALOADK((a + 2) * 64, (ks + 2) & 3); ALOADK((a + 3) * 64, (ks + 3) & 3); ALOADVG((a + 2) * 64, v2); }
        const int my = grpB ? a + 1 : a;
        const bool act = my * 64 <= qlo + 31;
        bf16x8 pa0, pa1, pa2, pa3;
        if (act) ATT_X(my, (grpB ? ks + 1 : ks) & 3);
        if (!more) asm volatile("s_waitcnt vmcnt(0)" ::: "memory");
        else if (grpB) asm volatile("s_waitcnt vmcnt(6)" ::: "memory");
        else asm volatile("s_waitcnt vmcnt(10)" ::: "memory");
        if (lane == 0) __hip_atomic_fetch_add(gflag, 1u, __ATOMIC_RELAXED, __HIP_MEMORY_SCOPE_WORKGROUP);
        vtarget += 4u;
        if (act) { while (*(volatile LAS unsigned*)gflag < vtarget) __builtin_amdgcn_s_sleep(1);
                   pv_tile(o, vbase + (grpB ? v1 : vs) * SHM_V, pa0, pa1, pa2, pa3); }
        if (more && !grpB) asm volatile("s_waitcnt vmcnt(4)" ::: "memory");
        else asm volatile("s_waitcnt vmcnt(0)" ::: "memory");
        __builtin_amdgcn_s_barrier();
        ks = (ks + 2) & 3; vs = v2;
    }
#undef ALOADVG
#undef ATT_X
#undef ZERO_O
#undef LOADQ
#undef ALOADV
#undef ALOADK
#undef GLDS
    { LAS float* EXO = (LAS float*)(L + OFF_EXO); LAS float* EXS = (LAS float*)(L + OFF_EXS);
      constexpr float C2 = 1.4426950408889634f * SCALE;
      if (!grpB) {
#pragma unroll
          for (int d = 0; d < 4; ++d)
#pragma unroll
              for (int r = 0; r < 16; ++r) EXO[((wid * 64) + d * 16 + r) * 64 + lane] = o[d][r];
          if (hi == 0) { EXS[(wid * 2 + 0) * 32 + r32] = m_reg; EXS[(wid * 2 + 1) * 32 + r32] = l_reg; }
      } else if (hi == 0) { li_l[r32] = l_reg; al_l[r32] = m_reg; }
      __syncthreads();
      if (grpB) { const int w4 = wid - 4; bf16_t* Or = Ow + (size_t)qlo * BR_LD;
#pragma unroll
          for (int r = 0; r < 16; ++r) { const int orow = crow(r, hi);
              const float mA = EXS[(w4 * 2 + 0) * 32 + orow], lA = EXS[(w4 * 2 + 1) * 32 + orow], mB = al_l[orow], lB = li_l[orow];
              const float M = fmaxf(mA, mB); float fa = __builtin_amdgcn_exp2f((mA - M) * C2), fb = __builtin_amdgcn_exp2f((mB - M) * C2);
              const float rl = __builtin_amdgcn_rcpf(lA * fa + lB * fb); fa *= rl; fb *= rl;
#pragma unroll
              for (int d0 = 0; d0 < 4; ++d0) { const float v = o[d0][r] * fb + EXO[((w4 * 64) + d0 * 16 + r) * 64 + lane] * fa; const float vn = __shfl_xor(v, 1);
                  if ((r32 & 1) == 0) *(unsigned*)(Or + (size_t)orow * BR_LD + d0 * 32 + r32) = cvt_pk_bf16(v, vn); } } }
      __syncthreads(); }
}

__device__ __forceinline__ void p8_router(Frame& F) {
    LAS unsigned char* L = F.lds;
    LAS float* RED = (LAS float*)L;
    LAS float* SSQ = (LAS float*)(L + 32768);
    LAS float* LG = (LAS float*)(L + 36864);
    LAS float* RS = (LAS float*)(L + 41472);
    LAS int* SEL = (LAS int*)(L + 41984);
    const float* X1 = WSP(float, WS_X1); const float* RW = WSP(float, WS_RW); const float* RC = WSP(float, WS_RC); const float* mod = WSP(float, WS_MOD);
    const int lane = F.lane, r = lane & 31, hh = lane >> 5;
    for (int task = F.vcu; task < NTOK / 32; task += F.G) {
        const int row0 = task * 32, b = row0 / SEQ, kbeg = F.wave * 256;
        const float* xa = X1 + (size_t)(row0 + r) * DM + kbeg + 4 * hh;
        const float* wb = RW + ((size_t)b * DM + kbeg + 4 * hh) * NEXP + r;
        f32x16 acc; float ss = 0.f;
#pragma unroll
        for (int i = 0; i < 16; ++i) acc[i] = 0.f;
#pragma unroll 4
        for (int m = 0; m < 32; ++m) { const f32x4 a = *(const f32x4*)(xa + 8 * m);
            const float w0 = wb[(8 * m + 0) * NEXP], w1 = wb[(8 * m + 1) * NEXP], w2 = wb[(8 * m + 2) * NEXP], w3 = wb[(8 * m + 3) * NEXP];
            acc = __builtin_amdgcn_mfma_f32_32x32x2f32(a.x, w0, acc, 0, 0, 0); acc = __builtin_amdgcn_mfma_f32_32x32x2f32(a.y, w1, acc, 0, 0, 0);
            acc = __builtin_amdgcn_mfma_f32_32x32x2f32(a.z, w2, acc, 0, 0, 0); acc = __builtin_amdgcn_mfma_f32_32x32x2f32(a.w, w3, acc, 0, 0, 0);
            ss += (a.x * a.x + a.y * a.y) + (a.z * a.z + a.w * a.w); }
#pragma unroll
        for (int i = 0; i < 16; ++i) RED[(F.wave * 32 + att::crow(i, hh)) * 32 + r] = acc[i];
        SSQ[(F.wave * 2 + hh) * 32 + r] = ss;
        __syncthreads();
#pragma unroll
        for (int q = 0; q < 2; ++q) { const int idx = F.tid + q * 512; float s = 0.f;
#pragma unroll
            for (int w = 0; w < 8; ++w) s += RED[w * 1024 + idx];
            LG[(idx >> 5) * 33 + (idx & 31)] = s; }
        if (F.tid < 32) { float s = 0.f;
#pragma unroll
            for (int w = 0; w < 16; ++w) s += SSQ[w * 32 + F.tid];
            RS[F.tid] = 1.0f / sqrtf(s * (1.0f / DM) + EPS); }
        __syncthreads();
        if (F.tid < 32) { const int row = F.tid; const float rs = RS[row];
            int s0 = -1, s1 = -1, s2 = -1, s3 = -1; float v0 = 0.f, v1 = 0.f, v2 = 0.f, v3 = 0.f;
#pragma unroll
            for (int k = 0; k < 4; ++k) { float best = -__builtin_inff(); int bi = 0;
                for (int e = 0; e < NEXP; ++e) { const float v = rs * LG[row * 33 + e] + RC[b * NEXP + e];
                    const bool taken = (e == s0) | (e == s1) | (e == s2) | (e == s3);
                    if (!taken && v > best) { best = v; bi = e; } }
                if (k == 0) { s0 = bi; v0 = best; } else if (k == 1) { s1 = bi; v1 = best; } else if (k == 2) { s2 = bi; v2 = best; } else { s3 = bi; v3 = best; } }
            const float e0 = 1.0f, e1 = __expf(v1 - v0), e2 = __expf(v2 - v0), e3 = __expf(v3 - v0), inv = 1.0f / (e0 + e1 + e2 + e3);
            *(f32x4*)(WSP(float, WS_TOPW) + (size_t)(row0 + row) * 4) = (f32x4){e0 * inv, e1 * inv, e2 * inv, e3 * inv};
            SEL[row * 4 + 0] = s0; SEL[row * 4 + 1] = s1; SEL[row * 4 + 2] = s2; SEL[row * 4 + 3] = s3; }
        __syncthreads();
        if (F.tid < 32) { const int e = F.tid; int nsel = 0;
            for (int i = 0; i < 128; ++i) nsel += (SEL[i] == e) ? 1 : 0;
            if (nsel) { int slot = (int)__hip_atomic_fetch_add((unsigned*)(F.ctl + CW_CNT + 64 * e), (unsigned)nsel, RLX_AGENT);
                int* rowmap = WSP(int, WS_ROWMAP) + (size_t)e * ECAP; int* topi = WSP(int, WS_TOPI);
                for (int i = 0; i < 128; ++i) if (SEL[i] == e) { rowmap[slot] = row0 + (i >> 2); topi[(size_t)(row0 + (i >> 2)) * 4 + (i & 3)] = e * ECAP + slot; ++slot; } } }
#pragma unroll
        for (int q = 0; q < 4; ++q) { const int m = row0 + F.wave * 4 + q;
            norm_mod_row_bf16<true>(X1 + (size_t)m * DM, F.norm_ffn_w, mod + b * 6 * DM + 3 * DM, mod + b * 6 * DM + 4 * DM, (bf16_t*)(WSP(unsigned char, WS_H) + (size_t)m * DM), F.lane); }
        __syncthreads();
    }
}

__device__ __forceinline__ void moe_tables(Frame& F, int npn, int G, int c) {
    if (F.tid < NEXP) { const unsigned cn = __hip_atomic_load((unsigned*)(F.ctl + CW_CNT + 64 * F.tid), RLX_AGENT); F.LW[LW_CNT + F.tid] = cn; F.LW[LW_NBLK + F.tid] = (cn + 255u) >> 8; }
    __syncthreads();
    if (F.tid == 0) { unsigned sacc = 0; for (int e = 0; e < NEXP; ++e) { F.LW[LW_USTART + e] = sacc; sacc += F.LW[LW_NBLK + e]; } F.LW[LW_USTART + NEXP] = sacc; }
    __syncthreads();
    if (F.tid < 16) { const unsigned Lx = (unsigned)(F.tid * G + c), total = F.LW[LW_USTART + NEXP] * (unsigned)npn;
        unsigned w0 = 0xffffffffu, w1 = 0, w2 = 0, w3 = 0;
        if (Lx < total) { int e = 0; while (Lx >= F.LW[LW_USTART + e + 1] * (unsigned)npn) ++e;
            const unsigned r = Lx - F.LW[LW_USTART + e] * (unsigned)npn, nb = F.LW[LW_NBLK + e], mb = r % nb;
            w0 = (unsigned)e * (ECAP / 256) + mb; w1 = r / nb; w2 = (unsigned)e; w3 = F.LW[LW_CNT + e] - mb * 256u; }
        F.LW[LW_UNITS + 4 * F.tid + 0] = w0; F.LW[LW_UNITS + 4 * F.tid + 1] = w1; F.LW[LW_UNITS + 4 * F.tid + 2] = w2; F.LW[LW_UNITS + 4 * F.tid + 3] = w3; }
    __syncthreads();
}
template <bool GATHER_>
struct MoeOrder {
    static constexpr bool GATHER = true, RGATHER = GATHER_, FP8 = true, DEPWAIT = false;
    const unsigned char* A; const unsigned char* Bt; int ldab, KB, npn; size_t bstride; const int* rowmap; volatile LAS unsigned* LW; int G, c;
    __device__ __forceinline__ bool next(int i, pg8::Unit& u) const {
        if (i >= 16) {
            const unsigned Lx = (unsigned)(i * G + c), total = LW[LW_USTART + NEXP] * (unsigned)npn; if (Lx >= total) return false;
            int e = 0; while (Lx >= LW[LW_USTART + e + 1] * (unsigned)npn) ++e;
            const unsigned r = Lx - LW[LW_USTART + e] * (unsigned)npn, nb = LW[LW_NBLK + e], mb = r % nb;
            u.pn = (int)(r / nb); u.pm = e * (ECAP / 256) + (int)mb; u.aux = e; u.cnt = (int)LW[LW_CNT + e] - (int)mb * 256; return true; }
        const unsigned w0 = LW[LW_UNITS + 4 * i]; if (w0 == 0xffffffffu) return false;
        u.pm = (int)w0; u.pn = (int)LW[LW_UNITS + 4 * i + 1]; u.aux = (int)LW[LW_UNITS + 4 * i + 2]; u.cnt = (int)LW[LW_UNITS + 4 * i + 3]; return true;
    }
    __device__ __forceinline__ const char* a_ptr(const pg8::Unit& u) const { return RGATHER ? (const char*)A : (const char*)A + (size_t)u.pm * 256 * ldab; }
    __device__ __forceinline__ unsigned a_off(const pg8::Unit& u, int row, int colb) const {
        if constexpr (RGATHER) { const int tok = row < u.cnt ? rowmap[(size_t)u.pm * 256 + row] : 0; return (unsigned)(tok * ldab + colb); }
        else return (unsigned)(row * ldab + colb);
    }
    __device__ __forceinline__ const char* b_ptr(const pg8::Unit& u) const { return (const char*)Bt + (size_t)u.aux * bstride + (size_t)u.pn * 256 * KB; }
};

__device__ __forceinline__ bool moe_both_decode(volatile LAS unsigned* LW, unsigned g, unsigned& w0, unsigned& w1, unsigned& w2, unsigned& w3) {
    const unsigned tot = LW[LW_USTART + NEXP], n9 = tot * ((2 * DEXP) / 256);
    unsigned kind = 0, npn = (2 * DEXP) / 256, Lx = g;
    if (g >= n9) { kind = 1; npn = DM / 256; Lx = g - n9; if (Lx >= tot * npn) return false; }
    int e = 0; while (Lx >= LW[LW_USTART + e + 1] * npn) ++e;
    const unsigned r = Lx - LW[LW_USTART + e] * npn, nb = LW[LW_NBLK + e], mb = r % nb;
    w0 = (unsigned)e * (ECAP / 256) + mb; w1 = r / nb; w2 = (unsigned)e | (kind << 8); w3 = LW[LW_CNT + e] - mb * 256u; return true;
}
__device__ __forceinline__ void moe_tables_both(Frame& F, int G, int c) {
    if (F.tid < NEXP) { const unsigned cn = __hip_atomic_load((unsigned*)(F.ctl + CW_CNT + 64 * F.tid), RLX_AGENT); F.LW[LW_CNT + F.tid] = cn; F.LW[LW_NBLK + F.tid] = (cn + 255u) >> 8; }
    __syncthreads();
    if (F.tid == 0) { unsigned sacc = 0; for (int e = 0; e < NEXP; ++e) { F.LW[LW_USTART + e] = sacc; sacc += F.LW[LW_NBLK + e]; } F.LW[LW_USTART + NEXP] = sacc; }
    __syncthreads();
    if (F.tid < 24) { unsigned w0 = 0xffffffffu, w1 = 0, w2 = 0, w3 = 0;
        if (!moe_both_decode(F.LW, (unsigned)(F.tid * G + c), w0, w1, w2, w3)) w0 = 0xffffffffu;
        F.LW[LW_UNITS + 4 * F.tid + 0] = w0; F.LW[LW_UNITS + 4 * F.tid + 1] = w1; F.LW[LW_UNITS + 4 * F.tid + 2] = w2; F.LW[LW_UNITS + 4 * F.tid + 3] = w3; }
    __syncthreads();
}
struct MoeBoth {
    static constexpr bool GATHER = true, FP8 = true, DEPWAIT = true;
    const unsigned char* H2; const unsigned char* ACT; const unsigned char* W1; const unsigned char* W2; int ldab, KB; const int* rowmap; volatile LAS unsigned* LW; const unsigned* blk; int G, c;
    __device__ __forceinline__ bool next(int i, pg8::Unit& u) const {
        unsigned w0, w1, w2, w3;
        if (i >= 24) { if (!moe_both_decode(LW, (unsigned)(i * G + c), w0, w1, w2, w3)) return false; }
        else { w0 = LW[LW_UNITS + 4 * i]; if (w0 == 0xffffffffu) return false; w1 = LW[LW_UNITS + 4 * i + 1]; w2 = LW[LW_UNITS + 4 * i + 2]; w3 = LW[LW_UNITS + 4 * i + 3]; }
        u.pm = (int)w0; u.pn = (int)w1; u.aux = (int)w2; u.cnt = (int)w3; return true;
    }
    __device__ __forceinline__ void wait_ready(const pg8::Unit& u) const {
        if (u.aux >> 8) { while (__hip_atomic_load(blk + u.pm, __ATOMIC_RELAXED, __HIP_MEMORY_SCOPE_AGENT) < 8u * ((2 * DEXP) / 256)) __builtin_amdgcn_s_sleep(2); }
    }
    __device__ __forceinline__ const char* a_ptr(const pg8::Unit& u) const { return (u.aux >> 8) ? (const char*)ACT + (size_t)u.pm * 256 * ldab : (const char*)H2; }
    __device__ __forceinline__ unsigned a_off(const pg8::Unit& u, int row, int colb) const {
        if (u.aux >> 8) return (unsigned)(row * ldab + colb);
        const int tok = row < u.cnt ? rowmap[(size_t)u.pm * 256 + row] : 0; return (unsigned)(tok * ldab + colb);
    }
    __device__ __forceinline__ int a_row(const pg8::Unit& u, int row) const {
        if (u.aux >> 8) return row;
        return row < u.cnt ? rowmap[(size_t)u.pm * 256 + row] : 0; }
    __device__ __forceinline__ const char* b_ptr(const pg8::Unit& u) const { const int e = u.aux & 255;
        return (u.aux >> 8) ? (const char*)W2 + (size_t)e * ((size_t)DM * DEXP) + (size_t)u.pn * 256 * KB : (const char*)W1 + (size_t)e * ((size_t)2 * DEXP * DM) + (size_t)u.pn * 256 * KB; }
};

__device__ __forceinline__ void p11_final(Frame& F) {
    const int gw = F.vcu * NWAVES + F.wave, NGW = F.G * NWAVES;
    const float* X1 = WSP(float, WS_X1); const float* mod = WSP(float, WS_MOD); const float* fmod = WSP(float, WS_FMOD); const unsigned char* Y = WSP(unsigned char, WS_Y);
    for (int m = gw; m < NTOK; m += NGW) { const int b = m / SEQ;
        const int* ti = WSP(int, WS_TOPI) + (size_t)m * 4; const f32x4 tw = *(const f32x4*)(WSP(float, WS_TOPW) + (size_t)m * 4);
        const unsigned char* y0 = Y + (size_t)ti[0] * DM; const unsigned char* y1 = Y + (size_t)ti[1] * DM; const unsigned char* y2 = Y + (size_t)ti[2] * DM; const unsigned char* y3 = Y + (size_t)ti[3] * DM;
        const f32x4 tws = tw * (1.0f / Y8_SCALE);
        const float* gf = mod + b * 6 * DM + 5 * DM;
        f32x4 v[8]; float s = 0.f;
#pragma unroll
        for (int j = 0; j < 8; ++j) { const int c = 4 * F.lane + 256 * j;
            const f32x4 xv = __builtin_nontemporal_load((const f32x4*)(X1 + (size_t)m * DM + c)), g = *(const f32x4*)(gf + c);
            const unsigned a0 = __builtin_nontemporal_load((const unsigned*)(y0 + c)), a1 = __builtin_nontemporal_load((const unsigned*)(y1 + c)), a2 = __builtin_nontemporal_load((const unsigned*)(y2 + c)), a3 = __builtin_nontemporal_load((const unsigned*)(y3 + c));
            const f32x2 l0 = __builtin_amdgcn_cvt_pk_f32_fp8((int)a0, false), h0 = __builtin_amdgcn_cvt_pk_f32_fp8((int)a0, true), l1 = __builtin_amdgcn_cvt_pk_f32_fp8((int)a1, false), h1 = __builtin_amdgcn_cvt_pk_f32_fp8((int)a1, true);
            const f32x2 l2 = __builtin_amdgcn_cvt_pk_f32_fp8((int)a2, false), h2 = __builtin_amdgcn_cvt_pk_f32_fp8((int)a2, true), l3 = __builtin_amdgcn_cvt_pk_f32_fp8((int)a3, false), h3 = __builtin_amdgcn_cvt_pk_f32_fp8((int)a3, true);
            f32x4 acc;
            acc.x = tws.x * l0.x + tws.y * l1.x + tws.z * l2.x + tws.w * l3.x;
            acc.y = tws.x * l0.y + tws.y * l1.y + tws.z * l2.y + tws.w * l3.y;
            acc.z = tws.x * h0.x + tws.y * h1.x + tws.z * h2.x + tws.w * h3.x;
            acc.w = tws.x * h0.y + tws.y * h1.y + tws.z * h2.y + tws.w * h3.y;
            v[j] = xv + g * acc; s += (v[j].x * v[j].x + v[j].y * v[j].y) + (v[j].z * v[j].z + v[j].w * v[j].w); }
        const float rs = 1.0f / sqrtf(wave_sum(s) * (1.0f / DM) + EPS);
#pragma unroll
        for (int j = 0; j < 8; ++j) { const int c = 4 * F.lane + 256 * j; const f32x4 g = *(const f32x4*)(F.norm_final_w + c), sh = *(const f32x4*)(fmod + b * 2 * DM + c), sc = *(const f32x4*)(fmod + b * 2 * DM + DM + c);
            __builtin_nontemporal_store(v[j] * rs * g * (sc + 1.0f) + sh, (f32x4*)(F.out + (size_t)m * DM + c)); }
    }
}

constexpr int NPHASE = 12;
struct Args { const void* in[27]; float* out; unsigned char* ws; int ph_lo, ph_hi, li, pad; };
__global__ void __launch_bounds__(NWAVES * 64, 2) mk_fwd(Args args) {
    extern __shared__ __attribute__((aligned(16))) unsigned char lds_raw[];
    Frame F;
    F.lds = (LAS unsigned char*)lds_raw;
    F.LW = (volatile LAS unsigned*)(F.lds + LDSCTL_OFF);
    F.tid = threadIdx.x; F.lane = F.tid & 63; F.wave = __builtin_amdgcn_readfirstlane(F.tid >> 6);
    F.G = gridDim.x; { const int bx = blockIdx.x; F.vcu = (F.G % 8 == 0) ? (bx % 8) * (F.G / 8) + bx / 8 : bx; }
    F.ws = args.ws; F.ctl = (gu32*)(args.ws + WS_CTL); F.out = args.out;
    F.x = (const float*)args.in[0]; F.c = (const float*)args.in[1]; F.pos = (const int*)args.in[2];
    F.w_ada = (const float*)args.in[3]; F.b_ada = (const float*)args.in[4]; F.norm_mix_w = (const float*)args.in[5]; F.w_in = (const float*)args.in[6];
    F.q_norm_w = (const float*)args.in[7]; F.w_q_b = (const float*)args.in[8]; F.kv_norm_w = (const float*)args.in[9]; F.w_kv_b = (const float*)args.in[10];
    F.w_gk_up = (const float*)args.in[11]; F.b_gk_up = (const float*)args.in[12]; F.gla_norm_w = (const float*)args.in[13];
    F.w_o_mla = (const float*)args.in[14]; F.w_o_gla = (const float*)args.in[15]; F.w_out = (const float*)args.in[16]; F.norm_ffn_w = (const float*)args.in[17];
    F.w_router = (const float*)args.in[18]; F.b_router = (const float*)args.in[19]; F.w1 = (const float*)args.in[20]; F.b1 = (const float*)args.in[21];
    F.w2 = (const float*)args.in[22]; F.b2 = (const float*)args.in[23]; F.w_ada_final = (const float*)args.in[24]; F.b_ada_final = (const float*)args.in[25]; F.norm_final_w = (const float*)args.in[26];
    for (int u = F.tid; u < (LDS_BYTES - LDSCTL_OFF) / 4; u += NWAVES * 64) ((LAS unsigned*)(F.lds + LDSCTL_OFF))[u] = 0u;
    __syncthreads();
    XcdBarrier bar; bar.bar = (unsigned*)(F.ctl + CW_BAR); bar.x = 0; bar.st = nullptr;
    if (MK_ONE_LAUNCH) bar = xcd_barrier_post((unsigned*)(F.ctl + CW_BAR), F.LW + LW_BAR);
    const int lo = args.ph_lo, hi = args.ph_hi;
#ifndef PH_MASK
#define PH_MASK 0xFFF
#endif
#define IN(k) (((PH_MASK >> (k)) & 1) && lo <= (k) && (k) < hi)
#define SEAM(k) do { if (IN(k) && IN((k) + 1)) xcd_barrier(bar); } while (0)
    const int cid = F.vcu;

    if (IN(0)) { p0_prologue(F); if (MK_ONE_LAUNCH) { wait_gemv(F); p1_norm(F); } } if (!MK_ONE_LAUNCH) SEAM(0);
    if (IN(1)) { if (!MK_ONE_LAUNCH) p1_norm(F); } SEAM(1);
    if (IN(2)) {
        constexpr int RP0 = 14, NX15 = 2;
        const bool split = (F.G == 256);
        const int idx = cid & 31, xc = cid >> 5;
        const int rpx = RP0 + (xc < NX15 ? 1 : 0), gbase = RP0 * xc + (xc < NX15 ? xc : NX15), cbase = (32 - RP0) * xc - (xc < NX15 ? xc : NX15);
        constexpr int NGW_ = 8 * RP0 + NX15, NCW_ = 256 - NGW_;
        if (!split || idx < rpx) {
            pg8::DenseOrder S; S.init(WSP(bf16_t, WS_H), DM, WSP(bf16_t, WS_WIN), NTOK, DINP, DM, split ? NGW_ : F.G, split ? gbase + idx : cid);
            epi::Bf16Plain E{WSP(bf16_t, WS_PROJ), DINP};
            pg8::gemm_phase_b3(F.lds, S, E);
        }
        if (!split) moe_convert(F, cid, F.G); else if (idx >= rpx) moe_convert(F, cbase + (idx - rpx), NCW_);
    } SEAM(2);
    if (IN(3)) {
        p3_rows(F);
        for (int u = cid; u < NB * GLA_H * GLA_NCH; u += F.G) gla_pass1_unit(F, u);
    } SEAM(3);
    if (IN(4)) {
        { pg8::DenseOrder S; S.init(WSP(bf16_t, WS_PROJ) + C_CKV, DINP, WSP(bf16_t, WS_WKV), NTOK, NKV, MLA_KVR, F.G, cid);
          epi::Bf16RowScale E{WSP(bf16_t, WS_KV), NKV, WSP(float, WS_RSKV)};
          pg8::gemm_phase(F.lds, S, E); }
        { pg8::DenseOrder S; S.init(WSP(bf16_t, WS_PROJ) + C_QLAT, DINP, WSP(bf16_t, WS_WQ), NTOK, NQ, MLA_QR, F.G, cid);
          epi::QRope E{WSP(bf16_t, WS_Q), WSP(float, WS_RSQ), WSP(float, WS_CS)};
          pg8::gemm_phase(F.lds, S, E); }
        gla_pass2(F);
    } SEAM(4);
    if (IN(5)) {
#ifndef NO_ATT
        for (int it = cid; it < NB * MLA_H * 16; it += F.G) attn_item(F, it);
#endif
#ifndef NO_GLA3
        for (;;) {
            if (F.tid == 0) F.LW[LW_TMP] = __hip_atomic_fetch_add((unsigned*)(F.ctl + CW_GQ), 1u, RLX_AGENT);
            __syncthreads();
            const int u = (int)F.LW[LW_TMP];
            __syncthreads();
            if (u >= NB * GLA_H * GLA_NCH) break;
            gla_pass3_unit(F, u);
        }
#endif
    } SEAM(5);
    if (IN(6)) {
        pg8::DenseOrder S; S.init(WSP(bf16_t, WS_ATTO), BR_LD, WSP(bf16_t, WS_WOM), NTOK, DM, 2048, F.G, cid);
        epi::GateMerge2 E{WSP(bf16_t, WS_MERGED), WSP(bf16_t, WS_PROJ)};
        pg8::gemm_phase(F.lds, S, E);
    } SEAM(6);
    if (IN(7)) {
        pg8::DenseOrder S; S.init(WSP(bf16_t, WS_MERGED), DM, WSP(bf16_t, WS_WOUT), NTOK, DM, DM, F.G, cid);
        epi::ResidGateF32 E{WSP(float, WS_X1), F.x, WSP(float, WS_MOD) + 2 * DM};
        pg8::gemm_phase(F.lds, S, E);
    } SEAM(7);
    if (IN(8)) { p8_router(F); } SEAM(8);
    if (IN(9)) {
        moe_tables_both(F, F.G, cid);
        MoeBoth S{WSP(unsigned char, WS_H), WSP(unsigned char, WS_ACT), WSP(unsigned char, WS_W1), WSP(unsigned char, WS_W2), DM, DM, WSP(int, WS_ROWMAP), F.LW, (const unsigned*)(F.ctl + CW_BLK), F.G, cid};
        epi::MoeEpi E{WSP(unsigned char, WS_ACT), F.b1, WSP(unsigned char, WS_Y), F.b2, (unsigned*)(F.ctl + CW_BLK)};
        pg8::gemm_phase_b3(F.lds, S, E);
    }
    SEAM(10);
    if (IN(11)) { p11_final(F); }
#undef IN
#undef SEAM
}

extern "C" void kernel_launch(void* const* d_in, const int* in_sizes, int n_in, void* d_out, int out_size, void* d_ws, size_t ws_size, hipStream_t stream) {
    static int grid = 0;
    if (grid == 0) {
        if (n_in != 27 || in_sizes[0] != NTOK * DM || out_size != NTOK * DM || ws_size < WS_END) { fprintf(stderr, "kernel_launch: unexpected shapes (n_in %d, in0 %d, out %d, ws %zu < %zu); nothing launched\n", n_in, n_in > 0 ? in_sizes[0] : -1, out_size, ws_size, (size_t)WS_END); grid = -1; return; }
        int dev = 0, cus = 0, per_cu = 0;
        if (hipGetDevice(&dev) != hipSuccess || hipDeviceGetAttribute(&cus, hipDeviceAttributeMultiprocessorCount, dev) != hipSuccess) { fprintf(stderr, "kernel_launch: device query failed\n"); grid = -1; return; }
        if (hipFuncSetAttribute((const void*)mk_fwd, hipFuncAttributeMaxDynamicSharedMemorySize, LDS_BYTES) != hipSuccess) { fprintf(stderr, "kernel_launch: hipFuncSetAttribute failed\n"); grid = -1; return; }
        if (hipOccupancyMaxActiveBlocksPerMultiprocessor(&per_cu, (const void*)mk_fwd, NWAVES * 64, LDS_BYTES) != hipSuccess || per_cu < 1) { fprintf(stderr, "kernel_launch: occupancy query reports %d workgroups per CU\n", per_cu); }
        (void)hipGetLastError();
        grid = cus;
    }
    if (grid < 0) return;
    if (hipMemsetAsync((char*)d_ws + WS_CTL, 0, CTL_ZERO_BYTES, stream) != hipSuccess) { fprintf(stderr, "kernel_launch: memset failed\n"); return; }
    Args a{};
    for (int i = 0; i < 27; ++i) a.in[i] = d_in[i];
    a.out = (float*)d_out; a.ws = (unsigned char*)d_ws; a.pad = 0;
#if MK_ONE_LAUNCH
    a.ph_lo = 0; a.ph_hi = NPHASE; a.li = 0;
    hipLaunchKernelGGL(mk_fwd, dim3(grid), dim3(NWAVES * 64), LDS_BYTES, stream, a);
#else
#ifndef REP_MASK
#define REP_MASK 0
#endif
#ifndef REP_CNT
#define REP_CNT 1
#endif
    for (int p = 0; p < NPHASE; ++p) for (int rep = 0; rep <= ((REP_MASK >> p) & 1) * REP_CNT; ++rep) { a.ph_lo = p; a.ph_hi = p + 1; a.li = p; hipLaunchKernelGGL(mk_fwd, dim3(grid), dim3(NWAVES * 64), LDS_BYTES, stream, a); }
#endif
    const hipError_t le = hipPeekAtLastError();
    if (le != hipSuccess) fprintf(stderr, "kernel_launch: launch failed: %s\n", hipGetErrorName(le));
}
```

```cpp
#include <hip/hip_runtime.h>
#include <cstdio>
#include <cstdint>

#ifndef MK_ONE_LAUNCH
#define MK_ONE_LAUNCH 1
#endif

#define GAS __attribute__((address_space(1)))
#define LAS __attribute__((address_space(3)))
typedef unsigned short bf16_t;
typedef short bf16x8 __attribute__((ext_vector_type(8)));
typedef short s16x4 __attribute__((ext_vector_type(4)));
typedef float f32x2 __attribute__((ext_vector_type(2)));
typedef float f32x4 __attribute__((ext_vector_type(4)));
typedef float f32x16 __attribute__((ext_vector_type(16)));
typedef unsigned u32x2 __attribute__((ext_vector_type(2)));
typedef unsigned u32x4 __attribute__((ext_vector_type(4)));
typedef GAS unsigned gu32;

constexpr int DM = 2048, NB = 2, SEQ = 4096, NTOK = NB * SEQ;
constexpr int MLA_H = 8, MLA_QR = 512, MLA_KVR = 256, MLA_NOPE = 128, MLA_ROPE = 64, MLA_V = 128, MLA_QK = MLA_NOPE + MLA_ROPE;
constexpr int GLA_H = 4, GLA_DK = 128, GLA_DV = 256, GLA_R = 16, GLA_C = 64, GLA_NCH = SEQ / GLA_C;
constexpr int NEXP = 32, TOPK = 4, DEXP = 2048;
constexpr float EPS = 1e-6f;
constexpr int DIN = 8016, DINP = 8192;
constexpr int C_QLAT = 0, C_CKV = 512, C_KPE = 768, C_GQ = 832, C_GK = 1344, C_GV = 1856, C_GLR = 2880, C_GOUT = 2896, C_GA = 3920, C_GB = 5968;
constexpr int NQ = MLA_H * MLA_QK;
constexpr int NKV = MLA_H * (MLA_NOPE + MLA_V);
constexpr int ECAP = NTOK;

typedef __bf16 bf16x2_hw __attribute__((ext_vector_type(2)));
__device__ __forceinline__ unsigned cvt_pk_bf16(float lo, float hi) { const f32x2 v = {lo, hi}; return __builtin_bit_cast(unsigned, __builtin_convertvector(v, bf16x2_hw)); }
__device__ __forceinline__ float bf_lo(unsigned w) { return __uint_as_float(w << 16); }
__device__ __forceinline__ float bf_hi(unsigned w) { return __uint_as_float(w & 0xffff0000u); }
__device__ __forceinline__ float bf2f(bf16_t b) { return __uint_as_float(((unsigned)b) << 16); }
__device__ __forceinline__ float fast_exp(float x) { return __builtin_amdgcn_exp2f(x * 1.4426950408889634f); }
__device__ __forceinline__ float fast_sigmoid(float x) { return __builtin_amdgcn_rcpf(1.0f + __builtin_amdgcn_exp2f(-x * 1.4426950408889634f)); }
__device__ __forceinline__ float wave_sum(float v) {
#pragma unroll
    for (int o = 1; o < 64; o <<= 1) v += __shfl_xor(v, o);
    return v;
}
__device__ __forceinline__ unsigned pk4_fp8(float a, float b, float c, float d) { int w = 0; w = __builtin_amdgcn_cvt_pk_fp8_f32(a, b, w, false); w = __builtin_amdgcn_cvt_pk_fp8_f32(c, d, w, true); return (unsigned)w; }
constexpr float W8_SCALE = 256.0f, A8_SCALE = 4.0f, Y8_SCALE = 16.0f;
#define LDS_WAIT() asm volatile("s_waitcnt lgkmcnt(0)" ::: "memory")
#define VM_WAIT() asm volatile("s_waitcnt vmcnt(0)" ::: "memory")
#define RLX_AGENT __ATOMIC_RELAXED, __HIP_MEMORY_SCOPE_AGENT

namespace pg8 {
constexpr int BM = 256, BK = 64, HALF = 128, HTB = HALF * BK * 2, STAGE_BYTES = 8 * HTB, NXCD = 8, WGM = 8;
__host__ __device__ __forceinline__ int lds_byte(int r, int c) { const int st = (r >> 4) * 2 + (c >> 5), rr = r & 15, cc = c & 31, ob = rr * 64 + cc * 2; return st * 1024 + (ob ^ (((ob >> 9) & 1) << 5)); }
__host__ __device__ __forceinline__ void stage_rc(int b, int& R, int& C) { const int st = b / 1024, sb = b % 1024, swz = sb ^ (((sb >> 9) & 1) << 5); R = (st >> 1) * 16 + swz / 64; C = (st & 1) * 32 + (swz % 64) / 2; }
__host__ __device__ __forceinline__ int perm32(int rho) { const int n = rho >> 4, i = rho & 15; return 8 * (i >> 2) + 4 * n + (i & 3); }

struct Unit { int pm, pn, aux, cnt; };
typedef int v4i_t __attribute__((ext_vector_type(4)));
typedef int v8i_t __attribute__((ext_vector_type(8)));
__device__ __forceinline__ v8i_t ld_frag8(const LAS unsigned char* p) {
    const v4i_t lo = *(const LAS v4i_t*)p, hi = *(const LAS v4i_t*)(p + 1024);
    return __builtin_shufflevector(lo, hi, 0, 1, 2, 3, 4, 5, 6, 7);
}
template <bool FP8> struct FragT { typedef bf16x8 T[2]; };
template <> struct FragT<true> { typedef v8i_t T; };

struct DenseOrder {
    static constexpr bool GATHER = false, FP8 = false, DEPWAIT = false, ROWDMA = false;
    const bf16_t* A; const bf16_t* Bt; int ldab, KB;
    int nM, nN, nwg, G, c;
    __device__ __forceinline__ void init(const bf16_t* A_, int lda_, const bf16_t* Bt_, int M, int N, int K_, int G_, int c_) { A = A_; ldab = lda_ * 2; Bt = Bt_; KB = K_ * 2; nM = M / BM; nN = N / BM; nwg = nM * nN; G = G_; c = c_; }
    __device__ __forceinline__ bool next(int i, Unit& u) const {
        const long L = (long)i * G + c; if (L >= nwg) return false;
        int wgid = (int)L; { const int q = nwg / NXCD, r = nwg % NXCD, xcd = wgid % NXCD, off = wgid / NXCD; wgid = (xcd < r ? xcd * (q + 1) : r * (q + 1) + (xcd - r) * q) + off; }
        const int nig = WGM * nN, gid = wgid / nig, fm = gid * WGM, gsz = (nM - fm) < WGM ? (nM - fm) : WGM;
        u.pm = fm + ((wgid % nig) % gsz); u.pn = (wgid % nig) / gsz; u.aux = 0; u.cnt = 0; return true;
    }
    __device__ __forceinline__ const char* a_ptr(const Unit& u) const { return (const char*)A + (size_t)u.pm * BM * ldab; }
    __device__ __forceinline__ unsigned a_off(const Unit&, int row, int colb) const { return (unsigned)(row * ldab + colb); }
    __device__ __forceinline__ int a_row(const Unit&, int row) const { return row; }
    __device__ __forceinline__ const char* b_ptr(const Unit& u) const { return (const char*)Bt + (size_t)u.pn * BM * KB; }
};

template <class Epi, class Sched>
__device__ __forceinline__ void gemm_phase(LAS unsigned char* lds, const Sched& S, const Epi& E) {
    const int tid = threadIdx.x, wid = __builtin_amdgcn_readfirstlane(tid >> 6), lane = tid & 63, wr = wid >> 2, wc = wid & 3, fr = lane & 15, fq = lane >> 4;
    int KB = S.KB; asm volatile("" : "+s"(KB));
    const int nt = KB / (BK * 2);
    int sR[2], sC[2]; unsigned voffB[2];
#pragma unroll
    for (int i = 0; i < 2; ++i) { int R, C; stage_rc(tid * 16 + i * 8192, R, C); sR[i] = R; sC[i] = 2 * C; const int Rb = (R & ~31) + perm32(R & 31); voffB[i] = (unsigned)(Rb * KB + 2 * C); }
    const size_t kstep = (size_t)(BK * 2);
    const size_t hstep = (size_t)HALF * KB;
    const unsigned ldsw = (unsigned)wid * 1024u;
    const int aoff = lds_byte(wr * 64 + fr, fq * 8), boff = lds_byte(wc * 32 + fr, fq * 8);
#define PG8_SA(b, h) (((b) * 2 + (h)) * HTB)
#define PG8_SB(b, h) ((4 + (b) * 2 + (h)) * HTB)
#define PG8_STAGE(bufoff, gbase, v0, v1) do { \
        __builtin_amdgcn_global_load_lds((const unsigned*)((const char*)(gbase) + (v0)), (LAS unsigned*)(lds + (bufoff) + ldsw), 16, 0, 0); \
        __builtin_amdgcn_global_load_lds((const unsigned*)((const char*)(gbase) + (v1)), (LAS unsigned*)(lds + (bufoff) + ldsw + 8192), 16, 0, 0); } while (0)
#define PG8_STAGEB(bufoff, gbase) PG8_STAGE(bufoff, gbase, voffB[0], voffB[1])
#define PG8_LDA(dst, b, h) do { _Pragma("unroll") for (int m = 0; m < 4; ++m) { if constexpr (Sched::FP8) dst[m] = ld_frag8(lds + PG8_SA(b, h) + aoff + m * 2048); \
        else { _Pragma("unroll") for (int k = 0; k < 2; ++k) dst[m][k] = *(const LAS bf16x8*)(lds + PG8_SA(b, h) + aoff + m * 2048 + k * 1024); } } } while (0)
#define PG8_LDB(dst, b, h) do { _Pragma("unroll") for (int n = 0; n < 2; ++n) { if constexpr (Sched::FP8) dst[n] = ld_frag8(lds + PG8_SB(b, h) + boff + n * 2048); \
        else { _Pragma("unroll") for (int k = 0; k < 2; ++k) dst[n][k] = *(const LAS bf16x8*)(lds + PG8_SB(b, h) + boff + n * 2048 + k * 1024); } } } while (0)
#define PG8_MMA(ai, bj, At, Bt) do { __builtin_amdgcn_s_setprio(1); _Pragma("unroll") for (int m = 0; m < 4; ++m) _Pragma("unroll") for (int n = 0; n < 2; ++n) { \
        if constexpr (Sched::FP8) acc[ai][bj][m][n] = __builtin_amdgcn_mfma_scale_f32_16x16x128_f8f6f4(Bt[n], At[m], acc[ai][bj][m][n], 0, 0, 0, 0, 0, 0); \
        else { _Pragma("unroll") for (int k = 0; k < 2; ++k) acc[ai][bj][m][n] = __builtin_amdgcn_mfma_f32_16x16x32_bf16(Bt[n][k], At[m][k], acc[ai][bj][m][n], 0, 0, 0); } } \
        __builtin_amdgcn_s_setprio(0); } while (0)
#define PG8_WAIT_V(n) asm volatile("s_waitcnt vmcnt(" #n ")" ::: "memory")
#define PG8_WAIT_L(n) asm volatile("s_waitcnt lgkmcnt(" #n ")" ::: "memory")
#define PG8_BAR __builtin_amdgcn_s_barrier()
#define PG8_SCHED __builtin_amdgcn_sched_barrier(0)
#define PG8_KITER(t) do { \
            const bool last = (t == nt - 2); \
            const char* a1 = cA + (size_t)(t + 1) * kstep; \
            const char* a2 = last ? nA : cA + (size_t)(t + 2) * kstep; const char* b2 = last ? nB : cB + (size_t)(t + 2) * kstep; \
            const char* a3 = a2 + kstep; const char* b3 = b2 + kstep; \
            PG8_LDB(B0, 0, 0); PG8_LDB(B1, 0, 1); PG8_SCHED; PG8_LDA(At, 0, 0); PG8_STAGE(PG8_SA(1, 1), a1, vc[1][0], vc[1][1]); \
            if constexpr (Sched::GATHER) { if (last) { \
                _Pragma("unroll") \
                for (int h = 0; h < 2; ++h) \
                _Pragma("unroll") \
                    for (int i = 0; i < 2; ++i) vc[h][i] = vn[h][i]; } } \
            PG8_WAIT_V(8); PG8_WAIT_L(0); PG8_BAR; PG8_MMA(0, 0, At, B0); PG8_MMA(0, 1, At, B1); PG8_BAR; PG8_SCHED; \
            PG8_LDA(At, 0, 1); PG8_STAGEB(PG8_SB(0, 0), b2); PG8_STAGEB(PG8_SB(0, 1), b2 + hstep); PG8_STAGE(PG8_SA(0, 0), a2, vc[0][0], vc[0][1]); \
            PG8_WAIT_V(8); PG8_WAIT_L(0); PG8_BAR; PG8_MMA(1, 0, At, B0); PG8_MMA(1, 1, At, B1); PG8_BAR; PG8_SCHED; \
            PG8_LDB(B0, 1, 0); PG8_LDB(B1, 1, 1); PG8_SCHED; PG8_LDA(At, 1, 0); PG8_STAGE(PG8_SA(0, 1), a2, vc[1][0], vc[1][1]); \
            PG8_WAIT_V(8); PG8_WAIT_L(0); PG8_BAR; PG8_MMA(0, 0, At, B0); PG8_MMA(0, 1, At, B1); PG8_BAR; PG8_SCHED; \
            PG8_LDA(At, 1, 1); PG8_STAGEB(PG8_SB(1, 0), b3); PG8_STAGEB(PG8_SB(1, 1), b3 + hstep); PG8_STAGE(PG8_SA(1, 0), a3, vc[0][0], vc[0][1]); \
            PG8_WAIT_V(8); PG8_WAIT_L(0); PG8_BAR; PG8_MMA(1, 0, At, B0); PG8_MMA(1, 1, At, B1); PG8_BAR; PG8_SCHED; \
        } while (0)
    Unit cur, nxt; int ui = 0;
    if (!S.next(0, cur)) return;
    f32x4 acc[2][2][4][2];
#pragma unroll
    for (int a = 0; a < 2; ++a)
#pragma unroll
        for (int b = 0; b < 2; ++b)
#pragma unroll
            for (int m = 0; m < 4; ++m)
#pragma unroll
                for (int n = 0; n < 2; ++n) acc[a][b][m][n] = (f32x4){0.f, 0.f, 0.f, 0.f};
    typename FragT<Sched::FP8>::T At[4], B0[2], B1[2];
    unsigned vc[2][2], vn[2][2];
#pragma unroll
    for (int h = 0; h < 2; ++h)
#pragma unroll
        for (int i = 0; i < 2; ++i) { vc[h][i] = S.a_off(cur, 128 * h + sR[i], sC[i]); asm volatile("" : "+v"(vc[h][i])); vn[h][i] = vc[h][i]; }
    const char* cA = S.a_ptr(cur); const char* cB = S.b_ptr(cur);
    if constexpr (Sched::DEPWAIT) S.wait_ready(cur);
    if constexpr (Epi::PREBIAS) { if (wid == 0) E.pre(cur, (LAS float*)(lds + STAGE_BYTES), lane); }
    PG8_STAGEB(PG8_SB(0, 0), cB); PG8_STAGEB(PG8_SB(0, 1), cB + hstep); PG8_STAGE(PG8_SA(0, 0), cA, vc[0][0], vc[0][1]); PG8_STAGE(PG8_SA(0, 1), cA, vc[1][0], vc[1][1]);
    if (wr == 1) PG8_BAR;
    PG8_WAIT_V(2); PG8_BAR;
    PG8_STAGEB(PG8_SB(1, 0), cB + kstep); PG8_STAGE(PG8_SA(1, 0), cA + kstep, vc[0][0], vc[0][1]); PG8_STAGEB(PG8_SB(1, 1), cB + hstep + kstep);
    PG8_WAIT_V(6); PG8_BAR;
    for (;;) {
        const bool has_next = S.next(ui + 1, nxt);
        const char* nA = has_next ? S.a_ptr(nxt) : cA; const char* nB = has_next ? S.b_ptr(nxt) : cB;
        if constexpr (Sched::GATHER) {
            if (has_next) {
                int tz = threadIdx.x; asm volatile("" : "+v"(tz));
#pragma unroll
                for (int h = 0; h < 2; ++h)
#pragma unroll
                    for (int i = 0; i < 2; ++i) { int R, C; stage_rc(tz * 16 + i * 8192, R, C); vn[h][i] = S.a_off(nxt, 128 * h + R, 2 * C); }
            }
        }
        if constexpr (Epi::MIDHOOK) {
            for (int t = 0; t < nt / 2; t += 2) PG8_KITER(t);
            { int tz = threadIdx.x; asm volatile("" : "+v"(tz)); const int we = tz >> 6, le = tz & 63; E.mid(acc, cur, we >> 2, we & 3, le & 15, le >> 4); }
            for (int t = nt / 2; t < nt; t += 2) PG8_KITER(t);
        } else if constexpr (Sched::DEPWAIT) {
            for (int t = 0; t < nt; t += 2) { if (t == nt - 2 && has_next) S.wait_ready(nxt); PG8_KITER(t); }
        } else { for (int t = 0; t < nt; t += 2) PG8_KITER(t); }
        if (wr == 0) PG8_BAR;
        { int tz = threadIdx.x; asm volatile("" : "+v"(tz)); const int we = tz >> 6, le = tz & 63;
          if constexpr (Epi::PREBIAS) E(acc, cur, we >> 2, we & 3, le & 15, le >> 4, (const LAS float*)(lds + STAGE_BYTES + (ui & 1) * 1024)); else E(acc, cur, we >> 2, we & 3, le & 15, le >> 4); }
        if (!has_next) break;
#pragma unroll
        for (int a = 0; a < 2; ++a)
#pragma unroll
            for (int b = 0; b < 2; ++b)
#pragma unroll
                for (int m = 0; m < 4; ++m)
#pragma unroll
                    for (int n = 0; n < 2; ++n) acc[a][b][m][n] = (f32x4){0.f, 0.f, 0.f, 0.f};
        cur = nxt; cA = nA; cB = nB; ++ui;
        if constexpr (Epi::PREBIAS) { if (wid == 0) E.pre(cur, (LAS float*)(lds + STAGE_BYTES + (ui & 1) * 1024), lane); }
        if (wr == 1) PG8_BAR;
    }
    PG8_WAIT_V(0);
    PG8_BAR;
#undef PG8_SA
#undef PG8_SB
#undef PG8_STAGE
#undef PG8_STAGEB
#undef PG8_LDA
#undef PG8_LDB
#undef PG8_MMA
#undef PG8_WAIT_V
#undef PG8_WAIT_L
#undef PG8_BAR
#undef PG8_SCHED
#undef PG8_KITER
}

template <class E, class = void> struct epi_deferpub { static constexpr bool value = false; };
template <class E> struct epi_deferpub<E, decltype((void)E::DEFERPUB)> { static constexpr bool value = E::DEFERPUB; };
template <class Epi, class Sched>
__device__ __forceinline__ void gemm_phase_b3(LAS unsigned char* lds, const Sched& S, const Epi& E) {
    const int tid = threadIdx.x, wid = __builtin_amdgcn_readfirstlane(tid >> 6), lane = tid & 63, wr = wid >> 2, wc = wid & 3, fr = lane & 15, fq = lane >> 4;
    const bool roleB = wc < 2; const int jr = wr * 2 + (wc & 1);
    int KB = S.KB; asm volatile("" : "+s"(KB));
    const int nt = KB / (BK * 2);
    constexpr int B_BASE = 5 * HTB, B_STAGE = 2 * HTB, BIAS_OFF = B_BASE + 2 * B_STAGE;
    const size_t kstep = (size_t)(BK * 2), hstep = (size_t)HALF * KB;
    const int aoff = lds_byte(wr * 64 + fr, fq * 8), boff = lds_byte(wc * 32 + fr, fq * 8);
    const unsigned pw = (unsigned)jr * 1024u;
    unsigned vs[8];
    LAS int* rowtab = (LAS int*)(lds + BIAS_OFF + 2048 + 8192);
    LAS unsigned* depflag = (LAS unsigned*)(lds + BIAS_OFF + 2048 + 8192 + 2048);
    LAS u32x4* park = (LAS u32x4*)(lds + BIAS_OFF + 2048) + tid;
#pragma unroll
    for (int i = 0; i < 4; ++i) { int R, C; stage_rc((jr + 4 * i) * 1024 + lane * 16, R, C); const int Rb = (R & ~31) + perm32(R & 31); vs[i] = (unsigned)(Rb * KB + 2 * C); vs[4 + i] = 0u; }
#define B3_STAGE4(ldsoff, gbase, v) do { _Pragma("unroll") for (int i_ = 0; i_ < 4; ++i_) \
        __builtin_amdgcn_global_load_lds((const unsigned*)((const char*)(gbase) + (v)[i_]), (LAS unsigned*)(lds + (ldsoff) + pw + 4096 * i_), 16, 0, 0); } while (0)
#define B3_LDA(dst, base) do { _Pragma("unroll") for (int m = 0; m < 4; ++m) { if constexpr (Sched::FP8) dst[m] = ld_frag8(lds + (base) + aoff + m * 2048); \
        else { _Pragma("unroll") for (int k = 0; k < 2; ++k) dst[m][k] = *(const LAS bf16x8*)(lds + (base) + aoff + m * 2048 + k * 1024); } } } while (0)
#define B3_LDB(dst, base) do { _Pragma("unroll") for (int n = 0; n < 2; ++n) { if constexpr (Sched::FP8) dst[n] = ld_frag8(lds + (base) + boff + n * 2048); \
        else { _Pragma("unroll") for (int k = 0; k < 2; ++k) dst[n][k] = *(const LAS bf16x8*)(lds + (base) + boff + n * 2048 + k * 1024); } } } while (0)
#define B3_MMA(ai, bj, At, Bt) do { __builtin_amdgcn_s_setprio(1); _Pragma("unroll") for (int m = 0; m < 4; ++m) _Pragma("unroll") for (int n = 0; n < 2; ++n) { \
        if constexpr (Sched::FP8) acc[ai][bj][m][n] = __builtin_amdgcn_mfma_scale_f32_16x16x128_f8f6f4(Bt[n], At[m], acc[ai][bj][m][n], 0, 0, 0, 0, 0, 0); \
        else { _Pragma("unroll") for (int k = 0; k < 2; ++k) acc[ai][bj][m][n] = __builtin_amdgcn_mfma_f32_16x16x32_bf16(Bt[n][k], At[m][k], acc[ai][bj][m][n], 0, 0, 0); } } \
        __builtin_amdgcn_s_setprio(0); } while (0)
#define B3_PIN(ai) do { _Pragma("unroll") for (int b_ = 0; b_ < 2; ++b_) _Pragma("unroll") for (int m_ = 0; m_ < 4; ++m_) \
        asm volatile("" : "+v"(acc[ai][b_][m_][0]), "+v"(acc[ai][b_][m_][1])); } while (0)
#define B3_WAIT_L0 asm volatile("s_waitcnt lgkmcnt(0)" ::: "memory")
#define B3_BAR __builtin_amdgcn_s_barrier()
#define B3_SCHED __builtin_amdgcn_sched_barrier(0)
    Unit cur, nxt; int ui = 0;
    if (!S.next(0, cur)) return;
    f32x4 acc[2][2][4][2];
#pragma unroll
    for (int a = 0; a < 2; ++a)
#pragma unroll
        for (int b = 0; b < 2; ++b)
#pragma unroll
            for (int m = 0; m < 4; ++m)
#pragma unroll
                for (int n = 0; n < 2; ++n) acc[a][b][m][n] = (f32x4){0.f, 0.f, 0.f, 0.f};
    typename FragT<Sched::FP8>::T At[4], B0[2], B1[2];
#define B3_ROWS(dst, U_) do { int tz_ = threadIdx.x; asm volatile("" : "+v"(tz_)); const int jr_ = ((tz_ >> 8) & 1) * 2 + ((tz_ >> 6) & 1), ln_ = tz_ & 63; \
        _Pragma("unroll") for (int h_ = 0; h_ < 2; ++h_) _Pragma("unroll") for (int i_ = 0; i_ < 4; i_ += 2) { int R0_, C0_, R1_, C1_; stage_rc((jr_ + 4 * i_) * 1024 + ln_ * 16, R0_, C0_); stage_rc((jr_ + 4 * i_ + 4) * 1024 + ln_ * 16, R1_, C1_); \
            dst[h_ * 2 + (i_ >> 1)] = (unsigned)S.a_row(U_, 128 * h_ + R0_) | ((unsigned)S.a_row(U_, 128 * h_ + R1_) << 16); } } while (0)
#define B3_UNPACK(srcp) do { int tz_ = threadIdx.x; asm volatile("" : "+v"(tz_)); const int jr_ = ((tz_ >> 8) & 1) * 2 + ((tz_ >> 6) & 1), ln_ = tz_ & 63; \
        _Pragma("unroll") for (int h_ = 0; h_ < 2; ++h_) _Pragma("unroll") for (int i_ = 0; i_ < 4; ++i_) { int R_, C_; stage_rc((jr_ + 4 * i_) * 1024 + ln_ * 16, R_, C_); \
            const unsigned rw_ = (srcp[h_ * 2 + (i_ >> 1)] >> ((i_ & 1) * 16)) & 0xffffu; vs[h_ * 4 + i_] = rw_ * (unsigned)S.ldab + 2u * (unsigned)C_; } } while (0)
    if (!roleB) { if constexpr (Sched::DEPWAIT) S.wait_ready(cur); unsigned vnp[4]; B3_ROWS(vnp, cur); B3_UNPACK(vnp); *park = (u32x4){vnp[0], vnp[1], vnp[2], vnp[3]}; }
    const char* cA = S.a_ptr(cur); const char* cB = S.b_ptr(cur);
    if constexpr (Epi::PREBIAS) { if (wid == 0) E.pre(cur, (LAS float*)(lds + BIAS_OFF), lane); }
    if (roleB) {
#pragma unroll
        for (int s = 0; s < 2; ++s) { B3_STAGE4(B_BASE + s * B_STAGE, cB + s * kstep, vs); B3_STAGE4(B_BASE + s * B_STAGE + HTB, cB + s * kstep + hstep, vs); }
    } else { B3_STAGE4(0, cA, vs); B3_STAGE4(HTB, cA, (vs + 4)); B3_STAGE4(2 * HTB, cA + kstep, vs); B3_STAGE4(3 * HTB, cA + kstep, (vs + 4)); }
    if (wr == 1) B3_BAR;
    asm volatile("s_waitcnt vmcnt(0)" ::: "memory"); B3_BAR; B3_BAR;
    int pend = -1;
    int aL = 0, sB = 0;
    for (;;) {
        const bool has_next = S.next(ui + 1, nxt);
        const char* nA = has_next ? S.a_ptr(nxt) : cA; const char* nB = has_next ? S.b_ptr(nxt) : cB;
        if constexpr (Sched::ROWDMA) { if (has_next && wid == 0) S.rows_dma(nxt, rowtab + ((ui + 1) & 1) * 256, lane); }
        else { if (has_next && !roleB) { unsigned vnp[4]; B3_ROWS(vnp, nxt); *park = (u32x4){vnp[0], vnp[1], vnp[2], vnp[3]}; } }
        for (int t = 0; t < nt; ++t) {
            if constexpr (epi_deferpub<Epi>::value) { if (t == 2 && pend >= 0) { asm volatile("s_waitcnt vmcnt(16)" ::: "memory");
                    E.publish(pend, lane); pend = -1; } }
            const bool lastt = (t == nt - 2);
            if constexpr (Epi::MIDHOOK) { if (t == nt / 2) { int tz = threadIdx.x; asm volatile("" : "+v"(tz)); const int we = tz >> 6, le = tz & 63; E.mid(acc, cur, we >> 2, we & 3, le & 15, le >> 4); } }
            if constexpr (Sched::DEPWAIT) { if (t == nt - 5 && has_next && wid == 0) S.dep_dma(nxt, depflag, lane); }
            if (lastt && !roleB) {
                if constexpr (Sched::DEPWAIT) { if (has_next && S.has_dep(nxt)) { if (*(volatile LAS unsigned*)depflag < S.dep_need()) S.wait_ready(nxt); } }
                if constexpr (Sched::ROWDMA) { if (has_next) { int tz_ = threadIdx.x; asm volatile("" : "+v"(tz_)); const int jr_ = ((tz_ >> 8) & 1) * 2 + ((tz_ >> 6) & 1), ln_ = tz_ & 63;
                        const LAS int* rt_ = rowtab + ((ui + 1) & 1) * 256;
#pragma unroll
                        for (int h_ = 0; h_ < 2; ++h_)
#pragma unroll
                            for (int i_ = 0; i_ < 4; ++i_) { int R_, C_; stage_rc((jr_ + 4 * i_) * 1024 + ln_ * 16, R_, C_); vs[h_ * 4 + i_] = (unsigned)S.row_from(nxt, 128 * h_ + R_, rt_) * (unsigned)S.ldab + 2u * (unsigned)C_; } } }
                else { const u32x4 pk = *park; const unsigned vnp[4] = {pk.x, pk.y, pk.z, pk.w}; B3_UNPACK(vnp); } }
            const char* aSrc = (t + 2 < nt) ? cA + (size_t)(t + 2) * kstep : nA + (size_t)(t + 2 - nt) * kstep;
            const char* bSrc = (t + 2 < nt) ? cB + (size_t)(t + 2) * kstep : nB + (size_t)(t + 2 - nt) * kstep;
            const int aU = aL == 4 ? 0 : aL + 1, aN = aL == 0 ? 4 : aL - 1;
            const int bb = B_BASE + sB * B_STAGE;
            B3_LDB(B0, bb); B3_LDB(B1, bb + HTB); B3_SCHED; B3_LDA(At, aL * HTB);
            if (!roleB) { B3_STAGE4(aN * HTB, aSrc, vs); asm volatile("s_waitcnt vmcnt(12)" ::: "memory"); }
            B3_WAIT_L0; B3_BAR; B3_MMA(0, 0, At, B0); B3_MMA(0, 1, At, B1); B3_PIN(0); B3_BAR; B3_SCHED;
            B3_LDA(At, aU * HTB);
            if (!roleB) { B3_STAGE4(aL * HTB, aSrc, (vs + 4)); asm volatile("s_waitcnt vmcnt(12)" ::: "memory"); }
            else { B3_STAGE4(bb, bSrc, vs); B3_STAGE4(bb + HTB, bSrc + hstep, vs); asm volatile("s_waitcnt vmcnt(8)" ::: "memory"); }
            B3_WAIT_L0; B3_BAR; B3_MMA(1, 0, At, B0); B3_MMA(1, 1, At, B1); B3_PIN(1); B3_BAR; B3_SCHED;
            aL = aL >= 3 ? aL - 3 : aL + 2; sB ^= 1;
        }
        if (wr == 0) B3_BAR;
        { int tz = threadIdx.x; asm volatile("" : "+v"(tz)); const int we = tz >> 6, le = tz & 63;
          if constexpr (Epi::PREBIAS) E(acc, cur, we >> 2, we & 3, le & 15, le >> 4, (const LAS float*)(lds + BIAS_OFF + (ui & 1) * 1024)); else E(acc, cur, we >> 2, we & 3, le & 15, le >> 4); }
        if constexpr (epi_deferpub<Epi>::value) pend = E.pending(cur);
        if (!has_next) break;
#pragma unroll
        for (int a = 0; a < 2; ++a)
#pragma unroll
            for (int b = 0; b < 2; ++b)
#pragma unroll
                for (int m = 0; m < 4; ++m)
#pragma unroll
                    for (int n = 0; n < 2; ++n) acc[a][b][m][n] = (f32x4){0.f, 0.f, 0.f, 0.f};
        cur = nxt; cA = nA; cB = nB; ++ui;
        if constexpr (Epi::PREBIAS) { if (wid == 0) E.pre(cur, (LAS float*)(lds + BIAS_OFF + (ui & 1) * 1024), lane); }
        if (wr == 1) B3_BAR;
    }
    asm volatile("s_waitcnt vmcnt(0)" ::: "memory");
    if constexpr (epi_deferpub<Epi>::value) { if (pend >= 0) E.publish(pend, lane); }
    B3_BAR;
#undef B3_STAGE4
#undef B3_LDA
#undef B3_LDB
#undef B3_MMA
#undef B3_WAIT_L0
#undef B3_PIN
#undef B3_BAR
#undef B3_SCHED
#undef B3_ROWS
#undef B3_UNPACK
}
}

namespace epi {
using pg8::Unit; using pg8::BM; using pg8::HALF;
typedef f32x4 Acc[2][2][4][2];
#define EPI_ROWS_COLS const int row0 = u.pm * BM + wr * 64 + fr, col0 = u.pn * BM + wc * 32 + 8 * fq
__device__ __forceinline__ u32x4 pack8(f32x4 v0, f32x4 v1) { u32x4 w; w.x = cvt_pk_bf16(v0[0], v0[1]); w.y = cvt_pk_bf16(v0[2], v0[3]); w.z = cvt_pk_bf16(v1[0], v1[1]); w.w = cvt_pk_bf16(v1[2], v1[3]); return w; }

struct Bf16Plain {
    static constexpr bool PREBIAS = false;
    static constexpr bool MIDHOOK = false;
    bf16_t* O; int ldc;
    __device__ __forceinline__ void operator()(const Acc& acc, const Unit& u, int wr, int wc, int fr, int fq) const {
        EPI_ROWS_COLS;
#pragma unroll
        for (int ai = 0; ai < 2; ++ai)
#pragma unroll
            for (int m = 0; m < 4; ++m) { bf16_t* rowp = O + (size_t)(row0 + ai * HALF + m * 16) * ldc + col0;
#pragma unroll
                for (int bj = 0; bj < 2; ++bj) *(u32x4*)(rowp + bj * HALF) = pack8(acc[ai][bj][m][0], acc[ai][bj][m][1]); }
    }
};
struct Bf16RowScale {
    static constexpr bool PREBIAS = false;
    static constexpr bool MIDHOOK = false;
    bf16_t* O; int ldc; const float* rs;
    __device__ __forceinline__ void operator()(const Acc& acc, const Unit& u, int wr, int wc, int fr, int fq) const {
        const int row0 = u.pm * BM + wr * 64 + fr, cin = wc * 32 + 8 * fq;
        float scv[8];
#pragma unroll
        for (int i = 0; i < 8; ++i) scv[i] = rs[row0 + (i >> 2) * HALF + (i & 3) * 16];
        asm volatile("" ::: "memory");
#pragma unroll
        for (int ai = 0; ai < 2; ++ai)
#pragma unroll
            for (int m = 0; m < 4; ++m) { const int row = row0 + ai * HALF + m * 16; const float sc = scv[ai * 4 + m]; const int bb = row / SEQ, ss = row % SEQ;
                bf16_t* rowp = O + ((size_t)(bb * MLA_H + u.pn) * SEQ + ss) * 256 + cin;
#pragma unroll
                for (int bj = 0; bj < 2; ++bj) *(u32x4*)(rowp + bj * HALF) = pack8(acc[ai][bj][m][0] * sc, acc[ai][bj][m][1] * sc); }
    }
};
struct QRope {
    static constexpr bool PREBIAS = false;
    static constexpr bool MIDHOOK = false;
    bf16_t* O; const float* rs; const float* cs;
    __device__ __forceinline__ void operator()(const Acc& acc, const Unit& u, int wr, int wc, int fr, int fq) const {
        EPI_ROWS_COLS;
        float scv[8];
#pragma unroll
        for (int i = 0; i < 8; ++i) scv[i] = rs[row0 + (i >> 2) * HALF + (i & 3) * 16];
#pragma unroll
        for (int bj = 0; bj < 2; ++bj) {
            const int c = col0 + bj * HALF, o = c % MLA_QK; const bool rot = o >= MLA_NOPE; const int i0 = rot ? (o - MLA_NOPE) >> 1 : 0;
#pragma unroll
            for (int ai = 0; ai < 2; ++ai) { f32x4 tv[8];
#pragma unroll
                for (int m = 0; m < 4; ++m) { const f32x4* t = (const f32x4*)(cs + ((size_t)(row0 + ai * HALF + m * 16) * 32 + i0) * 2); tv[2 * m] = t[0]; tv[2 * m + 1] = t[1]; }
                asm volatile("" ::: "memory");
#pragma unroll
                for (int m = 0; m < 4; ++m) { const int row = row0 + ai * HALF + m * 16; const float s = scv[ai * 4 + m]; bf16_t* rowp = O + (size_t)row * NQ + col0;
                    f32x4 v0 = acc[ai][bj][m][0] * s, v1 = acc[ai][bj][m][1] * s;
                    if (rot) { const f32x4 t0 = tv[m * 2], t1 = tv[m * 2 + 1];
                        f32x4 r0, r1;
                        r0[0] = v0[0] * t0[0] - v0[1] * t0[1]; r0[1] = v0[0] * t0[1] + v0[1] * t0[0];
                        r0[2] = v0[2] * t0[2] - v0[3] * t0[3]; r0[3] = v0[2] * t0[3] + v0[3] * t0[2];
                        r1[0] = v1[0] * t1[0] - v1[1] * t1[1]; r1[1] = v1[0] * t1[1] + v1[1] * t1[0];
                        r1[2] = v1[2] * t1[2] - v1[3] * t1[3]; r1[3] = v1[2] * t1[3] + v1[3] * t1[2];
                        v0 = r0; v1 = r1; }
                    *(u32x4*)(rowp + bj * HALF) = pack8(v0, v1); } } }
    }
};
struct GateStoreF32 {
    static constexpr bool PREBIAS = false;
    static constexpr bool MIDHOOK = false;
    float* M1; const bf16_t* proj; int gcol;
    __device__ __forceinline__ void operator()(const Acc& acc, const Unit& u, int wr, int wc, int fr, int fq) const {
        EPI_ROWS_COLS;
#pragma unroll
        for (int ai = 0; ai < 2; ++ai)
#pragma unroll
            for (int m = 0; m < 4; ++m) { const int row = row0 + ai * HALF + m * 16;
#pragma unroll
                for (int bj = 0; bj < 2; ++bj) { const int c = col0 + bj * HALF;
                    const u32x4 g = *(const u32x4*)(proj + (size_t)row * DINP + gcol + c);
                    f32x4 s0 = {fast_sigmoid(bf_lo(g.x)), fast_sigmoid(bf_hi(g.x)), fast_sigmoid(bf_lo(g.y)), fast_sigmoid(bf_hi(g.y))};
                    f32x4 s1 = {fast_sigmoid(bf_lo(g.z)), fast_sigmoid(bf_hi(g.z)), fast_sigmoid(bf_lo(g.w)), fast_sigmoid(bf_hi(g.w))};
                    float* p = M1 + (size_t)row * DM + c;
                    *(f32x4*)p = acc[ai][bj][m][0] * s0; *(f32x4*)(p + 4) = acc[ai][bj][m][1] * s1; } }
    }
};
struct GateMergeBf16 {
    static constexpr bool PREBIAS = false;
    static constexpr bool MIDHOOK = false;
    bf16_t* O; const float* M1; const bf16_t* proj; int gcol;
    __device__ __forceinline__ void operator()(const Acc& acc, const Unit& u, int wr, int wc, int fr, int fq) const {
        EPI_ROWS_COLS;
#pragma unroll
        for (int ai = 0; ai < 2; ++ai)
#pragma unroll
            for (int m = 0; m < 4; ++m) { const int row = row0 + ai * HALF + m * 16;
#pragma unroll
                for (int bj = 0; bj < 2; ++bj) { const int c = col0 + bj * HALF;
                    const u32x4 g = *(const u32x4*)(proj + (size_t)row * DINP + gcol + c);
                    f32x4 s0 = {fast_sigmoid(bf_lo(g.x)), fast_sigmoid(bf_hi(g.x)), fast_sigmoid(bf_lo(g.y)), fast_sigmoid(bf_hi(g.y))};
                    f32x4 s1 = {fast_sigmoid(bf_lo(g.z)), fast_sigmoid(bf_hi(g.z)), fast_sigmoid(bf_lo(g.w)), fast_sigmoid(bf_hi(g.w))};
                    const float* p = M1 + (size_t)row * DM + c;
                    const f32x4 a0 = *(const f32x4*)p, a1 = *(const f32x4*)(p + 4);
                    *(u32x4*)(O + (size_t)row * DM + c) = pack8(a0 + acc[ai][bj][m][0] * s0, a1 + acc[ai][bj][m][1] * s1); } }
    }
};
struct GateMerge2 {
    static constexpr bool PREBIAS = false;
    static constexpr bool MIDHOOK = true;
    bf16_t* O; const bf16_t* proj;
    __device__ __forceinline__ void mid(Acc& acc, const Unit& u, int wr, int wc, int fr, int fq) const {
        EPI_ROWS_COLS;
#pragma unroll
        for (int ai = 0; ai < 2; ++ai) {
            u32x4 gav[8], gbv[8];
#pragma unroll
            for (int m = 0; m < 4; ++m)
#pragma unroll
                for (int bj = 0; bj < 2; ++bj) { const int row = row0 + ai * HALF + m * 16, c = col0 + bj * HALF;
                    gav[m * 2 + bj] = __builtin_nontemporal_load((const u32x4*)(proj + (size_t)row * DINP + C_GA + c)); gbv[m * 2 + bj] = *(const u32x4*)(proj + (size_t)row * DINP + C_GB + c); }
            asm volatile("" ::: "memory");
#pragma unroll
            for (int m = 0; m < 4; ++m)
#pragma unroll
                for (int bj = 0; bj < 2; ++bj) { const u32x4 ga = gav[m * 2 + bj], gb = gbv[m * 2 + bj];
#pragma unroll
                    for (int hf = 0; hf < 2; ++hf) { const unsigned a0 = hf ? ga.z : ga.x, a1 = hf ? ga.w : ga.y, b0 = hf ? gb.z : gb.x, b1 = hf ? gb.w : gb.y;
                        const f32x4 av = {bf_lo(a0), bf_hi(a0), bf_lo(a1), bf_hi(a1)}; f32x4 bv = {bf_lo(b0), bf_hi(b0), bf_lo(b1), bf_hi(b1)}, ea, eb, ra;
#pragma unroll
                        for (int p = 0; p < 4; ++p) bv[p] = fmaxf(bv[p], -30.0f);
                        const f32x4 ta = av * -1.4426950408889634f, tb = bv * -1.4426950408889634f;
#pragma unroll
                        for (int p = 0; p < 4; ++p) { ea[p] = __builtin_amdgcn_exp2f(ta[p]); eb[p] = __builtin_amdgcn_exp2f(tb[p]); }
                        const f32x4 da = ea + 1.0f;
#pragma unroll
                        for (int p = 0; p < 4; ++p) ra[p] = __builtin_amdgcn_rcpf(da[p]);
                        acc[ai][bj][m][hf] *= (eb + 1.0f) * ra; } }
        }
    }
    __device__ __forceinline__ void operator()(const Acc& acc, const Unit& u, int wr, int wc, int fr, int fq) const {
        EPI_ROWS_COLS;
        u32x4 gv[16];
#pragma unroll
        for (int ai = 0; ai < 2; ++ai)
#pragma unroll
            for (int m = 0; m < 4; ++m)
#pragma unroll
                for (int bj = 0; bj < 2; ++bj) gv[(ai * 4 + m) * 2 + bj] = *(const u32x4*)(proj + (size_t)(row0 + ai * HALF + m * 16) * DINP + C_GB + col0 + bj * HALF);
        asm volatile("" ::: "memory");
#pragma unroll
        for (int ai = 0; ai < 2; ++ai)
#pragma unroll
            for (int m = 0; m < 4; ++m) { const int row = row0 + ai * HALF + m * 16;
#pragma unroll
                for (int bj = 0; bj < 2; ++bj) { const int c = col0 + bj * HALF;
                    const u32x4 g = gv[(ai * 4 + m) * 2 + bj];
                    f32x4 s0, s1;
#pragma unroll
                    for (int hf = 0; hf < 2; ++hf) { const unsigned b0 = hf ? g.z : g.x, b1 = hf ? g.w : g.y; f32x4 bv = {bf_lo(b0), bf_hi(b0), bf_lo(b1), bf_hi(b1)}, e, r;
#pragma unroll
                        for (int p = 0; p < 4; ++p) bv[p] = fmaxf(bv[p], -30.0f);
                        const f32x4 t = bv * -1.4426950408889634f;
#pragma unroll
                        for (int p = 0; p < 4; ++p) e[p] = __builtin_amdgcn_exp2f(t[p]);
                        const f32x4 d = e + 1.0f;
#pragma unroll
                        for (int p = 0; p < 4; ++p) r[p] = __builtin_amdgcn_rcpf(d[p]);
                        if (hf) s1 = r; else s0 = r; }
                    *(u32x4*)(O + (size_t)row * DM + c) = pack8(acc[ai][bj][m][0] * s0, acc[ai][bj][m][1] * s1); } }
    }
};
struct ResidGateF32 {
    static constexpr bool PREBIAS = false;
    static constexpr bool MIDHOOK = false;
    float* X1; const float* x; const float* gate;
    __device__ __forceinline__ void operator()(const Acc& acc, const Unit& u, int wr, int wc, int fr, int fq) const {
        EPI_ROWS_COLS;
        const float* gb = gate + (size_t)((u.pm * BM) / SEQ) * (6 * DM);
#pragma unroll
        for (int bj = 0; bj < 2; ++bj) { const int c = col0 + bj * HALF; const f32x4 g0 = *(const f32x4*)(gb + c), g1 = *(const f32x4*)(gb + c + 4);
#pragma unroll
            for (int ai = 0; ai < 2; ++ai)
#pragma unroll
                for (int m = 0; m < 4; ++m) { const int row = row0 + ai * HALF + m * 16; const float* xp = x + (size_t)row * DM + c; float* op = X1 + (size_t)row * DM + c;
                    const f32x4 x0 = __builtin_nontemporal_load((const f32x4*)xp), x1 = __builtin_nontemporal_load((const f32x4*)(xp + 4));
                    *(f32x4*)op = x0 + g0 * acc[ai][bj][m][0]; *(f32x4*)(op + 4) = x1 + g1 * acc[ai][bj][m][1]; } }
    }
};
struct SwiGlu {
    static constexpr bool MIDHOOK = false, PREBIAS = true;
    unsigned char* ACT; const float* b1;
    __device__ __forceinline__ void pre(const Unit& u, LAS float* dst, int lane) const {
        __builtin_amdgcn_global_load_lds((const unsigned*)(b1 + (size_t)u.aux * (2 * DEXP) + u.pn * BM + 4 * lane), (LAS unsigned*)dst, 16, 0, 0); }
    __device__ __forceinline__ void operator()(const Acc& acc, const Unit& u, int wr, int wc, int fr, int fq, const LAS float* bl) const {
        EPI_ROWS_COLS;
#pragma unroll
        for (int bj = 0; bj < 2; ++bj) { const int c = col0 + bj * HALF, cl = wc * 32 + 8 * fq + bj * HALF; const f32x4 bb0 = *(const LAS f32x4*)(bl + cl), bb1 = *(const LAS f32x4*)(bl + cl + 4);
#pragma unroll
            for (int ai = 0; ai < 2; ++ai)
#pragma unroll
                for (int m = 0; m < 4; ++m) { const int row = row0 + ai * HALF + m * 16;
                    const float un = 1.0f / (W8_SCALE * A8_SCALE);
                    const f32x4 v0 = acc[ai][bj][m][0] * un + bb0, v1 = acc[ai][bj][m][1] * un + bb1;
                    float o[4];
#pragma unroll
                    for (int p = 0; p < 4; ++p) { const float g = fminf(p < 2 ? v0[2 * p] : v1[2 * p - 4], 7.0f); float l = p < 2 ? v0[2 * p + 1] : v1[2 * p - 3]; l = fminf(fmaxf(l, -7.0f), 7.0f);
                        o[p] = g * fast_sigmoid(1.702f * g) * (l + 1.0f); }
                    *(unsigned*)(ACT + (size_t)row * DEXP + (c >> 1)) = pk4_fp8(o[0] * A8_SCALE, o[1] * A8_SCALE, o[2] * A8_SCALE, o[3] * A8_SCALE); } }
    }
};
struct BiasBf16 {
    static constexpr bool MIDHOOK = false, PREBIAS = true;
    unsigned char* Y; const float* b2;
    __device__ __forceinline__ void pre(const Unit& u, LAS float* dst, int lane) const {
        __builtin_amdgcn_global_load_lds((const unsigned*)(b2 + (size_t)u.aux * DM + u.pn * BM + 4 * lane), (LAS unsigned*)dst, 16, 0, 0); }
    __device__ __forceinline__ void operator()(const Acc& acc, const Unit& u, int wr, int wc, int fr, int fq, const LAS float* bl) const {
        EPI_ROWS_COLS;
#pragma unroll
        for (int bj = 0; bj < 2; ++bj) { const int c = col0 + bj * HALF, cl = wc * 32 + 8 * fq + bj * HALF; const f32x4 bb0 = *(const LAS f32x4*)(bl + cl) * Y8_SCALE, bb1 = *(const LAS f32x4*)(bl + cl + 4) * Y8_SCALE;
#pragma unroll
            for (int ai = 0; ai < 2; ++ai)
#pragma unroll
                for (int m = 0; m < 4; ++m) { const int row = row0 + ai * HALF + m * 16;
                    const float un = Y8_SCALE / (W8_SCALE * A8_SCALE);
                    const f32x4 v0 = acc[ai][bj][m][0] * un + bb0, v1 = acc[ai][bj][m][1] * un + bb1;
                    u32x2 w; w.x = pk4_fp8(v0[0], v0[1], v0[2], v0[3]); w.y = pk4_fp8(v1[0], v1[1], v1[2], v1[3]);
                    *(u32x2*)(Y + (size_t)row * DM + c) = w; } }
    }
};

struct MoeEpi {
    static constexpr bool MIDHOOK = false, PREBIAS = true, DEFERPUB = true;
    __device__ __forceinline__ int pending(const Unit& u) const { return (u.aux >> 8) == 0 ? u.pm : -1; }
    __device__ __forceinline__ void publish(int pm, int lane) const { if (lane == 0) __hip_atomic_fetch_add(blk + pm, 1u, __ATOMIC_RELAXED, __HIP_MEMORY_SCOPE_AGENT); }
    unsigned char* ACT; const float* b1; unsigned char* Y; const float* b2; unsigned* blk;
    __device__ __forceinline__ void pre(const Unit& u, LAS float* dst, int lane) const {
        const int e = u.aux & 255; const float* src = (u.aux >> 8) ? b2 + (size_t)e * DM + u.pn * BM + 4 * lane : b1 + (size_t)e * (2 * DEXP) + u.pn * BM + 4 * lane;
        __builtin_amdgcn_global_load_lds((const unsigned*)src, (LAS unsigned*)dst, 16, 0, 0); }
    __device__ __forceinline__ void operator()(const Acc& acc, const Unit& u, int wr, int wc, int fr, int fq, const LAS float* bl) const {
        EPI_ROWS_COLS;
        if ((u.aux >> 8) == 0) {
            f32x4 bg[2], bv[2];
#pragma unroll
            for (int bj = 0; bj < 2; ++bj) { const int cl = wc * 64 + fq * 16 + bj * 8; const f32x4 bb0 = *(const LAS f32x4*)(bl + cl), bb1 = *(const LAS f32x4*)(bl + cl + 4);
                bg[bj] = (f32x4){bb0[0], bb0[2], bb1[0], bb1[2]}; bv[bj] = (f32x4){bb0[1], bb0[3], bb1[1], bb1[3]}; }
#pragma unroll
            for (int ai = 0; ai < 2; ++ai)
#pragma unroll
                for (int m = 0; m < 4; ++m) { const int row = row0 + ai * HALF + m * 16; u32x2 w;
#pragma unroll
                    for (int bj = 0; bj < 2; ++bj) {
                        const float un = 1.0f / (W8_SCALE * A8_SCALE);
                        f32x4 g = acc[ai][bj][m][0] * un + bg[bj], l = acc[ai][bj][m][1] * un + bv[bj], e, r;
#pragma unroll
                        for (int p = 0; p < 4; ++p) { g[p] = fminf(g[p], 7.0f); l[p] = fminf(fmaxf(l[p], -7.0f), 7.0f); }
                        const f32x4 t = g * (-1.702f * 1.4426950408889634f);
#pragma unroll
                        for (int p = 0; p < 4; ++p) e[p] = __builtin_amdgcn_exp2f(t[p]);
                        const f32x4 d = e + 1.0f;
#pragma unroll
                        for (int p = 0; p < 4; ++p) r[p] = __builtin_amdgcn_rcpf(d[p]);
                        const f32x4 o = (g * (l * A8_SCALE + A8_SCALE)) * r;
                        w[bj] = pk4_fp8(o[0], o[1], o[2], o[3]); }
                    __hip_atomic_store((unsigned long long*)(ACT + (size_t)row * DEXP + u.pn * (BM / 2) + wc * 32 + fq * 8), (unsigned long long)w.x | ((unsigned long long)w.y << 32), __ATOMIC_RELAXED, __HIP_MEMORY_SCOPE_AGENT); }
        } else {
#pragma unroll
            for (int bj = 0; bj < 2; ++bj) { const int c = col0 + bj * HALF, cl = wc * 32 + 8 * fq + bj * HALF; const f32x4 bb0 = *(const LAS f32x4*)(bl + cl) * Y8_SCALE, bb1 = *(const LAS f32x4*)(bl + cl + 4) * Y8_SCALE;
#pragma unroll
                for (int ai = 0; ai < 2; ++ai)
#pragma unroll
                    for (int m = 0; m < 4; ++m) { const int row = row0 + ai * HALF + m * 16;
                        const float un = Y8_SCALE / (W8_SCALE * A8_SCALE);
                        const f32x4 v0 = acc[ai][bj][m][0] * un + bb0, v1 = acc[ai][bj][m][1] * un + bb1;
                        u32x2 w; w.x = pk4_fp8(v0[0], v0[1], v0[2], v0[3]); w.y = pk4_fp8(v1[0], v1[1], v1[2], v1[3]);
                        *(u32x2*)(Y + (size_t)row * DM + c) = w; } }
        }
    }
};
#undef EPI_ROWS_COLS
}

constexpr size_t MiB = 1u << 20;
constexpr size_t WS_CTL = 0, CTL_ZERO_BYTES = 64 * 1024;
constexpr size_t WS_MOD = 512 * 1024;
constexpr size_t WS_FMOD = 640 * 1024;
constexpr size_t WS_RW = 1 * MiB + 256 * 1024;
constexpr size_t WS_RC = 1 * MiB + 768 * 1024;
constexpr size_t WS_RSQ = 1 * MiB + 800 * 1024;
constexpr size_t WS_RSKV = 1 * MiB + 832 * 1024;
constexpr size_t WS_CS = 2 * MiB;
constexpr size_t WS_TOPI = 4 * MiB;
constexpr size_t WS_TOPW = 4 * MiB + 256 * 1024;
constexpr size_t WS_ROWMAP = 5 * MiB;
constexpr size_t WS_DLAST = 6 * MiB;
constexpr size_t WS_KPE = 7 * MiB;
constexpr size_t WS_WQ = 8 * MiB, WS_WKV = 10 * MiB, WS_WOM = 12 * MiB, WS_WOUT = 20 * MiB, WS_WIN = 32 * MiB;
constexpr size_t WS_W1 = 64 * MiB, WS_W2 = 576 * MiB;
constexpr size_t WS_H = 832 * MiB;
constexpr size_t WS_PROJ = 864 * MiB;
constexpr size_t WS_Q = 992 * MiB, WS_KV = 1016 * MiB;
constexpr size_t WS_GCUM = 1048 * MiB;
constexpr size_t WS_UT = 1064 * MiB;
constexpr size_t WS_ST = 1128 * MiB;
constexpr size_t WS_ATTO = 1160 * MiB;
constexpr int BR_LD = 2048;
constexpr size_t WS_M1 = 1192 * MiB;
constexpr size_t WS_MERGED = 1256 * MiB;
constexpr size_t WS_X1 = 1288 * MiB;
constexpr size_t WS_ACT = 1352 * MiB;
constexpr size_t WS_Y = 2376 * MiB;
constexpr size_t WS_END = 3400 * MiB;
constexpr int CW_TMO = 0, CW_CODE = 1, CW_BAR = 4096, CW_CNT = 8192  , CW_GQ = 12288  , CW_GEMV = 12352  , CW_BLK = 13312  ;

constexpr int NWAVES = 8;
constexpr int RING_BYTES = 131072, LDSCTL_OFF = 161792, LDS_BYTES = 163840;
constexpr int LW_BAR = 0, LW_TMP = 4, LW_NBLK = 16, LW_USTART = 48, LW_CNT = 96, LW_UNITS = 192  ;

#define XB_TMO      128
#define XB_XCNT(j)  (256  + 64 * (j))
#define XB_XSUB(j)  (1280 + 64 * (j))
#define XB_XGEN(j)  (2304 + 64 * (j))
#define XB_TOP      3328
#define XB_TOPGEN   3392
#define XCD_BAR_WORDS 3456
#define XB_SPIN_CAP (1u << 18)
__device__ __forceinline__ unsigned xb_ld(unsigned* p)              { return __hip_atomic_load(p, __ATOMIC_RELAXED, __HIP_MEMORY_SCOPE_AGENT); }
__device__ __forceinline__ unsigned xb_add(unsigned* p, unsigned v) { return __hip_atomic_fetch_add(p, v, __ATOMIC_RELAXED, __HIP_MEMORY_SCOPE_AGENT); }
__device__ __forceinline__ unsigned xb_xcc_id() { return (unsigned)__builtin_amdgcn_s_getreg((3 << 11) | 20) & 0xFu; }
#define XB_SPIN(cond, bar) do { unsigned _sp = 0; while (cond) { __builtin_amdgcn_s_sleep(1); \
    if ((++_sp & 255u) == 0u) { if (xb_ld(&(bar)[XB_TMO])) break; if (_sp > XB_SPIN_CAP) { atomicAdd(&(bar)[XB_TMO], 1u); break; } } } } while (0)
struct XcdBarrier { unsigned* bar; unsigned x; volatile LAS unsigned* st; };
__device__ __forceinline__ XcdBarrier xcd_barrier_post(unsigned* bar, volatile LAS unsigned* st) {
    XcdBarrier b; b.bar = bar; b.x = xb_xcc_id(); b.st = st;
    if (threadIdx.x == 0) (void)xb_add(&bar[XB_XCNT(b.x)], 1u);
    return b;
}
__device__ __forceinline__ void xcd_barrier_complete(unsigned* bar, unsigned x, unsigned& nloc, unsigned& nx) {
    const unsigned G = gridDim.x * gridDim.y * gridDim.z;
    unsigned sum, cnt, mine, sp = 0u;
    for (;;) {
        sum = 0u; cnt = 0u; mine = 0u;
#pragma unroll
        for (unsigned j = 0; j < 16; ++j) { const unsigned c = xb_ld(&bar[XB_XCNT(j)]); sum += c; cnt += (c > 0u) ? 1u : 0u; mine = (j == x) ? c : mine; }
        if (sum == G) break;
        __builtin_amdgcn_s_sleep(1);
        if ((++sp & 255u) == 0u) { if (xb_ld(&bar[XB_TMO])) break; if (sp > XB_SPIN_CAP) { atomicAdd(&bar[XB_TMO], 1u); break; } }
    }
    nloc = mine > 0u ? mine : 1u; nx = cnt > 0u ? cnt : 1u;
}
__device__ __forceinline__ void xcd_barrier(const XcdBarrier& b) {
    asm volatile("s_waitcnt vmcnt(0)" ::: "memory");
    __syncthreads();
    if (threadIdx.x == 0) {
        unsigned* bar = b.bar;
        __builtin_amdgcn_s_waitcnt(0);
        unsigned nloc = b.st[0], nx = b.st[1];
        if (nloc == 0u) { xcd_barrier_complete(bar, b.x, nloc, nx); b.st[0] = nloc; b.st[1] = nx; }
        const unsigned old = xb_add(&bar[XB_XSUB(b.x)], 1u);
        const unsigned gen = old / nloc;
        if (old + 1u == (gen + 1u) * nloc) {
            __builtin_amdgcn_fence(__ATOMIC_RELEASE, "agent");
            asm volatile("s_waitcnt vmcnt(0)" ::: "memory");
            const unsigned og = xb_add(&bar[XB_TOP], 1u);
            const unsigned tg = og / nx;
            if (og + 1u == (tg + 1u) * nx) xb_add(&bar[XB_TOPGEN], 1u);
            else XB_SPIN(xb_ld(&bar[XB_TOPGEN]) == tg, bar);
            __builtin_amdgcn_fence(__ATOMIC_ACQUIRE, "agent");
            xb_add(&bar[XB_XGEN(b.x)], 1u);
            asm volatile("s_waitcnt vmcnt(0)" ::: "memory");
        } else {
            XB_SPIN(xb_ld(&bar[XB_XGEN(b.x)]) == gen, bar);
            __builtin_amdgcn_fence(__ATOMIC_ACQUIRE, "agent");
            asm volatile("s_waitcnt vmcnt(0)" ::: "memory");
        }
    }
    __syncthreads();
}

struct Frame {
    LAS unsigned char* lds;
    volatile LAS unsigned* LW;
    gu32* ctl;
    int tid, lane, wave, vcu, G, probe;
    const float *x, *c; const int* pos;
    const float *w_ada, *b_ada, *norm_mix_w, *w_in, *q_norm_w, *w_q_b, *kv_norm_w, *w_kv_b, *w_gk_up, *b_gk_up, *gla_norm_w, *w_o_mla, *w_o_gla, *w_out, *norm_ffn_w, *w_router, *b_router,
        *w1, *b1, *w2, *b2, *w_ada_final, *b_ada_final, *norm_final_w;
    float* out;
    unsigned char* ws;
};
#define WSP(T, off) ((T*)(F.ws + (off)))

template <bool FP8>
__device__ __forceinline__ void p0_convert_item(const float* W, int K, int N, int nblk, void* WT, const float* kscale, LAS unsigned char* scr, int item, int lane, int ldk = 0, int koff = 0, bool pairsplit = false) {
    if (ldk == 0) ldk = K;
    constexpr int KT = FP8 ? 128 : 64, NG = KT / 16, PITCH = FP8 ? 132 : 136, EB = FP8 ? 1 : 2;
    const int kb = item / nblk, nb = item % nblk, k0 = KT * kb, n0 = 64 * nb, q = lane >> 4, n4 = lane & 15;
    const bool ok = n0 + 4 * n4 < N;
    const float* src = W + (size_t)(k0 + 4 * q) * N + n0 + 4 * n4;
#pragma unroll
    for (int gh = 0; gh < NG; gh += 4) {
        f32x4 v[4][4];
#pragma unroll
        for (int g = 0; g < 4; ++g)
#pragma unroll
            for (int r = 0; r < 4; ++r) v[g][r] = ok ? __builtin_nontemporal_load((const f32x4*)(src + (size_t)(16 * (gh + g) + r) * N)) : (f32x4){0.f, 0.f, 0.f, 0.f};
#pragma unroll
        for (int g = 0; g < 4; ++g) {
            if (kscale) {
#pragma unroll
                for (int r = 0; r < 4; ++r) v[g][r] = v[g][r] * kscale[k0 + 16 * (gh + g) + 4 * q + r]; }
#pragma unroll
            for (int c = 0; c < 4; ++c) { LAS unsigned char* p = scr + (4 * n4 + c) * PITCH + (16 * (gh + g) + 4 * q) * EB;
                if constexpr (FP8) *(LAS unsigned*)p = pk4_fp8(v[g][0][c] * W8_SCALE, v[g][1][c] * W8_SCALE, v[g][2][c] * W8_SCALE, v[g][3][c] * W8_SCALE);
                else { u32x2 w; w.x = cvt_pk_bf16(v[g][0][c], v[g][1][c]); w.y = cvt_pk_bf16(v[g][2][c], v[g][3][c]); *(LAS u32x2*)p = w; } }
        }
    }
    LDS_WAIT(); asm volatile("" ::: "memory");
#pragma unroll
    for (int i = 0; i < 8; ++i) { const int row = i * 8 + (lane >> 3), ch = lane & 7; const LAS unsigned* p = (const LAS unsigned*)(scr + row * PITCH + ch * 16);
        u32x4 o; o.x = p[0]; o.y = p[1]; o.z = p[2]; o.w = p[3];
        int drow = row;
        if (pairsplit) { const int ct = (n0 + row) & 255, n_ = ct & 1, oi = ct >> 1;
            drow = (((n0 + row) & ~255) - n0) + ((oi >> 2) & 1) * 128 + (oi >> 5) * 32 + ((oi >> 3) & 3) * 8 + n_ * 4 + (oi & 3); }
        u32x4* dstp = (u32x4*)((unsigned char*)WT + ((size_t)(n0 + drow) * ldk + koff + k0) * EB + ch * 16);
        if constexpr (FP8) __builtin_nontemporal_store(o, dstp); else *dstp = o; }
    LDS_WAIT(); asm volatile("" ::: "memory");
}
__device__ __forceinline__ void p0_prologue(Frame& F) {
    {
        LAS float* cond = (LAS float*)F.lds;
        LAS float* part = (LAS float*)(F.lds + 16384);
        for (int i = F.tid; i < NB * DM; i += NWAVES * 64) { const float v = F.c[i]; cond[i] = v * fast_sigmoid(v); }
        __syncthreads();
        for (int cg = F.vcu; cg < 256; cg += F.G) {
            const bool fin = cg >= 192; const float* W = fin ? F.w_ada_final : F.w_ada; const int N = fin ? 2 * DM : 6 * DM; const int col = (fin ? cg - 192 : cg) * 64 + F.lane;
            float a0 = 0.f, a1 = 0.f; const int kbeg = F.wave * 256;
            const float* wp = W + (size_t)kbeg * N + col;
            for (int kk = 0; kk < 256; kk += 32) { float w[32];
#pragma unroll
                for (int k = 0; k < 32; ++k) w[k] = __builtin_nontemporal_load(wp + (size_t)(kk + k) * N);
#pragma unroll
                for (int k = 0; k < 32; ++k) { a0 += cond[kbeg + kk + k] * w[k]; a1 += cond[DM + kbeg + kk + k] * w[k]; } }
            part[(F.wave * 2 + 0) * 64 + F.lane] = a0; part[(F.wave * 2 + 1) * 64 + F.lane] = a1;
            __syncthreads();
            if (F.tid < 128) { const int b = F.tid >> 6, l = F.tid & 63; float sres = 0.f;
#pragma unroll
                for (int w = 0; w < 8; ++w) sres += part[(w * 2 + b) * 64 + l];
                const int cc = (fin ? cg - 192 : cg) * 64 + l;
                if (fin) __hip_atomic_store(WSP(float, WS_FMOD) + b * (2 * DM) + cc, sres + F.b_ada_final[cc], RLX_AGENT); else __hip_atomic_store(WSP(float, WS_MOD) + b * (6 * DM) + cc, sres + F.b_ada[cc], RLX_AGENT); }
            asm volatile("s_waitcnt vmcnt(0)" ::: "memory");
            __syncthreads();
            if (F.tid == 0) __hip_atomic_fetch_add((unsigned*)(F.ctl + CW_GEMV), 1u, RLX_AGENT);
        }
    }
    {
        float* cs = WSP(float, WS_CS);
        for (int g = F.vcu * (NWAVES * 64) + F.tid; g < NTOK * 32; g += F.G * NWAVES * 64) {
            const int tok = g >> 5, i = g & 31;
            const float inv = powf(10000.0f, -(float)(2 * i) / 64.0f);
            const float ang = (float)F.pos[tok] * inv;
            const double r = (double)ang - 6.283185307179586 * rint((double)ang * 0.15915494309189535);
            const float rf = (float)r;
            cs[2 * g] = cosf(rf); cs[2 * g + 1] = sinf(rf);
        }
    }
    LAS unsigned char* scr = F.lds + F.wave * 16384;
    const int gw = F.vcu * NWAVES + F.wave, NGW = F.G * NWAVES;
    constexpr int I_IN = (DM / 64) * (DINP / 64), I_Q = (MLA_QR / 64) * (NQ / 64), I_KV = (MLA_KVR / 64) * (NKV / 64), I_OM = (1024 / 64) * (DM / 64), I_OG = I_OM, I_OUT = (DM / 64) * (DM / 64),
                  I_W1E = (DM / 128) * (2 * DEXP / 64), I_W2E = (DEXP / 128) * (DM / 64);
    constexpr int NITEMS = I_IN + I_Q + I_KV + I_OM + I_OG + I_OUT;
    (void)I_W1E; (void)I_W2E;
    for (int it = gw; it < NITEMS; it += NGW) {
        int r = it;
        if (r < I_IN) { p0_convert_item<false>(F.w_in, DM, DIN, DINP / 64, WSP(bf16_t, WS_WIN), nullptr, scr, r, F.lane); continue; } r -= I_IN;
        if (r < I_Q) { p0_convert_item<false>(F.w_q_b, MLA_QR, NQ, NQ / 64, WSP(bf16_t, WS_WQ), F.q_norm_w, scr, r, F.lane); continue; } r -= I_Q;
        if (r < I_KV) { p0_convert_item<false>(F.w_kv_b, MLA_KVR, NKV, NKV / 64, WSP(bf16_t, WS_WKV), F.kv_norm_w, scr, r, F.lane); continue; } r -= I_KV;
        if (r < I_OM) { p0_convert_item<false>(F.w_o_mla, 1024, DM, DM / 64, WSP(bf16_t, WS_WOM), nullptr, scr, r, F.lane, 2048, 0); continue; } r -= I_OM;
        if (r < I_OG) { p0_convert_item<false>(F.w_o_gla, 1024, DM, DM / 64, WSP(bf16_t, WS_WOM), nullptr, scr, r, F.lane, 2048, 1024); continue; } r -= I_OG;
        p0_convert_item<false>(F.w_out, DM, DM, DM / 64, WSP(bf16_t, WS_WOUT), nullptr, scr, r, F.lane);
    }
}
__device__ __forceinline__ void moe_convert(Frame& F, int cc, int ncv) {
    LAS unsigned char* scr = F.lds + F.wave * 16384;
    const int gw = cc * NWAVES + F.wave, NGW = ncv * NWAVES;
    constexpr int I_W1E = (DM / 128) * (2 * DEXP / 64), I_W2E = (DEXP / 128) * (DM / 64);
    for (int it = gw; it < NEXP * (I_W1E + I_W2E); it += NGW) {
        int r = it;
        if (r < NEXP * I_W1E) { const int e = r / I_W1E; p0_convert_item<true>(F.w1 + (size_t)e * DM * 2 * DEXP, DM, 2 * DEXP, 2 * DEXP / 64, WSP(unsigned char, WS_W1) + (size_t)e * 2 * DEXP * DM, nullptr, scr, r % I_W1E, F.lane, 0, 0, true); continue; } r -= NEXP * I_W1E;
        { const int e = r / I_W2E; p0_convert_item<true>(F.w2 + (size_t)e * DEXP * DM, DEXP, DM, DM / 64, WSP(unsigned char, WS_W2) + (size_t)e * DM * DEXP, nullptr, scr, r % I_W2E, F.lane); }
    }
}
__device__ __forceinline__ void wait_gemv(Frame& F) {
    if (F.tid == 0) { unsigned sp = 0;
        while (__hip_atomic_load((unsigned*)(F.ctl + CW_GEMV), RLX_AGENT) < 256u) { __builtin_amdgcn_s_sleep(2);
            if ((++sp & 255u) == 0u) { if (__hip_atomic_load((unsigned*)(F.ctl + CW_TMO), RLX_AGENT)) break; if (sp > (1u << 22)) { __hip_atomic_store((unsigned*)(F.ctl + CW_TMO), 1u, RLX_AGENT); break; } } }
        __builtin_amdgcn_fence(__ATOMIC_ACQUIRE, "agent");
        asm volatile("s_waitcnt vmcnt(0)" ::: "memory"); }
    __syncthreads();
}

template <bool FP8 = false>
__device__ __forceinline__ void norm_mod_row_bf16(const float* xrow, const float* gain, const float* shift, const float* scale, bf16_t* orow, int lane) {
    const f32x4* xr = (const f32x4*)xrow + lane;
    f32x4 v[8]; float s = 0.f;
#pragma unroll
    for (int j = 0; j < 8; ++j) { v[j] = FP8 ? xr[64 * j] : __builtin_nontemporal_load(xr + 64 * j); s += (v[j].x * v[j].x + v[j].y * v[j].y) + (v[j].z * v[j].z + v[j].w * v[j].w); }
    const float rs = 1.0f / sqrtf(wave_sum(s) * (1.0f / DM) + EPS);
#pragma unroll
    for (int j = 0; j < 8; ++j) { const int c = 4 * lane + 256 * j; const f32x4 g = *(const f32x4*)(gain + c), sc = *(const f32x4*)(scale + c), sh = *(const f32x4*)(shift + c);
        const f32x4 o = v[j] * rs * g * (sc + 1.0f) + sh;
        if constexpr (FP8) { *(unsigned*)((unsigned char*)orow + c) = pk4_fp8(o.x * A8_SCALE, o.y * A8_SCALE, o.z * A8_SCALE, o.w * A8_SCALE); }
        else { u32x2 w; w.x = cvt_pk_bf16(o.x, o.y); w.y = cvt_pk_bf16(o.z, o.w); *(u32x2*)(orow + c) = w; } }
}
template <bool FP8 = false>
__device__ __forceinline__ void norm_mod_row2_bf16(const float* xrow0, const float* xrow1, const float* gain, const float* shift0, const float* scale0, const float* shift1, const float* scale1, bf16_t* orow0, bf16_t* orow1, int lane) {
    const f32x4* xr0 = (const f32x4*)xrow0 + lane; const f32x4* xr1 = (const f32x4*)xrow1 + lane;
    f32x4 v0[8], v1[8];
#pragma unroll
    for (int j = 0; j < 8; ++j) { v0[j] = FP8 ? xr0[64 * j] : __builtin_nontemporal_load(xr0 + 64 * j); v1[j] = FP8 ? xr1[64 * j] : __builtin_nontemporal_load(xr1 + 64 * j); }
    asm volatile("" ::: "memory");
    float s0 = 0.f, s1 = 0.f;
#pragma unroll
    for (int j = 0; j < 8; ++j) { s0 += (v0[j].x * v0[j].x + v0[j].y * v0[j].y) + (v0[j].z * v0[j].z + v0[j].w * v0[j].w); s1 += (v1[j].x * v1[j].x + v1[j].y * v1[j].y) + (v1[j].z * v1[j].z + v1[j].w * v1[j].w); }
    const float rs0 = 1.0f / sqrtf(wave_sum(s0) * (1.0f / DM) + EPS), rs1 = 1.0f / sqrtf(wave_sum(s1) * (1.0f / DM) + EPS);
#pragma unroll
    for (int j = 0; j < 8; ++j) { const int c = 4 * lane + 256 * j; const f32x4 g = *(const f32x4*)(gain + c);
        { const f32x4 sc = *(const f32x4*)(scale0 + c), sh = *(const f32x4*)(shift0 + c); const f32x4 o = v0[j] * rs0 * g * (sc + 1.0f) + sh;
          if constexpr (FP8) { *(unsigned*)((unsigned char*)orow0 + c) = pk4_fp8(o.x * A8_SCALE, o.y * A8_SCALE, o.z * A8_SCALE, o.w * A8_SCALE); }
          else { u32x2 w; w.x = cvt_pk_bf16(o.x, o.y); w.y = cvt_pk_bf16(o.z, o.w); *(u32x2*)(orow0 + c) = w; } }
        { const f32x4 sc = *(const f32x4*)(scale1 + c), sh = *(const f32x4*)(shift1 + c); const f32x4 o = v1[j] * rs1 * g * (sc + 1.0f) + sh;
          if constexpr (FP8) { *(unsigned*)((unsigned char*)orow1 + c) = pk4_fp8(o.x * A8_SCALE, o.y * A8_SCALE, o.z * A8_SCALE, o.w * A8_SCALE); }
          else { u32x2 w; w.x = cvt_pk_bf16(o.x, o.y); w.y = cvt_pk_bf16(o.z, o.w); *(u32x2*)(orow1 + c) = w; } } }
}
__device__ __forceinline__ void p1_norm(Frame& F) {
    const int gw = F.vcu * NWAVES + F.wave, NGW = F.G * NWAVES;
    const float* mod = WSP(float, WS_MOD);
    for (int m = gw; m < NTOK; m += 2 * NGW) { const int b = m / SEQ, m2 = m + NGW;
        if (m2 < NTOK) { const int b2 = m2 / SEQ;
            norm_mod_row2_bf16(F.x + (size_t)m * DM, F.x + (size_t)m2 * DM, F.norm_mix_w, mod + b * 6 * DM + 0 * DM, mod + b * 6 * DM + 1 * DM, mod + b2 * 6 * DM + 0 * DM, mod + b2 * 6 * DM + 1 * DM,
                               WSP(bf16_t, WS_H) + (size_t)m * DM, WSP(bf16_t, WS_H) + (size_t)m2 * DM, F.lane); }
        else norm_mod_row_bf16(F.x + (size_t)m * DM, F.norm_mix_w, mod + b * 6 * DM + 0 * DM, mod + b * 6 * DM + 1 * DM, WSP(bf16_t, WS_H) + (size_t)m * DM, F.lane); }
    float* RW = WSP(float, WS_RW); float* RC = WSP(float, WS_RC);
    for (int g = F.vcu * (NWAVES * 64) + F.tid; g < NB * DM * NEXP; g += F.G * NWAVES * 64) { const int b = g / (DM * NEXP), k = (g / NEXP) % DM;
        RW[g] = F.norm_ffn_w[k] * (1.0f + mod[b * 6 * DM + 4 * DM + k]) * F.w_router[g % (DM * NEXP)]; }
    if (gw < NB * NEXP) { const int b = gw / NEXP, e = gw % NEXP; float s = 0.f;
        for (int k = F.lane; k < DM; k += 64) s += mod[b * 6 * DM + 3 * DM + k] * F.w_router[k * NEXP + e];
        s = wave_sum(s); if (F.lane == 0) RC[b * NEXP + e] = s + F.b_router[e]; }
}

__device__ __forceinline__ void p3_rows(Frame& F) {
    const int gw = F.vcu * NWAVES + F.wave, NGW = F.G * NWAVES;
    const bf16_t* proj = WSP(bf16_t, WS_PROJ); const float* cs = WSP(float, WS_CS);
    for (int m0 = gw; m0 < NTOK; m0 += 4 * NGW) {
        u32x4 wq[4], wk[4]; unsigned wp[4]; f32x2 tt[4];
#pragma unroll
        for (int k = 0; k < 4; ++k) { const int m = m0 + k * NGW; wq[k] = (u32x4){0u, 0u, 0u, 0u}; wk[k] = wq[k]; wp[k] = 0u; tt[k] = (f32x2){0.f, 0.f};
            if (m < NTOK) { const bf16_t* pr = proj + (size_t)m * DINP;
                wq[k] = *(const u32x4*)(pr + C_QLAT + 8 * F.lane);
                if (F.lane < 32) { wk[k] = *(const u32x4*)(pr + C_CKV + 8 * F.lane); wp[k] = *(const unsigned*)(pr + C_KPE + 2 * F.lane); tt[k] = *(const f32x2*)(cs + ((size_t)m * 32 + F.lane) * 2); } } }
        asm volatile("" ::: "memory");
#pragma unroll
        for (int k = 0; k < 4; ++k) { const int m = m0 + k * NGW; if (m >= NTOK) break;
            { const u32x4 w = wq[k];
              float s = bf_lo(w.x) * bf_lo(w.x) + bf_hi(w.x) * bf_hi(w.x) + bf_lo(w.y) * bf_lo(w.y) + bf_hi(w.y) * bf_hi(w.y) + bf_lo(w.z) * bf_lo(w.z) + bf_hi(w.z) * bf_hi(w.z) + bf_lo(w.w) * bf_lo(w.w) + bf_hi(w.w) * bf_hi(w.w);
              s = wave_sum(s); if (F.lane == 0) WSP(float, WS_RSQ)[m] = 1.0f / sqrtf(s * (1.0f / MLA_QR) + EPS); }
            { float s = 0.f;
              if (F.lane < 32) { const u32x4 w = wk[k];
                  s = bf_lo(w.x) * bf_lo(w.x) + bf_hi(w.x) * bf_hi(w.x) + bf_lo(w.y) * bf_lo(w.y) + bf_hi(w.y) * bf_hi(w.y) + bf_lo(w.z) * bf_lo(w.z) + bf_hi(w.z) * bf_hi(w.z) + bf_lo(w.w) * bf_lo(w.w) + bf_hi(w.w) * bf_hi(w.w); }
              s = wave_sum(s); if (F.lane == 0) WSP(float, WS_RSKV)[m] = 1.0f / sqrtf(s * (1.0f / MLA_KVR) + EPS); }
            if (F.lane < 32) { const unsigned w = wp[k]; const float re = bf_lo(w), im = bf_hi(w); const f32x2 t = tt[k];
                *(unsigned*)(WSP(bf16_t, WS_KPE) + (size_t)m * MLA_ROPE + 2 * F.lane) = cvt_pk_bf16(re * t.x - im * t.y, re * t.y + im * t.x); }
        }
    }
}

#define MFMA16(a, b, c) __builtin_amdgcn_mfma_f32_16x16x32_bf16((a), (b), (c), 0, 0, 0)
__device__ __forceinline__ void gla_stage_vt(Frame& F, LAS unsigned char* VT, const bf16_t* proj, int t0, int h) {
#pragma unroll
    for (int it = 0; it < 4; ++it) { const int idx = F.tid + it * 512, j = idx >> 5, v8 = (idx & 31) * 8;
        const u32x4 w = *(const u32x4*)(proj + (size_t)(t0 + j) * DINP + C_GV + h * GLA_DV + v8);
        LAS unsigned char* p = VT + v8 * 144 + j * 2;
        *(LAS bf16_t*)(p + 0 * 144) = (bf16_t)(w.x & 0xffffu); *(LAS bf16_t*)(p + 1 * 144) = (bf16_t)(w.x >> 16);
        *(LAS bf16_t*)(p + 2 * 144) = (bf16_t)(w.y & 0xffffu); *(LAS bf16_t*)(p + 3 * 144) = (bf16_t)(w.y >> 16);
        *(LAS bf16_t*)(p + 4 * 144) = (bf16_t)(w.z & 0xffffu); *(LAS bf16_t*)(p + 5 * 144) = (bf16_t)(w.z >> 16);
        *(LAS bf16_t*)(p + 6 * 144) = (bf16_t)(w.w & 0xffffu); *(LAS bf16_t*)(p + 7 * 144) = (bf16_t)(w.w >> 16); }
}
__device__ __forceinline__ void gla_pass1_unit(Frame& F, int u) {
    const int b = u >> 8, h = (u >> 6) & 3, n = u & 63, t0 = b * SEQ + n * GLA_C;
    LAS unsigned char* L = F.lds;
    LAS float* GZ = (LAS float*)(L + 0); LAS float* WG = (LAS float*)(L + 4096); LAS float* BG = (LAS float*)(L + 12288); LAS float* QS = (LAS float*)(L + 12800);
    LAS unsigned char* KDT = L + 16384; LAS unsigned char* VT = L + 36864;
    const bf16_t* proj = WSP(bf16_t, WS_PROJ);
    if (F.tid < 128) { const int row = F.tid >> 1, half = F.tid & 1; const u32x4 w = *(const u32x4*)(proj + (size_t)(t0 + row) * DINP + C_GLR + half * 8);
        LAS float* g = GZ + row * 16 + half * 8; g[0] = bf_lo(w.x); g[1] = bf_hi(w.x); g[2] = bf_lo(w.y); g[3] = bf_hi(w.y); g[4] = bf_lo(w.z); g[5] = bf_hi(w.z); g[6] = bf_lo(w.w); g[7] = bf_hi(w.w); }
    { const int r = F.tid >> 5, c = (F.tid & 31) * 4; *(LAS f32x4*)(WG + r * 128 + c) = *(const f32x4*)(F.w_gk_up + r * (GLA_H * GLA_DK) + h * GLA_DK + c); }
    if (F.tid < 128) BG[F.tid] = F.b_gk_up[h * GLA_DK + F.tid];
    gla_stage_vt(F, VT, proj, t0, h);
    __syncthreads();
    const int d = F.tid & 127, qtr = F.tid >> 7;
    float bq[16];
    { float wg[16];
#pragma unroll
      for (int r = 0; r < 16; ++r) wg[r] = WG[r * 128 + d];
      const float bias = BG[d]; float run = 0.f;
#pragma unroll
      for (int i = 0; i < 16; ++i) { const LAS float* gz = GZ + (qtr * 16 + i) * 16; float z = bias;
#pragma unroll
          for (int r = 0; r < 16; ++r) z += gz[r] * wg[r];
          const float ls = fminf(z, 0.f) - __logf(1.0f + __expf(-fabsf(z)));
          run += ls * (1.0f / 16.0f); bq[i] = run; }
      QS[qtr * 128 + d] = run; }
    __syncthreads();
    float off = 0.f, blast = 0.f;
#pragma unroll
    for (int q = 0; q < 4; ++q) { const float s = QS[q * 128 + d]; blast += s; if (q < qtr) off += s; }
    float* gc = WSP(float, WS_GCUM) + (size_t)(t0 + qtr * 16) * (GLA_H * GLA_DK) + h * GLA_DK + d;
    const bf16_t* kp = proj + (size_t)(t0 + qtr * 16) * DINP + C_GK + h * GLA_DK + d;
    float kd[16];
#pragma unroll
    for (int i = 0; i < 16; ++i) { bq[i] += off; gc[(size_t)i * (GLA_H * GLA_DK)] = bq[i]; kd[i] = bf2f(kp[(size_t)i * DINP]) * __expf(blast - bq[i]); }
    { u32x4 w0, w1; w0.x = cvt_pk_bf16(kd[0], kd[1]); w0.y = cvt_pk_bf16(kd[2], kd[3]); w0.z = cvt_pk_bf16(kd[4], kd[5]); w0.w = cvt_pk_bf16(kd[6], kd[7]);
      w1.x = cvt_pk_bf16(kd[8], kd[9]); w1.y = cvt_pk_bf16(kd[10], kd[11]); w1.z = cvt_pk_bf16(kd[12], kd[13]); w1.w = cvt_pk_bf16(kd[14], kd[15]);
      *(LAS u32x4*)(KDT + d * 144 + qtr * 32) = w0; *(LAS u32x4*)(KDT + d * 144 + qtr * 32 + 16) = w1; }
    if (qtr == 0) WSP(float, WS_DLAST)[u * GLA_DK + d] = __expf(blast);
    __syncthreads();
    const int l15 = F.lane & 15, quad = F.lane >> 4, w = F.wave;
    f32x4 acc[2][8];
#pragma unroll
    for (int mt = 0; mt < 2; ++mt)
#pragma unroll
        for (int nt = 0; nt < 8; ++nt) acc[mt][nt] = (f32x4){0.f, 0.f, 0.f, 0.f};
#pragma unroll
    for (int ks = 0; ks < 2; ++ks) { bf16x8 xf[2];
#pragma unroll
        for (int mt = 0; mt < 2; ++mt) xf[mt] = *(const LAS bf16x8*)(VT + (w * 32 + mt * 16 + l15) * 144 + (ks * 32 + quad * 8) * 2);
#pragma unroll
        for (int nt = 0; nt < 8; ++nt) { const bf16x8 yf = *(const LAS bf16x8*)(KDT + (nt * 16 + l15) * 144 + (ks * 32 + quad * 8) * 2);
#pragma unroll
            for (int mt = 0; mt < 2; ++mt) acc[mt][nt] = MFMA16(yf, xf[mt], acc[mt][nt]); } }
    bf16_t* UT = WSP(bf16_t, WS_UT) + (size_t)u * (GLA_DV * GLA_DK);
#pragma unroll
    for (int mt = 0; mt < 2; ++mt)
#pragma unroll
        for (int nt = 0; nt < 8; ++nt) { u32x2 w2; w2.x = cvt_pk_bf16(acc[mt][nt][0], acc[mt][nt][1]); w2.y = cvt_pk_bf16(acc[mt][nt][2], acc[mt][nt][3]);
            *(u32x2*)(UT + (size_t)(w * 32 + mt * 16 + l15) * GLA_DK + nt * 16 + quad * 4) = w2; }
    __syncthreads();
}
__device__ __forceinline__ void gla_pass2(Frame& F) {
    const bf16_t* UT = WSP(bf16_t, WS_UT); const float* DL = WSP(float, WS_DLAST); bf16_t* ST = WSP(bf16_t, WS_ST);
    for (int g = F.vcu * (NWAVES * 64) + F.tid; g < NB * GLA_H * GLA_DV * (GLA_DK / 2); g += F.G * NWAVES * 64) {
        const int bh = g >> 14, rem = g & 16383, v = rem >> 6, d2 = (rem & 63) * 2;
        f32x2 S = {0.f, 0.f};
#pragma unroll 16
        for (int n = 0; n < GLA_NCH; ++n) { const int u = bh * GLA_NCH + n; const size_t e = ((size_t)u * GLA_DV + v) * GLA_DK + d2;
            *(unsigned*)(ST + e) = cvt_pk_bf16(S.x, S.y);
            const unsigned uw = __builtin_nontemporal_load((const unsigned*)(UT + e)); const f32x2 U = {bf_lo(uw), bf_hi(uw)}, dl = *(const f32x2*)(DL + u * GLA_DK + d2);
            S = S * dl + U; }
    }
}
__device__ __forceinline__ void gla_pass3_unit(Frame& F, int u) {
    const int b = u >> 8, h = (u >> 6) & 3, n = u & 63, t0 = b * SEQ + n * GLA_C;
    LAS unsigned char* L = F.lds;
    LAS unsigned char* QD = L; LAS unsigned char* KD2 = L + 17408; LAS unsigned char* P = L + 34816; LAS unsigned char* VT = L + 44032; LAS float* RED = (LAS float*)(L + 80896);
    const bf16_t* proj = WSP(bf16_t, WS_PROJ); const float* gcum = WSP(float, WS_GCUM);
#pragma unroll
    for (int it = 0; it < 2; ++it) { const int idx = F.tid + it * 512, i = idx >> 4, d8 = (idx & 15) * 8;
        const u32x4 qw = *(const u32x4*)(proj + (size_t)(t0 + i) * DINP + C_GQ + h * GLA_DK + d8), kw = *(const u32x4*)(proj + (size_t)(t0 + i) * DINP + C_GK + h * GLA_DK + d8);
        const float* bp = gcum + (size_t)(t0 + i) * (GLA_H * GLA_DK) + h * GLA_DK + d8; const f32x4 b0 = *(const f32x4*)bp, b1 = *(const f32x4*)(bp + 4);
        const float sc = 0.08838834764831845f;
        float q[8] = {bf_lo(qw.x), bf_hi(qw.x), bf_lo(qw.y), bf_hi(qw.y), bf_lo(qw.z), bf_hi(qw.z), bf_lo(qw.w), bf_hi(qw.w)};
        float k[8] = {bf_lo(kw.x), bf_hi(kw.x), bf_lo(kw.y), bf_hi(kw.y), bf_lo(kw.z), bf_hi(kw.z), bf_lo(kw.w), bf_hi(kw.w)};
        float bb[8] = {b0.x, b0.y, b0.z, b0.w, b1.x, b1.y, b1.z, b1.w};
#pragma unroll
        for (int j = 0; j < 8; ++j) { q[j] *= sc * __expf(bb[j]); k[j] *= __expf(-bb[j]); }
        u32x4 qo, ko; qo.x = cvt_pk_bf16(q[0], q[1]); qo.y = cvt_pk_bf16(q[2], q[3]); qo.z = cvt_pk_bf16(q[4], q[5]); qo.w = cvt_pk_bf16(q[6], q[7]);
        ko.x = cvt_pk_bf16(k[0], k[1]); ko.y = cvt_pk_bf16(k[2], k[3]); ko.z = cvt_pk_bf16(k[4], k[5]); ko.w = cvt_pk_bf16(k[6], k[7]);
        *(LAS u32x4*)(QD + i * 272 + d8 * 2) = qo; *(LAS u32x4*)(KD2 + i * 272 + d8 * 2) = ko; }
    gla_stage_vt(F, VT, proj, t0, h);
    const int l15 = F.lane & 15, quad = F.lane >> 4, w = F.wave;
    const bf16_t* STu = WSP(bf16_t, WS_ST) + (size_t)u * (GLA_DV * GLA_DK);
    bf16x8 stf[4][2]; u32x2 gwf[4][2]; f32x4 nwf[2];
#pragma unroll
    for (int ks = 0; ks < 4; ++ks)
#pragma unroll
        for (int n2 = 0; n2 < 2; ++n2) stf[ks][n2] = *(const bf16x8*)(STu + (size_t)(w * 32 + n2 * 16 + l15) * GLA_DK + ks * 32 + quad * 8);
#pragma unroll
    for (int n2 = 0; n2 < 2; ++n2) { const int v0 = w * 32 + n2 * 16 + quad * 4; nwf[n2] = *(const f32x4*)(F.gla_norm_w + v0);
#pragma unroll
        for (int mt = 0; mt < 4; ++mt) gwf[mt][n2] = *(const u32x2*)(proj + (size_t)(t0 + mt * 16 + l15) * DINP + C_GOUT + h * GLA_DV + v0); }
    __syncthreads();
    { const int mt = w >> 1;
#pragma unroll
      for (int q2 = 0; q2 < 2; ++q2) { const int nt = (w & 1) * 2 + q2; f32x4 a = {0.f, 0.f, 0.f, 0.f};
          if (nt <= mt) {
#pragma unroll
              for (int ks = 0; ks < 4; ++ks) { const bf16x8 xf = *(const LAS bf16x8*)(QD + (mt * 16 + l15) * 272 + (ks * 32 + quad * 8) * 2), yf = *(const LAS bf16x8*)(KD2 + (nt * 16 + l15) * 272 + (ks * 32 + quad * 8) * 2);
                  a = MFMA16(yf, xf, a); } }
          const int i = mt * 16 + l15, j0 = nt * 16 + quad * 4;
          u32x2 pw; pw.x = cvt_pk_bf16(j0 + 0 <= i ? a[0] : 0.f, j0 + 1 <= i ? a[1] : 0.f); pw.y = cvt_pk_bf16(j0 + 2 <= i ? a[2] : 0.f, j0 + 3 <= i ? a[3] : 0.f);
          *(LAS u32x2*)(P + i * 144 + j0 * 2) = pw; } }
    __syncthreads();
    f32x4 acc[4][2];
#pragma unroll
    for (int mt = 0; mt < 4; ++mt) { acc[mt][0] = (f32x4){0.f, 0.f, 0.f, 0.f}; acc[mt][1] = (f32x4){0.f, 0.f, 0.f, 0.f}; }
#pragma unroll
    for (int ks = 0; ks < 4; ++ks) {
#pragma unroll
        for (int mt = 0; mt < 4; ++mt) { const bf16x8 xf = *(const LAS bf16x8*)(QD + (mt * 16 + l15) * 272 + (ks * 32 + quad * 8) * 2);
            acc[mt][0] = MFMA16(stf[ks][0], xf, acc[mt][0]); acc[mt][1] = MFMA16(stf[ks][1], xf, acc[mt][1]); } }
#pragma unroll
    for (int ks = 0; ks < 2; ++ks) { bf16x8 yf[2];
#pragma unroll
        for (int n2 = 0; n2 < 2; ++n2) yf[n2] = *(const LAS bf16x8*)(VT + (w * 32 + n2 * 16 + l15) * 144 + (ks * 32 + quad * 8) * 2);
#pragma unroll
        for (int mt = 0; mt < 4; ++mt) { const bf16x8 xf = *(const LAS bf16x8*)(P + (mt * 16 + l15) * 144 + (ks * 32 + quad * 8) * 2);
            acc[mt][0] = MFMA16(yf[0], xf, acc[mt][0]); acc[mt][1] = MFMA16(yf[1], xf, acc[mt][1]); } }
#pragma unroll
    for (int mt = 0; mt < 4; ++mt) { float ss = 0.f;
#pragma unroll
        for (int n2 = 0; n2 < 2; ++n2)
#pragma unroll
            for (int r = 0; r < 4; ++r) ss += acc[mt][n2][r] * acc[mt][n2][r];
        ss += __shfl_xor(ss, 16); ss += __shfl_xor(ss, 32);
        if (quad == 0) RED[w * 64 + mt * 16 + l15] = ss; }
    __syncthreads();
    bf16_t* GO = WSP(bf16_t, WS_ATTO) + MLA_H * MLA_V;
#pragma unroll
    for (int mt = 0; mt < 4; ++mt) { const int i = mt * 16 + l15; float tot = 0.f;
#pragma unroll
        for (int ww = 0; ww < 8; ++ww) tot += RED[ww * 64 + i];
        const float rs = 1.0f / sqrtf(tot * (1.0f / GLA_DV) + EPS);
#pragma unroll
        for (int n2 = 0; n2 < 2; ++n2) { const int v0 = w * 32 + n2 * 16 + quad * 4; const f32x4 nw = nwf[n2];
            const u32x2 gw = gwf[mt][n2];
            const float g0 = bf_lo(gw.x), g1 = bf_hi(gw.x), g2 = bf_lo(gw.y), g3 = bf_hi(gw.y);
            const f32x4 o = acc[mt][n2] * rs * nw;
            u32x2 ow; ow.x = cvt_pk_bf16(o.x * g0 * fast_sigmoid(g0), o.y * g1 * fast_sigmoid(g1)); ow.y = cvt_pk_bf16(o.z * g2 * fast_sigmoid(g2), o.w * g3 * fast_sigmoid(g3));
            *(u32x2*)(GO + (size_t)(t0 + i) * BR_LD + h * GLA_DV + v0) = ow; } }
    __syncthreads();
}

namespace att {
constexpr float SCALE = 0.07216878364870322f, THR = 8.f;
constexpr int SHM_V = 16384, SHM_KN = 16384, SHM_KP = 8192;
constexpr int OFF_V = 0, OFF_KN = 3 * SHM_V, OFF_KP = OFF_KN + 4 * SHM_KN, OFF_WS = OFF_KP + 4 * SHM_KP, ATT_LDS_END = OFF_WS + 2048 + 16;
constexpr int OFF_EXO = 0, OFF_EXS = 65536;
#define KSWZ(row, colB) ((row) * 256 + ((colB) ^ (((row) & 7) << 4)))
#define KPSWZ(row, colB) ((row) * 128 + ((colB) ^ (((row) & 7) << 4)))
#define SBAR() __builtin_amdgcn_sched_barrier(0)
__device__ __forceinline__ int v_rd_base(int lane) { return ((lane & 3) << 3) | (((lane >> 2) & 3) << 6) | (((lane >> 4) & 1) << 5) | (((lane >> 5) & 1) << 8); }
constexpr int v_rd_off(int d0, int ks, int half) { return d0 * 512 + ks * 4096 + half * 2048; }
__device__ __forceinline__ int crow(int r, int hi) { return (r & 3) + 8 * (r >> 2) + 4 * hi; }
__device__ __forceinline__ void mask_tile(f32x16& p0, f32x16& p1, int dq) {
    const float NEG = -__builtin_inff();
#pragma unroll
    for (int r = 0; r < 16; ++r) { const int c = (r & 3) + 8 * (r >> 2);
        if (dq - c < 0) p0[r] = NEG;
        if (dq - c - 32 < 0) p1[r] = NEG; }
}
__device__ __forceinline__ void partialSM(f32x16& p0, f32x16& p1, float& m_reg, float& mn, float& alpha) {
    float pmax = p0[0];
#pragma unroll
    for (int r = 1; r < 16; ++r) pmax = fmaxf(pmax, p0[r]);
#pragma unroll
    for (int r = 0; r < 16; ++r) pmax = fmaxf(pmax, p1[r]);
    { auto rr = __builtin_amdgcn_permlane32_swap(__float_as_uint(pmax), __float_as_uint(pmax), false, false);
      pmax = fmaxf(__uint_as_float(rr[0]), __uint_as_float(rr[1])); }
    constexpr float C2 = 1.4426950408889634f * SCALE;
    if (__builtin_expect(__all((pmax - m_reg) * SCALE <= THR), 1)) { mn = m_reg; alpha = 1.f; }
    else { mn = fmaxf(m_reg, pmax); alpha = __builtin_amdgcn_exp2f((m_reg - mn) * C2); m_reg = mn; }
    const float mnL = -mn * C2;
#pragma unroll
    for (int r = 0; r < 16; ++r) p0[r] = fmaf(p0[r], C2, mnL);
#pragma unroll
    for (int r = 0; r < 16; ++r) p1[r] = fmaf(p1[r], C2, mnL);
#pragma unroll
    for (int r = 0; r < 16; ++r) p0[r] = __builtin_amdgcn_exp2f(p0[r]);
}
__device__ __forceinline__ void finishSM(f32x16& p0, f32x16& p1, float alpha, float& l_reg, bf16x8& pa0, bf16x8& pa1, bf16x8& pa2, bf16x8& pa3) {
#pragma unroll
    for (int r = 0; r < 16; ++r) p1[r] = __builtin_amdgcn_exp2f(p1[r]);
    float ps = 0;
#pragma unroll
    for (int r = 0; r < 16; ++r) ps += p0[r];
#pragma unroll
    for (int r = 0; r < 16; ++r) ps += p1[r];
    { auto rr = __builtin_amdgcn_permlane32_swap(__float_as_uint(ps), __float_as_uint(ps), false, false);
      ps = __uint_as_float(rr[0]) + __uint_as_float(rr[1]); }
    l_reg = l_reg * alpha + ps;
#define PK4(P, B_, OUT) do { unsigned a0 = cvt_pk_bf16(P[B_+0], P[B_+1]), a1 = cvt_pk_bf16(P[B_+2], P[B_+3]);                          \
        unsigned b0 = cvt_pk_bf16(P[B_+4], P[B_+5]), b1 = cvt_pk_bf16(P[B_+6], P[B_+7]);                                             \
        auto r0 = __builtin_amdgcn_permlane32_swap(a0, b0, false, false); auto r1 = __builtin_amdgcn_permlane32_swap(a1, b1, false, false); \
        u32x4 w = {r0[0], r1[0], r0[1], r1[1]}; OUT = __builtin_bit_cast(bf16x8, w); } while (0)
    PK4(p0, 0, pa0); PK4(p0, 8, pa1); PK4(p1, 0, pa2); PK4(p1, 8, pa3);
#undef PK4
}
__device__ __forceinline__ void qkt(f32x16& p0, f32x16& p1, const int* kb, const int* pb, const bf16x8* qn, const bf16x8* qp) {
#define KRD(dst, base, off) asm volatile("ds_read_b128 %0, %1 offset:%2" : "=&v"(dst) : "v"(base), "i"(off) : "memory")
#define RN(S, d0) do { KRD(S##0, kb[(d0) & 3], ((d0) >> 2) * 128); KRD(S##1, kb[(d0) & 3], ((d0) >> 2) * 128 + 32 * 256); } while (0)
#define RP(S, d0) do { KRD(S##0, pb[d0], 0); KRD(S##1, pb[d0], 32 * 128); } while (0)
#define MN(S, d0) do { p0 = __builtin_amdgcn_mfma_f32_32x32x16_bf16(__builtin_bit_cast(bf16x8, S##0), qn[d0], p0, 0, 0, 0); p1 = __builtin_amdgcn_mfma_f32_32x32x16_bf16(__builtin_bit_cast(bf16x8, S##1), qn[d0], p1, 0, 0, 0); } while (0)
#define MP(S, d0) do { p0 = __builtin_amdgcn_mfma_f32_32x32x16_bf16(__builtin_bit_cast(bf16x8, S##0), qp[d0], p0, 0, 0, 0); p1 = __builtin_amdgcn_mfma_f32_32x32x16_bf16(__builtin_bit_cast(bf16x8, S##1), qp[d0], p1, 0, 0, 0); } while (0)
#define LW(n) asm volatile("s_waitcnt lgkmcnt(" #n ")" ::: "memory")
#pragma unroll
    for (int r = 0; r < 16; ++r) { p0[r] = 0.f; p1[r] = 0.f; }
    u32x4 A0, A1, B0, B1;
    RN(A, 0); RN(B, 1);
    __builtin_amdgcn_s_setprio(2);
    LW(2); SBAR(); MN(A, 0); SBAR(); RN(A, 2);
    LW(2); SBAR(); MN(B, 1); SBAR(); RN(B, 3);
    LW(2); SBAR(); MN(A, 2); SBAR(); RN(A, 4);
    LW(2); SBAR(); MN(B, 3); SBAR(); RN(B, 5);
    LW(2); SBAR(); MN(A, 4); SBAR(); RN(A, 6);
    LW(2); SBAR(); MN(B, 5); SBAR(); RN(B, 7);
    LW(2); SBAR(); MN(A, 6); SBAR(); RP(A, 0);
    LW(2); SBAR(); MN(B, 7); SBAR(); RP(B, 1);
    LW(2); SBAR(); MP(A, 0); SBAR(); RP(A, 2);
    LW(2); SBAR(); MP(B, 1); SBAR(); RP(B, 3);
    LW(2); SBAR(); MP(A, 2); SBAR();
    LW(0); SBAR(); MP(B, 3);
    __builtin_amdgcn_s_setprio(0);
#undef LW
#undef MP
#undef MN
#undef RP
#undef RN
#undef KRD
}
__device__ __forceinline__ void pv_tile(f32x16* o, int vb0, bf16x8 pa0, bf16x8 pa1, bf16x8 pa2, bf16x8 pa3) {
#define TRRD(dst, off) asm volatile("ds_read_b64_tr_b16 %0, %1 offset:%2" : "=&v"(dst) : "v"(vb0), "i"(off) : "memory")
#define VRD(ks, S) do { TRRD(S##l0, v_rd_off(0, ks, 0)); TRRD(S##h0, v_rd_off(0, ks, 1)); TRRD(S##l1, v_rd_off(1, ks, 0)); TRRD(S##h1, v_rd_off(1, ks, 1)); \
                        TRRD(S##l2, v_rd_off(2, ks, 0)); TRRD(S##h2, v_rd_off(2, ks, 1)); TRRD(S##l3, v_rd_off(3, ks, 0)); TRRD(S##h3, v_rd_off(3, ks, 1)); } while (0)
#define VMM(pa, S) do { \
        o[0] = __builtin_amdgcn_mfma_f32_32x32x16_bf16(pa, (bf16x8){S##l0[0], S##l0[1], S##l0[2], S##l0[3], S##h0[0], S##h0[1], S##h0[2], S##h0[3]}, o[0], 0, 0, 0); \
        o[1] = __builtin_amdgcn_mfma_f32_32x32x16_bf16(pa, (bf16x8){S##l1[0], S##l1[1], S##l1[2], S##l1[3], S##h1[0], S##h1[1], S##h1[2], S##h1[3]}, o[1], 0, 0, 0); \
        o[2] = __builtin_amdgcn_mfma_f32_32x32x16_bf16(pa, (bf16x8){S##l2[0], S##l2[1], S##l2[2], S##l2[3], S##h2[0], S##h2[1], S##h2[2], S##h2[3]}, o[2], 0, 0, 0); \
        o[3] = __builtin_amdgcn_mfma_f32_32x32x16_bf16(pa, (bf16x8){S##l3[0], S##l3[1], S##l3[2], S##l3[3], S##h3[0], S##h3[1], S##h3[2], S##h3[3]}, o[3], 0, 0, 0); } while (0)
    s16x4 Al0, Ah0, Al1, Ah1, Al2, Ah2, Al3, Ah3, Bl0, Bh0, Bl1, Bh1, Bl2, Bh2, Bl3, Bh3;
    VRD(0, A); VRD(1, B);
    __builtin_amdgcn_s_setprio(2);
    asm volatile("s_waitcnt lgkmcnt(8)" ::: "memory"); SBAR(); VMM(pa0, A); SBAR();
    VRD(2, A);
    asm volatile("s_waitcnt lgkmcnt(8)" ::: "memory"); SBAR(); VMM(pa1, B); SBAR();
    VRD(3, B);
    asm volatile("s_waitcnt lgkmcnt(8)" ::: "memory"); SBAR(); VMM(pa2, A); SBAR();
    asm volatile("s_waitcnt lgkmcnt(0)" ::: "memory"); SBAR(); VMM(pa3, B);
    __builtin_amdgcn_s_setprio(0);
#undef VMM
#undef VRD
#undef TRRD
}
}

__device__ __forceinline__ void attn_item(Frame& F, int item) {
    using namespace att;
    const int bh = item >> 4, x = item & 15, b = bh >> 3, h = bh & 7;
    const int wid = F.wave, lane = F.lane, r32 = lane & 31, hi = lane >> 5;
    const bool grpB = wid >= 4;
    const int NL = 2 * x + 2, NH = 64 - 2 * x;
    const int qloH = (31 - x) * 128 + (wid & 3) * 32;
    int qlo = grpB ? qloH : x * 128 + (wid & 3) * 32;
    LAS unsigned char* L = F.lds;
    const bf16_t* Q = WSP(bf16_t, WS_Q) + (size_t)(b * SEQ) * NQ + h * MLA_QK;
    const bf16_t* KV = WSP(bf16_t, WS_KV) + (size_t)(b * MLA_H + h) * SEQ * 256;
    const bf16_t* KPE = WSP(bf16_t, WS_KPE) + (size_t)(b * SEQ) * MLA_ROPE;
    bf16x8 qn[8], qp[4];
#define LOADQ() do { const bf16_t* qrow = Q + (size_t)(qlo + r32) * NQ; \
        _Pragma("unroll") for (int d0 = 0; d0 < 8; ++d0) qn[d0] = *(const bf16x8*)(qrow + d0 * 16 + hi * 8); \
        _Pragma("unroll") for (int d0 = 0; d0 < 4; ++d0) qp[d0] = *(const bf16x8*)(qrow + MLA_NOPE + d0 * 16 + hi * 8); } while (0)
    LOADQ();
#define GLDS(src, dst) __builtin_amdgcn_global_load_lds((const unsigned*)(src), (LAS unsigned*)(dst), 16, 0, 0)
    unsigned ofKn, ofKp, ofV;
    { const int p0_ = wid * 64 + lane;
      { const int row_ = p0_ >> 4, ch_ = (p0_ & 15) ^ (row_ & 7); ofKn = (unsigned)(row_ * 256 + ch_ * 8) * 2u; }
      { const int row_ = p0_ >> 3, ch_ = (p0_ & 7) ^ (row_ & 7); ofKp = (unsigned)(row_ * MLA_ROPE + ch_ * 8) * 2u; }
      { const int st_ = p0_ >> 5, wi_ = p0_ & 31, kk_ = (st_ >> 2) * 8 + (wi_ >> 2), k_ = (kk_ & ~0xC) | ((kk_ & 4) << 1) | ((kk_ & 8) >> 1), c_ = (st_ & 3) * 32 + (wi_ & 3) * 8; ofV = (unsigned)(k_ * 256 + MLA_NOPE + c_) * 2u; } }
#define ALOADK(k0, slot) do { const char* kvb = (const char*)(KV + (size_t)(k0) * 256); const char* kpb_ = (const char*)(KPE + (size_t)(k0) * MLA_ROPE); \
        GLDS(kvb + ofKn, L + OFF_KN + (slot) * SHM_KN + wid * 1024); GLDS(kvb + 16384 + ofKn, L + OFF_KN + (slot) * SHM_KN + (wid + 8) * 1024); \
        GLDS(kpb_ + ofKp, L + OFF_KP + (slot) * SHM_KP + wid * 1024); } while (0)
#define ALOADV(k0, slot) do { const char* kvb = (const char*)(KV + (size_t)(k0) * 256); \
        GLDS(kvb + ofV, L + OFF_V + (slot) * SHM_V + wid * 1024); GLDS(kvb + 16384 + ofV, L + OFF_V + (slot) * SHM_V + (wid + 8) * 1024); } while (0)
    LAS float* wsf = (LAS float*)(L + OFF_WS) + wid * 64; LAS float* li_l = wsf; LAS float* al_l = wsf + 32;
    const int lbase = (int)(unsigned)(size_t)L;
    const int vbase = lbase + OFF_V + v_rd_base(lane);
    float m_reg = -1e30f, l_reg = 0.f; f32x16 o[4];
#define ZERO_O() do { _Pragma("unroll") for (int d = 0; d < 4; ++d) _Pragma("unroll") for (int r = 0; r < 16; ++r) o[d][r] = 0.f; } while (0)
    ZERO_O();
#define ATT_X(T_, KS_) do { f32x16 p0, p1; float mn, al; \
        { int tq_ = threadIdx.x; asm volatile("" : "+v"(tq_)); const int r_ = tq_ & 31, h_ = (tq_ >> 5) & 1; \
          const int ksw0 = lbase + OFF_KN + KSWZ(r_, (h_ * 8) * 2) + (KS_) * SHM_KN, psw0 = lbase + OFF_KP + KPSWZ(r_, (h_ * 8) * 2) + (KS_) * SHM_KP; \
          int kb[4], pb[4]; _Pragma("unroll") for (int dd = 0; dd < 4; ++dd) { kb[dd] = ksw0 ^ (dd << 5); pb[dd] = psw0 ^ (dd << 5); } qkt(p0, p1, kb, pb, qn, qp); } \
        if ((T_) * 64 + 63 > qlo) mask_tile(p0, p1, qlo + r32 - 4 * hi - (T_) * 64); \
        partialSM(p0, p1, m_reg, mn, al); \
        if (__any(al < 1.f)) { if (hi == 0) al_l[r32] = al; asm volatile("s_waitcnt lgkmcnt(0)" ::: "memory"); \
            _Pragma("unroll") for (int d_ = 0; d_ < 4; ++d_) _Pragma("unroll") for (int r = 0; r < 16; ++r) o[d_][r] *= al_l[crow(r, hi)]; } \
        finishSM(p0, p1, al, l_reg, pa0, pa1, pa2, pa3); SBAR(); } while (0)
    LAS unsigned* vflag = (LAS unsigned*)(L + OFF_WS + 2048); unsigned vtarget = 0;
    if (F.tid == 0) { vflag[0] = 0u; vflag[1] = 0u; }
    ALOADK(0, 0); ALOADV(0, 0); ALOADK(64, 1); ALOADV(64, 1);
    asm volatile("s_waitcnt vmcnt(0)" ::: "memory"); __syncthreads();
    int ks = 0, vs = 0;
    for (int t = 0; t < NL; ++t) {
        { const int v2 = vs == 0 ? 2 : vs - 1; ALOADK((t + 2) * 64, (ks + 2) & 3); ALOADV((t + 2) * 64, v2); }
        if (t * 64 <= qlo + 31) {
            bf16x8 pa0, pa1, pa2, pa3;
            ATT_X(t, ks);
            pv_tile(o, vbase + vs * SHM_V, pa0, pa1, pa2, pa3);
        }
        if (t + 1 < NL) asm volatile("s_waitcnt vmcnt(5)" ::: "memory");
        else asm volatile("s_waitcnt vmcnt(0)" ::: "memory");
        __builtin_amdgcn_s_barrier();
        ks = (ks + 1) & 3; vs = vs == 2 ? 0 : vs + 1;
    }
    bf16_t* Ow = WSP(bf16_t, WS_ATTO) + (size_t)(b * SEQ) * BR_LD + h * MLA_V;
    if (!grpB) {
        if (hi == 0) li_l[r32] = l_reg; asm volatile("s_waitcnt lgkmcnt(0)" ::: "memory");
        bf16_t* Or = Ow + (size_t)qlo * BR_LD;
#pragma unroll
        for (int r = 0; r < 16; ++r) { const int orow = crow(r, hi); const float rl = __builtin_amdgcn_rcpf(li_l[orow]);
#pragma unroll
            for (int d0 = 0; d0 < 4; ++d0) { const float v = o[d0][r] * rl; const float vn = __shfl_xor(v, 1);
                if ((r32 & 1) == 0) *(unsigned*)(Or + (size_t)orow * BR_LD + d0 * 32 + r32) = cvt_pk_bf16(v, vn); } }
        qlo = qloH; LOADQ(); m_reg = -1e30f; l_reg = 0.f; ZERO_O();
    }
#define ALOADVG(k0, slot) do { const char* kvb = (const char*)(KV + (size_t)(k0) * 256) - (grpB ? 8192 : 0); const int w3_ = wid & 3; \
        GLDS(kvb + ofV, L + OFF_V + (slot) * SHM_V + w3_ * 1024); GLDS(kvb + 8192 + ofV, L + OFF_V + (slot) * SHM_V + (w3_ + 4) * 1024); \
        GLDS(kvb + 16384 + ofV, L + OFF_V + (slot) * SHM_V + (w3_ + 8) * 1024); GLDS(kvb + 24576 + ofV, L + OFF_V + (slot) * SHM_V + (w3_ + 12) * 1024); } while (0)
    LAS unsigned* gflag = vflag + (grpB ? 1 : 0);
    for (int a = NL; a < NH; a += 2) {
        const bool more = a + 2 < NH;
        const int v1 = vs == 2 ? 0 : vs + 1, v2 = vs == 0 ? 2 : vs - 1;
        if (grpB) { if (a > NL) ALOADVG((a + 1) * 64, v1);
                    if (more) { ALOADK((a + 2) * 64, (ks + 2) & 3); ALOADK((a + 3) * 64, (ks + 3) & 3); } }
        else if (more) { ALOADK((a + 2) * 64, (ks + 2) & 3); ALOADK((a + 3) * 64, (ks + 3) & 3); ALOADVG((a + 2) * 64, v2); }
        const int my = grpB ? a + 1 : a;
        const bool act = my * 64 <= qlo + 31;
        bf16x8 pa0, pa1, pa2, pa3;
        if (act) ATT_X(my, (grpB ? ks + 1 : ks) & 3);
        if (!more) asm volatile("s_waitcnt vmcnt(0)" ::: "memory");
        else if (grpB) asm volatile("s_waitcnt vmcnt(6)" ::: "memory");
        else asm volatile("s_waitcnt vmcnt(10)" ::: "memory");
        if (lane == 0) __hip_atomic_fetch_add(gflag, 1u, __ATOMIC_RELAXED, __HIP_MEMORY_SCOPE_WORKGROUP);
        vtarget += 4u;
        if (act) { while (*(volatile LAS unsigned*)gflag < vtarget) __builtin_amdgcn_s_sleep(1);
                   pv_tile(o, vbase + (grpB ? v1 : vs) * SHM_V, pa0, pa1, pa2, pa3); }
        if (more && !grpB) asm volatile("s_waitcnt vmcnt(4)" ::: "memory");
        else asm volatile("s_waitcnt vmcnt(0)" ::: "memory");
        __builtin_amdgcn_s_barrier();
        ks = (ks + 2) & 3; vs = v2;
    }
#undef ALOADVG
#undef ATT_X
#undef ZERO_O
#undef LOADQ
#undef ALOADV
#undef ALOADK
#undef GLDS
    { LAS float* EXO = (LAS float*)(L + OFF_EXO); LAS float* EXS = (LAS float*)(L + OFF_EXS);
      constexpr float C2 = 1.4426950408889634f * SCALE;
      if (!grpB) {
#pragma unroll
          for (int d = 0; d < 4; ++d)
#pragma unroll
              for (int r = 0; r < 16; ++r) EXO[((wid * 64) + d * 16 + r) * 64 + lane] = o[d][r];
          if (hi == 0) { EXS[(wid * 2 + 0) * 32 + r32] = m_reg; EXS[(wid * 2 + 1) * 32 + r32] = l_reg; }
      } else if (hi == 0) { li_l[r32] = l_reg; al_l[r32] = m_reg; }
      __syncthreads();
      if (grpB) { const int w4 = wid - 4; bf16_t* Or = Ow + (size_t)qlo * BR_LD;
#pragma unroll
          for (int r = 0; r < 16; ++r) { const int orow = crow(r, hi);
              const float mA = EXS[(w4 * 2 + 0) * 32 + orow], lA = EXS[(w4 * 2 + 1) * 32 + orow], mB = al_l[orow], lB = li_l[orow];
              const float M = fmaxf(mA, mB); float fa = __builtin_amdgcn_exp2f((mA - M) * C2), fb = __builtin_amdgcn_exp2f((mB - M) * C2);
              const float rl = __builtin_amdgcn_rcpf(lA * fa + lB * fb); fa *= rl; fb *= rl;
#pragma unroll
              for (int d0 = 0; d0 < 4; ++d0) { const float v = o[d0][r] * fb + EXO[((w4 * 64) + d0 * 16 + r) * 64 + lane] * fa; const float vn = __shfl_xor(v, 1);
                  if ((r32 & 1) == 0) *(unsigned*)(Or + (size_t)orow * BR_LD + d0 * 32 + r32) = cvt_pk_bf16(v, vn); } } }
      __syncthreads(); }
}

__device__ __forceinline__ void p8_router(Frame& F) {
    LAS unsigned char* L = F.lds;
    LAS float* RED = (LAS float*)L;
    LAS float* SSQ = (LAS float*)(L + 32768);
    LAS float* LG = (LAS float*)(L + 36864);
    LAS float* RS = (LAS float*)(L + 41472);
    LAS int* SEL = (LAS int*)(L + 41984);
    const float* X1 = WSP(float, WS_X1); const float* RW = WSP(float, WS_RW); const float* RC = WSP(float, WS_RC); const float* mod = WSP(float, WS_MOD);
    const int lane = F.lane, r = lane & 31, hh = lane >> 5;
    for (int task = F.vcu; task < NTOK / 32; task += F.G) {
        const int row0 = task * 32, b = row0 / SEQ, kbeg = F.wave * 256;
        const float* xa = X1 + (size_t)(row0 + r) * DM + kbeg + 4 * hh;
        const float* wb = RW + ((size_t)b * DM + kbeg + 4 * hh) * NEXP + r;
        f32x16 acc; float ss = 0.f;
#pragma unroll
        for (int i = 0; i < 16; ++i) acc[i] = 0.f;
#pragma unroll 4
        for (int m = 0; m < 32; ++m) { const f32x4 a = *(const f32x4*)(xa + 8 * m);
            const float w0 = wb[(8 * m + 0) * NEXP], w1 = wb[(8 * m + 1) * NEXP], w2 = wb[(8 * m + 2) * NEXP], w3 = wb[(8 * m + 3) * NEXP];
            acc = __builtin_amdgcn_mfma_f32_32x32x2f32(a.x, w0, acc, 0, 0, 0); acc = __builtin_amdgcn_mfma_f32_32x32x2f32(a.y, w1, acc, 0, 0, 0);
            acc = __builtin_amdgcn_mfma_f32_32x32x2f32(a.z, w2, acc, 0, 0, 0); acc = __builtin_amdgcn_mfma_f32_32x32x2f32(a.w, w3, acc, 0, 0, 0);
            ss += (a.x * a.x + a.y * a.y) + (a.z * a.z + a.w * a.w); }
#pragma unroll
        for (int i = 0; i < 16; ++i) RED[(F.wave * 32 + att::crow(i, hh)) * 32 + r] = acc[i];
        SSQ[(F.wave * 2 + hh) * 32 + r] = ss;
        __syncthreads();
#pragma unroll
        for (int q = 0; q < 2; ++q) { const int idx = F.tid + q * 512; float s = 0.f;
#pragma unroll
            for (int w = 0; w < 8; ++w) s += RED[w * 1024 + idx];
            LG[(idx >> 5) * 33 + (idx & 31)] = s; }
        if (F.tid < 32) { float s = 0.f;
#pragma unroll
            for (int w = 0; w < 16; ++w) s += SSQ[w * 32 + F.tid];
            RS[F.tid] = 1.0f / sqrtf(s * (1.0f / DM) + EPS); }
        __syncthreads();
        if (F.tid < 32) { const int row = F.tid; const float rs = RS[row];
            int s0 = -1, s1 = -1, s2 = -1, s3 = -1; float v0 = 0.f, v1 = 0.f, v2 = 0.f, v3 = 0.f;
#pragma unroll
            for (int k = 0; k < 4; ++k) { float best = -__builtin_inff(); int bi = 0;
                for (int e = 0; e < NEXP; ++e) { const float v = rs * LG[row * 33 + e] + RC[b * NEXP + e];
                    const bool taken = (e == s0) | (e == s1) | (e == s2) | (e == s3);
                    if (!taken && v > best) { best = v; bi = e; } }
                if (k == 0) { s0 = bi; v0 = best; } else if (k == 1) { s1 = bi; v1 = best; } else if (k == 2) { s2 = bi; v2 = best; } else { s3 = bi; v3 = best; } }
            const float e0 = 1.0f, e1 = __expf(v1 - v0), e2 = __expf(v2 - v0), e3 = __expf(v3 - v0), inv = 1.0f / (e0 + e1 + e2 + e3);
            *(f32x4*)(WSP(float, WS_TOPW) + (size_t)(row0 + row) * 4) = (f32x4){e0 * inv, e1 * inv, e2 * inv, e3 * inv};
            SEL[row * 4 + 0] = s0; SEL[row * 4 + 1] = s1; SEL[row * 4 + 2] = s2; SEL[row * 4 + 3] = s3; }
        __syncthreads();
        if (F.tid < 32) { const int e = F.tid; int nsel = 0;
            for (int i = 0; i < 128; ++i) nsel += (SEL[i] == e) ? 1 : 0;
            if (nsel) { int slot = (int)__hip_atomic_fetch_add((unsigned*)(F.ctl + CW_CNT + 64 * e), (unsigned)nsel, RLX_AGENT);
                int* rowmap = WSP(int, WS_ROWMAP) + (size_t)e * ECAP; int* topi = WSP(int, WS_TOPI);
                for (int i = 0; i < 128; ++i) if (SEL[i] == e) { rowmap[slot] = row0 + (i >> 2); topi[(size_t)(row0 + (i >> 2)) * 4 + (i & 3)] = e * ECAP + slot; ++slot; } } }
#pragma unroll
        for (int q = 0; q < 4; q += 2) { const int m = row0 + F.wave * 4 + q;
            norm_mod_row2_bf16<true>(X1 + (size_t)m * DM, X1 + (size_t)(m + 1) * DM, F.norm_ffn_w, mod + b * 6 * DM + 3 * DM, mod + b * 6 * DM + 4 * DM, mod + b * 6 * DM + 3 * DM, mod + b * 6 * DM + 4 * DM,
                                     (bf16_t*)(WSP(unsigned char, WS_H) + (size_t)m * DM), (bf16_t*)(WSP(unsigned char, WS_H) + (size_t)(m + 1) * DM), F.lane); }
        __syncthreads();
    }
}

__device__ __forceinline__ void moe_tables(Frame& F, int npn, int G, int c) {
    if (F.tid < NEXP) { const unsigned cn = __hip_atomic_load((unsigned*)(F.ctl + CW_CNT + 64 * F.tid), RLX_AGENT); F.LW[LW_CNT + F.tid] = cn; F.LW[LW_NBLK + F.tid] = (cn + 255u) >> 8; }
    __syncthreads();
    if (F.tid == 0) { unsigned sacc = 0; for (int e = 0; e < NEXP; ++e) { F.LW[LW_USTART + e] = sacc; sacc += F.LW[LW_NBLK + e]; } F.LW[LW_USTART + NEXP] = sacc; }
    __syncthreads();
    if (F.tid < 16) { const unsigned Lx = (unsigned)(F.tid * G + c), total = F.LW[LW_USTART + NEXP] * (unsigned)npn;
        unsigned w0 = 0xffffffffu, w1 = 0, w2 = 0, w3 = 0;
        if (Lx < total) { int e = 0; while (Lx >= F.LW[LW_USTART + e + 1] * (unsigned)npn) ++e;
            const unsigned r = Lx - F.LW[LW_USTART + e] * (unsigned)npn, nb = F.LW[LW_NBLK + e], mb = r % nb;
            w0 = (unsigned)e * (ECAP / 256) + mb; w1 = r / nb; w2 = (unsigned)e; w3 = F.LW[LW_CNT + e] - mb * 256u; }
        F.LW[LW_UNITS + 4 * F.tid + 0] = w0; F.LW[LW_UNITS + 4 * F.tid + 1] = w1; F.LW[LW_UNITS + 4 * F.tid + 2] = w2; F.LW[LW_UNITS + 4 * F.tid + 3] = w3; }
    __syncthreads();
}
template <bool GATHER_>
struct MoeOrder {
    static constexpr bool GATHER = true, RGATHER = GATHER_, FP8 = true, DEPWAIT = false;
    const unsigned char* A; const unsigned char* Bt; int ldab, KB, npn; size_t bstride; const int* rowmap; volatile LAS unsigned* LW; int G, c;
    __device__ __forceinline__ bool next(int i, pg8::Unit& u) const {
        if (i >= 16) {
            const unsigned Lx = (unsigned)(i * G + c), total = LW[LW_USTART + NEXP] * (unsigned)npn; if (Lx >= total) return false;
            int e = 0; while (Lx >= LW[LW_USTART + e + 1] * (unsigned)npn) ++e;
            const unsigned r = Lx - LW[LW_USTART + e] * (unsigned)npn, nb = LW[LW_NBLK + e], mb = r % nb;
            u.pn = (int)(r / nb); u.pm = e * (ECAP / 256) + (int)mb; u.aux = e; u.cnt = (int)LW[LW_CNT + e] - (int)mb * 256; return true; }
        const unsigned w0 = LW[LW_UNITS + 4 * i]; if (w0 == 0xffffffffu) return false;
        u.pm = (int)w0; u.pn = (int)LW[LW_UNITS + 4 * i + 1]; u.aux = (int)LW[LW_UNITS + 4 * i + 2]; u.cnt = (int)LW[LW_UNITS + 4 * i + 3]; return true;
    }
    __device__ __forceinline__ const char* a_ptr(const pg8::Unit& u) const { return RGATHER ? (const char*)A : (const char*)A + (size_t)u.pm * 256 * ldab; }
    __device__ __forceinline__ unsigned a_off(const pg8::Unit& u, int row, int colb) const {
        if constexpr (RGATHER) { const int tok = row < u.cnt ? rowmap[(size_t)u.pm * 256 + row] : 0; return (unsigned)(tok * ldab + colb); }
        else return (unsigned)(row * ldab + colb);
    }
    __device__ __forceinline__ const char* b_ptr(const pg8::Unit& u) const { return (const char*)Bt + (size_t)u.aux * bstride + (size_t)u.pn * 256 * KB; }
};

__device__ __forceinline__ bool moe_both_decode(volatile LAS unsigned* LW, unsigned g, unsigned& w0, unsigned& w1, unsigned& w2, unsigned& w3) {
    const unsigned tot = LW[LW_USTART + NEXP], n9 = tot * ((2 * DEXP) / 256);
    unsigned kind = 0, npn = (2 * DEXP) / 256, Lx = g;
    if (g >= n9) { kind = 1; npn = DM / 256; Lx = g - n9; if (Lx >= tot * npn) return false; }
    int e = 0; while (Lx >= LW[LW_USTART + e + 1] * npn) ++e;
    const unsigned r = Lx - LW[LW_USTART + e] * npn, nb = LW[LW_NBLK + e], mb = r % nb;
    w0 = (unsigned)e * (ECAP / 256) + mb; w1 = r / nb; w2 = (unsigned)e | (kind << 8); w3 = LW[LW_CNT + e] - mb * 256u; return true;
}
__device__ __forceinline__ void moe_tables_both(Frame& F, int G, int c) {
    if (F.tid < 64) { const int e = F.tid & 31; const unsigned cn = __hip_atomic_load((unsigned*)(F.ctl + CW_CNT + 64 * e), RLX_AGENT), nb = (cn + 255u) >> 8;
        unsigned inc = nb;
#pragma unroll
        for (int o = 1; o < 32; o <<= 1) { const unsigned t = (unsigned)__shfl_up((int)inc, o, 32); if (e >= o) inc += t; }
        if (F.tid < NEXP) { F.LW[LW_CNT + e] = cn; F.LW[LW_NBLK + e] = nb; F.LW[LW_USTART + e] = inc - nb; if (e == NEXP - 1) F.LW[LW_USTART + NEXP] = inc; } }
    __syncthreads();
    if (F.tid < 24) { unsigned w0 = 0xffffffffu, w1 = 0, w2 = 0, w3 = 0;
        if (!moe_both_decode(F.LW, (unsigned)(F.tid * G + c), w0, w1, w2, w3)) w0 = 0xffffffffu;
        F.LW[LW_UNITS + 4 * F.tid + 0] = w0; F.LW[LW_UNITS + 4 * F.tid + 1] = w1; F.LW[LW_UNITS + 4 * F.tid + 2] = w2; F.LW[LW_UNITS + 4 * F.tid + 3] = w3; }
    __syncthreads();
}
struct MoeBoth {
    static constexpr bool GATHER = true, FP8 = true, DEPWAIT = true, ROWDMA = true;
    const unsigned char* H2; const unsigned char* ACT; const unsigned char* W1; const unsigned char* W2; int ldab, KB; const int* rowmap; volatile LAS unsigned* LW; const unsigned* blk; int G, c; int probe;
    __device__ __forceinline__ bool next(int i, pg8::Unit& u) const {
        unsigned w0, w1, w2, w3;
        if (i >= 24) { if (!moe_both_decode(LW, (unsigned)(i * G + c), w0, w1, w2, w3)) return false; }
        else { w0 = LW[LW_UNITS + 4 * i]; if (w0 == 0xffffffffu) return false; w1 = LW[LW_UNITS + 4 * i + 1]; w2 = LW[LW_UNITS + 4 * i + 2]; w3 = LW[LW_UNITS + 4 * i + 3]; }
        u.pm = (int)w0; u.pn = (int)w1; u.aux = (int)w2; u.cnt = (int)w3; return true;
    }
    __device__ __forceinline__ void wait_ready(const pg8::Unit& u) const {
        if (u.aux >> 8) { while (__hip_atomic_load(blk + u.pm, __ATOMIC_RELAXED, __HIP_MEMORY_SCOPE_AGENT) < 8u * ((2 * DEXP) / 256)) __builtin_amdgcn_s_sleep(2); }
    }
    __device__ __forceinline__ const char* a_ptr(const pg8::Unit& u) const { if (probe & 2) return (const char*)H2; return (u.aux >> 8) ? (const char*)ACT + (size_t)u.pm * 256 * ldab : (const char*)H2; }
    __device__ __forceinline__ unsigned a_off(const pg8::Unit& u, int row, int colb) const {
        if (u.aux >> 8) return (unsigned)(row * ldab + colb);
        const int tok = row < u.cnt ? rowmap[(size_t)u.pm * 256 + row] : 0; return (unsigned)(tok * ldab + colb);
    }
    __device__ __forceinline__ void rows_dma(const pg8::Unit& u, LAS int* dst, int lane) const {
        if ((u.aux >> 8) == 0) __builtin_amdgcn_global_load_lds((const unsigned*)(rowmap + (size_t)u.pm * 256 + 4 * lane), (LAS unsigned*)dst, 16, 0, 0); }

    __device__ __forceinline__ int row_from(const pg8::Unit& u, int row, const LAS int* tab) const { if (u.aux >> 8) return row; if (probe & 2) return row; return row < u.cnt ? tab[row] : 0; }
    __device__ __forceinline__ bool has_dep(const pg8::Unit& u) const { return (u.aux >> 8) != 0; }
    __device__ __forceinline__ unsigned dep_need() const { return 8u * ((2 * DEXP) / 256); }
    __device__ __forceinline__ void dep_dma(const pg8::Unit& u, LAS unsigned* dst, int lane) const {
        if ((u.aux >> 8) && lane == 0) __builtin_amdgcn_global_load_lds((const unsigned*)(blk + u.pm), dst, 4, 0, 17); }
    __device__ __forceinline__ int a_row(const pg8::Unit& u, int row) const {
        if (u.aux >> 8) return row;
        return row < u.cnt ? rowmap[(size_t)u.pm * 256 + row] : 0; }
    __device__ __forceinline__ const char* b_ptr(const pg8::Unit& u) const { if (probe & 1) return (const char*)W1; const int e = u.aux & 255;
        return (u.aux >> 8) ? (const char*)W2 + (size_t)e * ((size_t)DM * DEXP) + (size_t)u.pn * 256 * KB : (const char*)W1 + (size_t)e * ((size_t)2 * DEXP * DM) + (size_t)u.pn * 256 * KB; }
};

__device__ __forceinline__ void p11_final(Frame& F) {
    const int gw = F.vcu * NWAVES + F.wave, NGW = F.G * NWAVES;
    const float* X1 = WSP(float, WS_X1); const float* mod = WSP(float, WS_MOD); const float* fmod = WSP(float, WS_FMOD); const unsigned char* Y = WSP(unsigned char, WS_Y);
    for (int m = gw; m < NTOK; m += NGW) { const int b = m / SEQ;
        const int* ti = WSP(int, WS_TOPI) + (size_t)m * 4; const f32x4 tw = *(const f32x4*)(WSP(float, WS_TOPW) + (size_t)m * 4);
        const unsigned char* y0 = Y + (size_t)ti[0] * DM; const unsigned char* y1 = Y + (size_t)ti[1] * DM; const unsigned char* y2 = Y + (size_t)ti[2] * DM; const unsigned char* y3 = Y + (size_t)ti[3] * DM;
        const f32x4 tws = tw * (1.0f / Y8_SCALE);
        const float* gf = mod + b * 6 * DM + 5 * DM;
        f32x4 v[8]; float s = 0.f;
#pragma unroll
        for (int j = 0; j < 8; ++j) { const int c = 4 * F.lane + 256 * j;
            const f32x4 xv = __builtin_nontemporal_load((const f32x4*)(X1 + (size_t)m * DM + c)), g = *(const f32x4*)(gf + c);
            const unsigned a0 = __builtin_nontemporal_load((const unsigned*)(y0 + c)), a1 = __builtin_nontemporal_load((const unsigned*)(y1 + c)), a2 = __builtin_nontemporal_load((const unsigned*)(y2 + c)), a3 = __builtin_nontemporal_load((const unsigned*)(y3 + c));
            const f32x2 l0 = __builtin_amdgcn_cvt_pk_f32_fp8((int)a0, false), h0 = __builtin_amdgcn_cvt_pk_f32_fp8((int)a0, true), l1 = __builtin_amdgcn_cvt_pk_f32_fp8((int)a1, false), h1 = __builtin_amdgcn_cvt_pk_f32_fp8((int)a1, true);
            const f32x2 l2 = __builtin_amdgcn_cvt_pk_f32_fp8((int)a2, false), h2 = __builtin_amdgcn_cvt_pk_f32_fp8((int)a2, true), l3 = __builtin_amdgcn_cvt_pk_f32_fp8((int)a3, false), h3 = __builtin_amdgcn_cvt_pk_f32_fp8((int)a3, true);
            f32x4 acc;
            acc.x = tws.x * l0.x + tws.y * l1.x + tws.z * l2.x + tws.w * l3.x;
            acc.y = tws.x * l0.y + tws.y * l1.y + tws.z * l2.y + tws.w * l3.y;
            acc.z = tws.x * h0.x + tws.y * h1.x + tws.z * h2.x + tws.w * h3.x;
            acc.w = tws.x * h0.y + tws.y * h1.y + tws.z * h2.y + tws.w * h3.y;
            v[j] = xv + g * acc; s += (v[j].x * v[j].x + v[j].y * v[j].y) + (v[j].z * v[j].z + v[j].w * v[j].w); }
        const float rs = 1.0f / sqrtf(wave_sum(s) * (1.0f / DM) + EPS);
#pragma unroll
        for (int j = 0; j < 8; ++j) { const int c = 4 * F.lane + 256 * j; const f32x4 g = *(const f32x4*)(F.norm_final_w + c), sh = *(const f32x4*)(fmod + b * 2 * DM + c), sc = *(const f32x4*)(fmod + b * 2 * DM + DM + c);
            __builtin_nontemporal_store(v[j] * rs * g * (sc + 1.0f) + sh, (f32x4*)(F.out + (size_t)m * DM + c)); }
    }
}

constexpr int NPHASE = 12;
struct Args { const void* in[27]; float* out; unsigned char* ws; int ph_lo, ph_hi, li, pad; };
__global__ void __launch_bounds__(NWAVES * 64, 2) mk_fwd(Args args) {
    extern __shared__ __attribute__((aligned(16))) unsigned char lds_raw[];
    Frame F;
    F.lds = (LAS unsigned char*)lds_raw;
    F.LW = (volatile LAS unsigned*)(F.lds + LDSCTL_OFF);
    F.tid = threadIdx.x; F.lane = F.tid & 63; F.wave = __builtin_amdgcn_readfirstlane(F.tid >> 6);
    F.probe = args.pad; F.G = gridDim.x; { const int bx = blockIdx.x; F.vcu = (F.G % 8 == 0) ? (bx % 8) * (F.G / 8) + bx / 8 : bx; }
    F.ws = args.ws; F.ctl = (gu32*)(args.ws + WS_CTL); F.out = args.out;
    F.x = (const float*)args.in[0]; F.c = (const float*)args.in[1]; F.pos = (const int*)args.in[2];
    F.w_ada = (const float*)args.in[3]; F.b_ada = (const float*)args.in[4]; F.norm_mix_w = (const float*)args.in[5]; F.w_in = (const float*)args.in[6];
    F.q_norm_w = (const float*)args.in[7]; F.w_q_b = (const float*)args.in[8]; F.kv_norm_w = (const float*)args.in[9]; F.w_kv_b = (const float*)args.in[10];
    F.w_gk_up = (const float*)args.in[11]; F.b_gk_up = (const float*)args.in[12]; F.gla_norm_w = (const float*)args.in[13];
    F.w_o_mla = (const float*)args.in[14]; F.w_o_gla = (const float*)args.in[15]; F.w_out = (const float*)args.in[16]; F.norm_ffn_w = (const float*)args.in[17];
    F.w_router = (const float*)args.in[18]; F.b_router = (const float*)args.in[19]; F.w1 = (const float*)args.in[20]; F.b1 = (const float*)args.in[21];
    F.w2 = (const float*)args.in[22]; F.b2 = (const float*)args.in[23]; F.w_ada_final = (const float*)args.in[24]; F.b_ada_final = (const float*)args.in[25]; F.norm_final_w = (const float*)args.in[26];
    for (int u = F.tid; u < (LDS_BYTES - LDSCTL_OFF) / 4; u += NWAVES * 64) ((LAS unsigned*)(F.lds + LDSCTL_OFF))[u] = 0u;
    __syncthreads();
    XcdBarrier bar; bar.bar = (unsigned*)(F.ctl + CW_BAR); bar.x = 0; bar.st = nullptr;
    if (MK_ONE_LAUNCH) bar = xcd_barrier_post((unsigned*)(F.ctl + CW_BAR), F.LW + LW_BAR);
    const int lo = args.ph_lo, hi = args.ph_hi;
#ifndef PH_MASK
#define PH_MASK 0xFFF
#endif
#define IN(k) (((PH_MASK >> (k)) & 1) && lo <= (k) && (k) < hi)
#define SEAM(k) do { if (IN(k) && IN((k) + 1)) xcd_barrier(bar); } while (0)
    const int cid = F.vcu;

    if (IN(0)) { p0_prologue(F); if (MK_ONE_LAUNCH) { wait_gemv(F); p1_norm(F); } } if (!MK_ONE_LAUNCH) SEAM(0);
    if (IN(1)) { if (!MK_ONE_LAUNCH) p1_norm(F); } SEAM(1);
    if (IN(2)) {
        constexpr int RP0 = 14, NX15 = 2;
        const bool split = (F.G == 256);
        const int idx = cid & 31, xc = cid >> 5;
        const int rpx = RP0 + (xc < NX15 ? 1 : 0), gbase = RP0 * xc + (xc < NX15 ? xc : NX15), cbase = (32 - RP0) * xc - (xc < NX15 ? xc : NX15);
        constexpr int NGW_ = 8 * RP0 + NX15, NCW_ = 256 - NGW_;
        if (!split || idx < rpx) {
            pg8::DenseOrder S; S.init(WSP(bf16_t, WS_H), DM, WSP(bf16_t, WS_WIN), NTOK, DINP, DM, split ? NGW_ : F.G, split ? gbase + idx : cid);
            epi::Bf16Plain E{WSP(bf16_t, WS_PROJ), DINP};
            pg8::gemm_phase_b3(F.lds, S, E);
        }
        if (!split) moe_convert(F, cid, F.G); else if (idx >= rpx) moe_convert(F, cbase + (idx - rpx), NCW_);
    } SEAM(2);
    if (IN(3)) {
        p3_rows(F);
        for (int u = cid; u < NB * GLA_H * GLA_NCH; u += F.G) gla_pass1_unit(F, u);
    } SEAM(3);
    if (IN(4)) {
        { pg8::DenseOrder S; S.init(WSP(bf16_t, WS_PROJ) + C_CKV, DINP, WSP(bf16_t, WS_WKV), NTOK, NKV, MLA_KVR, F.G, cid);
          epi::Bf16RowScale E{WSP(bf16_t, WS_KV), NKV, WSP(float, WS_RSKV)};
          pg8::gemm_phase(F.lds, S, E); }
        { pg8::DenseOrder S; S.init(WSP(bf16_t, WS_PROJ) + C_QLAT, DINP, WSP(bf16_t, WS_WQ), NTOK, NQ, MLA_QR, F.G, cid);
          epi::QRope E{WSP(bf16_t, WS_Q), WSP(float, WS_RSQ), WSP(float, WS_CS)};
          pg8::gemm_phase(F.lds, S, E); }
        gla_pass2(F);
    } SEAM(4);
    if (IN(5)) {
#ifndef NO_ATT
        for (int it = cid; it < NB * MLA_H * 16; it += F.G) attn_item(F, it);
#endif
#ifndef NO_GLA3
        if (F.tid == 0) F.LW[LW_TMP] = __hip_atomic_fetch_add((unsigned*)(F.ctl + CW_GQ), 1u, RLX_AGENT);
        __syncthreads();
        for (;;) {
            const int u = (int)F.LW[LW_TMP];
            __syncthreads();
            if (u >= NB * GLA_H * GLA_NCH) break;
            unsigned nx = 0u; if (F.tid == 0) nx = __hip_atomic_fetch_add((unsigned*)(F.ctl + CW_GQ), 1u, RLX_AGENT);
            gla_pass3_unit(F, u);
            if (F.tid == 0) F.LW[LW_TMP] = nx;
            __syncthreads();
        }
#endif
    } SEAM(5);
    if (IN(6)) {
        pg8::DenseOrder S; S.init(WSP(bf16_t, WS_ATTO), BR_LD, WSP(bf16_t, WS_WOM), NTOK, DM, 2048, F.G, cid);
        epi::GateMerge2 E{WSP(bf16_t, WS_MERGED), WSP(bf16_t, WS_PROJ)};
        pg8::gemm_phase(F.lds, S, E);
    } SEAM(6);
    if (IN(7)) {
        pg8::DenseOrder S; S.init(WSP(bf16_t, WS_MERGED), DM, WSP(bf16_t, WS_WOUT), NTOK, DM, DM, F.G, cid);
        epi::ResidGateF32 E{WSP(float, WS_X1), F.x, WSP(float, WS_MOD) + 2 * DM};
        pg8::gemm_phase(F.lds, S, E);
    } SEAM(7);
    if (IN(8)) { p8_router(F); } SEAM(8);
    if (IN(9)) {
        moe_tables_both(F, F.G, cid);
        MoeBoth S{WSP(unsigned char, WS_H), WSP(unsigned char, WS_ACT), WSP(unsigned char, WS_W1), WSP(unsigned char, WS_W2), DM, DM, WSP(int, WS_ROWMAP), F.LW, (const unsigned*)(F.ctl + CW_BLK), F.G, cid, F.probe};
        epi::MoeEpi E{WSP(unsigned char, WS_ACT), F.b1, WSP(unsigned char, WS_Y), F.b2, (unsigned*)(F.ctl + CW_BLK)};
        pg8::gemm_phase_b3(F.lds, S, E);
    }
    SEAM(10);
    if (IN(11)) { p11_final(F); }
#undef IN
#undef SEAM
}

extern "C" void kernel_launch(void* const* d_in, const int* in_sizes, int n_in, void* d_out, int out_size, void* d_ws, size_t ws_size, hipStream_t stream) {
    static int grid = 0;
    if (grid == 0) {
        if (n_in != 27 || in_sizes[0] != NTOK * DM || out_size != NTOK * DM || ws_size < WS_END) { fprintf(stderr, "kernel_launch: unexpected shapes (n_in %d, in0 %d, out %d, ws %zu < %zu); nothing launched\n", n_in, n_in > 0 ? in_sizes[0] : -1, out_size, ws_size, (size_t)WS_END); grid = -1; return; }
        int dev = 0, cus = 0, per_cu = 0;
        if (hipGetDevice(&dev) != hipSuccess || hipDeviceGetAttribute(&cus, hipDeviceAttributeMultiprocessorCount, dev) != hipSuccess) { fprintf(stderr, "kernel_launch: device query failed\n"); grid = -1; return; }
        if (hipFuncSetAttribute((const void*)mk_fwd, hipFuncAttributeMaxDynamicSharedMemorySize, LDS_BYTES) != hipSuccess) { fprintf(stderr, "kernel_launch: hipFuncSetAttribute failed\n"); grid = -1; return; }
        if (hipOccupancyMaxActiveBlocksPerMultiprocessor(&per_cu, (const void*)mk_fwd, NWAVES * 64, LDS_BYTES) != hipSuccess || per_cu < 1) { fprintf(stderr, "kernel_launch: occupancy query reports %d workgroups per CU\n", per_cu); }
        (void)hipGetLastError();
        grid = cus;
    }
    if (grid < 0) return;
    if (hipMemsetAsync((char*)d_ws + WS_CTL, 0, CTL_ZERO_BYTES, stream) != hipSuccess) { fprintf(stderr, "kernel_launch: memset failed\n"); return; }
    Args a{};
    for (int i = 0; i < 27; ++i) a.in[i] = d_in[i];
    a.out = (float*)d_out; a.ws = (unsigned char*)d_ws; a.pad = 0;
#if MK_ONE_LAUNCH
    a.ph_lo = 0; a.ph_hi = NPHASE; a.li = 0;
    hipLaunchKernelGGL(mk_fwd, dim3(grid), dim3(NWAVES * 64), LDS_BYTES, stream, a);
#else
#ifndef REP_MASK
#define REP_MASK 0
#endif
#ifndef REP_CNT
#define REP_CNT 1
#endif
#ifndef PROBE_ID
#define PROBE_ID 0
#endif
    for (int p = 0; p < NPHASE; ++p) for (int rep = 0; rep <= ((REP_MASK >> p) & 1) * REP_CNT; ++rep) { a.ph_lo = p; a.ph_hi = p + 1; a.li = p; a.pad = (rep < ((REP_MASK >> p) & 1) * REP_CNT) ? PROBE_ID : 0; hipLaunchKernelGGL(mk_fwd, dim3(grid), dim3(NWAVES * 64), LDS_BYTES, stream, a); }
#endif
    const hipError_t le = hipPeekAtLastError();
    if (le != hipSuccess) fprintf(stderr, "kernel_launch: launch failed: %s\n", hipGetErrorName(le));
}
```
